# Optimizing an MI355X kernel written in HIP

```python
import jax, jax.numpy as jnp
from jax import lax
import numpy as np

D_MODEL = 1024
BATCH = 4
SEQ = 8192
DEPTH = 1

CHUNK = 64
Q_BLOCK = 128
HEAD_DIM = 64
N_ATTN_HEADS = 8
D_ATTN = N_ATTN_HEADS * HEAD_DIM
N_IDX_HEADS = 8
IDX_DIM = 64
TOPK_MAX = 256
D_CONV = D_MODEL - D_ATTN
N_CONV_GROUPS = 8
CONV_WIDTH = 3
D_FF = 2816
D_PLE = 256
LN_EPS = 1e-5
DN_ALPHA = (2 * DEPTH) ** 0.25
DN_BETA = (8 * DEPTH) ** -0.25
IDX_SCALE = (N_IDX_HEADS ** -0.5) * (IDX_DIM ** -0.5)
SPLIT_SIZES = (D_ATTN, D_ATTN, D_ATTN, N_IDX_HEADS * IDX_DIM, IDX_DIM, N_IDX_HEADS, D_CONV, D_CONV, D_CONV)
D_IN = sum(SPLIT_SIZES)

kernel_name = "hybrid_dsa_shortconv_macaron_deepnorm"


def alibi_slopes():
    h = jnp.arange(1, N_ATTN_HEADS + 1, dtype=jnp.float32)
    return jnp.exp2(-8.0 * h / N_ATTN_HEADS)


def layer_norm(x, g, b):
    xf = x.astype(jnp.float32)
    mu = jnp.mean(xf, axis=-1, keepdims=True)
    xc = xf - mu
    var = jnp.mean(xc * xc, axis=-1, keepdims=True)
    y = xc * lax.rsqrt(var + LN_EPS) * g.astype(jnp.float32) + b.astype(jnp.float32)
    return y.astype(x.dtype)


def swiglu(x, wg, wu, wd):
    return (jax.nn.silu(x @ wg) * (x @ wu)) @ wd


def short_conv_mixer(bg, cg, u, conv_w):
    s = u.shape[1]
    z = cg * u
    zp = jnp.pad(z, ((0, 0), (CONV_WIDTH - 1, 0), (0, 0)))
    y = sum(conv_w[j] * zp[:, j:j + s] for j in range(CONV_WIDTH))
    return bg * y


def dsa_attention(q, k, v, q_idx, k_idx, w_idx):
    b, s = q.shape[0], q.shape[1]
    topk = min(TOPK_MAX, s // 4)
    nb = s // Q_BLOCK
    slopes = alibi_slopes()
    key_pos = jnp.arange(s)
    k_idx_f = k_idx.astype(jnp.float32)

    def block(args):
        qb, qib, wb, start = args
        q_pos = start + jnp.arange(Q_BLOCK)
        limit = (q_pos // CHUNK + 1) * CHUNK
        rel = jnp.einsum('bqhd,bsd->bqhs', qib.astype(jnp.float32), k_idx_f)
        score = jnp.einsum('bqhs,bqh->bqs', jax.nn.relu(rel), wb.astype(jnp.float32))
        admissible = key_pos[None, :] < limit[:, None]
        score = jnp.where(admissible[None], score, -jnp.inf)
        _, idx = lax.top_k(score, topk)
        valid = idx < limit[None, :, None]
        kg = jax.vmap(lambda kb, ib: kb[ib])(k, idx)
        vg = jax.vmap(lambda vb, ib: vb[ib])(v, idx)
        logits = jnp.einsum('bqhd,bqkhd->bhqk', qb, kg).astype(jnp.float32) * (HEAD_DIM ** -0.5)
        dist = jnp.abs(q_pos[None, :, None] - idx).astype(jnp.float32)
        logits = logits - slopes[None, :, None, None] * dist[:, None]
        logits = jnp.where(valid[:, None], logits, -jnp.inf)
        probs = jax.nn.softmax(logits, axis=-1).astype(v.dtype)
        return jnp.einsum('bhqk,bqkhd->bqhd', probs, vg)

    def to_blocks(a):
        return a.reshape(b, nb, Q_BLOCK, *a.shape[2:]).swapaxes(0, 1)

    starts = jnp.arange(nb) * Q_BLOCK
    out = lax.map(block, (to_blocks(q), to_blocks(q_idx), to_blocks(w_idx), starts))
    return out.swapaxes(0, 1).reshape(b, s, N_ATTN_HEADS * HEAD_DIM)


def setup_inputs(seed: int = 0) -> dict:
    key = jax.random.key(seed)
    ks = jax.random.split(key, 24)
    f32 = jnp.float32

    def nrm(k, shape, scale):
        return jax.random.normal(k, shape, f32) * scale

    x = nrm(ks[0], (BATCH, SEQ, D_MODEL), 1.0)
    p = nrm(ks[1], (DEPTH, BATCH, SEQ, D_PLE), 1.0)
    w_in = nrm(ks[2], (DEPTH, D_MODEL, D_IN), D_MODEL ** -0.5)
    w_in = w_in.at[:, :, 2 * D_ATTN:3 * D_ATTN].multiply(DN_BETA)
    return {
        "x": x,
        "p": p,
        "ln1_g": 1.0 + nrm(ks[3], (DEPTH, D_MODEL), 0.02),
        "ln1_b": nrm(ks[4], (DEPTH, D_MODEL), 0.02),
        "ffn1_wg": nrm(ks[5], (DEPTH, D_MODEL, D_FF), D_MODEL ** -0.5),
        "ffn1_wu": nrm(ks[6], (DEPTH, D_MODEL, D_FF), DN_BETA * D_MODEL ** -0.5),
        "ffn1_wd": nrm(ks[7], (DEPTH, D_FF, D_MODEL), DN_BETA * D_FF ** -0.5),
        "w_in": w_in,
        "conv_w": nrm(ks[8], (DEPTH, CONV_WIDTH, D_CONV), CONV_WIDTH ** -0.5),
        "w_out": nrm(ks[9], (DEPTH, D_MODEL, D_MODEL), DN_BETA * D_MODEL ** -0.5),
        "ln2_g": 1.0 + nrm(ks[10], (DEPTH, D_MODEL), 0.02),
        "ln2_b": nrm(ks[11], (DEPTH, D_MODEL), 0.02),
        "ffn2_wg": nrm(ks[12], (DEPTH, D_MODEL, D_FF), D_MODEL ** -0.5),
        "ffn2_wu": nrm(ks[13], (DEPTH, D_MODEL, D_FF), DN_BETA * D_MODEL ** -0.5),
        "ffn2_wd": nrm(ks[14], (DEPTH, D_FF, D_MODEL), DN_BETA * D_FF ** -0.5),
        "ln3_g": 1.0 + nrm(ks[15], (DEPTH, D_MODEL), 0.02),
        "ln3_b": nrm(ks[16], (DEPTH, D_MODEL), 0.02),
        "ple_gate_w": nrm(ks[17], (DEPTH, D_MODEL, D_MODEL), D_MODEL ** -0.5),
        "ple_proj_w": nrm(ks[18], (DEPTH, D_PLE, D_MODEL), D_PLE ** -0.5),
    }


def reference(x, p, ln1_g, ln1_b, ffn1_wg, ffn1_wu, ffn1_wd, w_in, conv_w, w_out,
              ln2_g, ln2_b, ffn2_wg, ffn2_wu, ffn2_wd, ln3_g, ln3_b, ple_gate_w, ple_proj_w):
    b, s, _ = x.shape
    split_points = list(np.cumsum(SPLIT_SIZES)[:-1])
    for i in range(DEPTH):
        x = layer_norm(DN_ALPHA * x + 0.5 * swiglu(x, ffn1_wg[i], ffn1_wu[i], ffn1_wd[i]), ln1_g[i], ln1_b[i])
        h = x @ w_in[i]
        q, k, v, qi, ki, wi, bg, cg, u = jnp.split(h, split_points, axis=-1)
        attn = dsa_attention(
            q.reshape(b, s, N_ATTN_HEADS, HEAD_DIM),
            k.reshape(b, s, N_ATTN_HEADS, HEAD_DIM),
            v.reshape(b, s, N_ATTN_HEADS, HEAD_DIM),
            qi.reshape(b, s, N_IDX_HEADS, IDX_DIM),
            ki,
            wi * IDX_SCALE,
        )
        conv = short_conv_mixer(bg, cg, u, conv_w[i])
        mix = jnp.concatenate([attn, conv], axis=-1) @ w_out[i]
        x = layer_norm(DN_ALPHA * x + mix, ln2_g[i], ln2_b[i])
        x = layer_norm(DN_ALPHA * x + 0.5 * swiglu(x, ffn2_wg[i], ffn2_wu[i], ffn2_wd[i]), ln3_g[i], ln3_b[i])
        x = x + jax.nn.sigmoid(x @ ple_gate_w[i]) * (p[i] @ ple_proj_w[i])
    return x
```

```cpp
#include <hip/hip_runtime.h>
#include <cstdio>
#include <cstdint>
namespace pg8 {
#define PG8_LAS __attribute__((address_space(3)))
typedef unsigned short bf16_t;
typedef short bf16x8 __attribute__((ext_vector_type(8)));
typedef float f32x4 __attribute__((ext_vector_type(4)));
typedef unsigned u32x4 __attribute__((ext_vector_type(4)));
constexpr int BM = 256, BK = 64, HALF = 128, HTB = HALF * BK * 2  , STAGE_BYTES = 8 * HTB, NXCD = 8, WGM = 8;

__host__ __device__ __forceinline__ int lds_byte(int r, int c) { const int st = (r >> 4) * 2 + (c >> 5), rr = r & 15, cc = c & 31, ob = rr * 64 + cc * 2; return st * 1024 + (ob ^ (((ob >> 9) & 1) << 5)); }
__host__ __device__ __forceinline__ void stage_rc(int b, int& R, int& C) { const int st = b / 1024, sb = b % 1024, swz = sb ^ (((sb >> 9) & 1) << 5); R = (st >> 1) * 16 + swz / 64; C = (st & 1) * 32 + (swz % 64) / 2; }
__host__ __device__ __forceinline__ int perm32(int rho) { const int n = rho >> 4, i = rho & 15; return 8 * (i >> 2) + 4 * n + (i & 3); }

struct Unit { int pm, pn; };
struct Gemm { const bf16_t* A; const bf16_t* Bt; int M, N, K; };

struct StaticOrder {
    int nM, nN, nwg, G, c;
    __host__ __device__ void init(int M, int N, int G_, int c_) { nM = M / BM; nN = N / BM; nwg = nM * nN; G = G_; c = c_; }
    __host__ __device__ bool next(int i, Unit& u) const {
        const long L = (long)i * G + c; if (L >= nwg) return false;
        int wgid = (int)L; { const int q = nwg / NXCD, r = nwg % NXCD, xcd = wgid % NXCD, off = wgid / NXCD; wgid = (xcd < r ? xcd * (q + 1) : r * (q + 1) + (xcd - r) * q) + off; }
        const int nig = WGM * nN, gid = wgid / nig, fm = gid * WGM, gsz = (nM - fm) < WGM ? (nM - fm) : WGM;
        u.pm = fm + ((wgid % nig) % gsz); u.pn = (wgid % nig) / gsz; return true;
    }
    __device__ __forceinline__ void a_ready(const Unit&) const {}
    __device__ __forceinline__ void done(const Unit&) const {}
};

__device__ __forceinline__ unsigned cvt_pk_bf16(float lo, float hi) { unsigned r; asm volatile("v_cvt_pk_bf16_f32 %0, %1, %2" : "=v"(r) : "v"(lo), "v"(hi)); return r; }
__device__ __forceinline__ float silu_mul(float g, float u) { return g * __builtin_amdgcn_rcpf(1.0f + __builtin_amdgcn_exp2f(-1.4426950408889634f * g)) * u; }
__device__ __forceinline__ float sigmoidf_(float g) { return __builtin_amdgcn_rcpf(1.0f + __builtin_amdgcn_exp2f(-1.4426950408889634f * g)); }

struct EpiSwiGLU {
    static constexpr bool PERM = true, AFTER_DRAIN = false;
    bf16_t* H; int ldh;
    __device__ __forceinline__ void operator()(const f32x4 (&acc)[2][2][4][2], const Unit& u, int wr, int wc, int fr, int fq) const {
        const int row0 = u.pm * BM + wr * 64 + fr, col0 = u.pn * HALF + wc * 32 + 8 * fq;
#pragma unroll
        for (int ai = 0; ai < 2; ++ai)
#pragma unroll
            for (int m = 0; m < 4; ++m) { bf16_t* rowp = H + (size_t)(row0 + ai * HALF + m * 16) * ldh + col0;
                const f32x4 g0 = acc[ai][0][m][0], g1 = acc[ai][0][m][1], u0 = acc[ai][1][m][0], u1 = acc[ai][1][m][1];
                u32x4 w; w.x = cvt_pk_bf16(silu_mul(g0[0], u0[0]), silu_mul(g0[1], u0[1])); w.y = cvt_pk_bf16(silu_mul(g0[2], u0[2]), silu_mul(g0[3], u0[3]));
                w.z = cvt_pk_bf16(silu_mul(g1[0], u1[0]), silu_mul(g1[1], u1[1])); w.w = cvt_pk_bf16(silu_mul(g1[2], u1[2]), silu_mul(g1[3], u1[3]));
                *(u32x4*)rowp = w; }
    }
};
struct EpiRes {
    static constexpr bool PERM = false, AFTER_DRAIN = false;
    const float* base; float* out; int ldc; float alpha, s;
    __device__ __forceinline__ void operator()(const f32x4 (&acc)[2][2][4][2], const Unit& u, int wr, int wc, int fr, int fq) const {
        const int row0 = u.pm * BM + wr * 64 + fr, col0 = u.pn * BM + wc * 32 + 4 * fq;
#pragma unroll
        for (int ai = 0; ai < 2; ++ai)
#pragma unroll
            for (int m = 0; m < 4; ++m) { const size_t off = (size_t)(row0 + ai * HALF + m * 16) * ldc + col0;
#pragma unroll
                for (int bj = 0; bj < 2; ++bj)
#pragma unroll
                    for (int n = 0; n < 2; ++n) { const f32x4 bs = *(const f32x4*)(base + off + bj * HALF + n * 16); *(f32x4*)(out + off + bj * HALF + n * 16) = bs * alpha + acc[ai][bj][m][n] * s; } }
    }
};
struct EpiF32 {
    static constexpr bool PERM = false, AFTER_DRAIN = false;
    float* out; int ldc;
    __device__ __forceinline__ void operator()(const f32x4 (&acc)[2][2][4][2], const Unit& u, int wr, int wc, int fr, int fq) const {
        const int row0 = u.pm * BM + wr * 64 + fr, col0 = u.pn * BM + wc * 32 + 4 * fq;
#pragma unroll
        for (int ai = 0; ai < 2; ++ai)
#pragma unroll
            for (int m = 0; m < 4; ++m) { const size_t off = (size_t)(row0 + ai * HALF + m * 16) * ldc + col0;
#pragma unroll
                for (int bj = 0; bj < 2; ++bj)
#pragma unroll
                    for (int n = 0; n < 2; ++n) *(f32x4*)(out + off + bj * HALF + n * 16) = acc[ai][bj][m][n]; }
    }
};
struct EpiGate {
    static constexpr bool PERM = false, AFTER_DRAIN = false;
    const float* xin; const float* pp; float* out; int ldc;
    __device__ __forceinline__ void operator()(const f32x4 (&acc)[2][2][4][2], const Unit& u, int wr, int wc, int fr, int fq) const {
        const int row0 = u.pm * BM + wr * 64 + fr, col0 = u.pn * BM + wc * 32 + 4 * fq;
#pragma unroll
        for (int ai = 0; ai < 2; ++ai)
#pragma unroll
            for (int m = 0; m < 4; ++m) { const size_t off = (size_t)(row0 + ai * HALF + m * 16) * ldc + col0;
#pragma unroll
                for (int bj = 0; bj < 2; ++bj)
#pragma unroll
                    for (int n = 0; n < 2; ++n) { const f32x4 xv = *(const f32x4*)(xin + off + bj * HALF + n * 16), pv = *(const f32x4*)(pp + off + bj * HALF + n * 16), a = acc[ai][bj][m][n];
                        f32x4 o; o[0] = xv[0] + sigmoidf_(a[0]) * pv[0]; o[1] = xv[1] + sigmoidf_(a[1]) * pv[1]; o[2] = xv[2] + sigmoidf_(a[2]) * pv[2]; o[3] = xv[3] + sigmoidf_(a[3]) * pv[3];
                        *(f32x4*)(out + off + bj * HALF + n * 16) = o; } }
    }
};
struct EpiWin {
    static constexpr bool PERM = true, AFTER_DRAIN = false;
    bf16_t* qkvi;
    bf16_t* ki;
    float* wi;
    bf16_t* bc;
    bf16_t* z;
    int M; float idx_scale;
    __device__ __forceinline__ void operator()(const f32x4 (&acc)[2][2][4][2], const Unit& u, int wr, int wc, int fr, int fq) const {
        const int row0 = u.pm * BM + wr * 64 + fr, cw = wc * 32 + 8 * fq; const int pn = u.pn;
        if (pn >= 11) {
#pragma unroll
            for (int ai = 0; ai < 2; ++ai)
#pragma unroll
                for (int m = 0; m < 4; ++m) { bf16_t* rowp = z + (size_t)(row0 + ai * HALF + m * 16) * 512 + (pn - 11) * HALF + cw;
                    const f32x4 g0 = acc[ai][0][m][0], g1 = acc[ai][0][m][1], u0 = acc[ai][1][m][0], u1 = acc[ai][1][m][1];
                    u32x4 w; w.x = cvt_pk_bf16(g0[0] * u0[0], g0[1] * u0[1]); w.y = cvt_pk_bf16(g0[2] * u0[2], g0[3] * u0[3]); w.z = cvt_pk_bf16(g1[0] * u1[0], g1[1] * u1[1]); w.w = cvt_pk_bf16(g1[2] * u1[2], g1[3] * u1[3]);
                    *(u32x4*)rowp = w; }
        } else if (pn == 8) {
            if (wc < 2) {
#pragma unroll
                for (int ai = 0; ai < 2; ++ai)
#pragma unroll
                    for (int m = 0; m < 4; ++m) { bf16_t* rowp = ki + (size_t)(row0 + ai * HALF + m * 16) * 64 + cw; const f32x4 v0 = acc[ai][0][m][0], v1 = acc[ai][0][m][1];
                        u32x4 w; w.x = cvt_pk_bf16(v0[0], v0[1]); w.y = cvt_pk_bf16(v0[2], v0[3]); w.z = cvt_pk_bf16(v1[0], v1[1]); w.w = cvt_pk_bf16(v1[2], v1[3]); *(u32x4*)rowp = w; }
            } else if (wc == 2 && fq == 0) {
#pragma unroll
                for (int ai = 0; ai < 2; ++ai)
#pragma unroll
                    for (int m = 0; m < 4; ++m) { float* rowp = wi + (size_t)(row0 + ai * HALF + m * 16) * 8; *(f32x4*)rowp = acc[ai][0][m][0] * idx_scale; *(f32x4*)(rowp + 4) = acc[ai][0][m][1] * idx_scale; }
            }
        } else {
            bf16_t* base; int colt;
            if (pn < 8) { base = qkvi + (size_t)(pn >> 1) * M * 512; colt = (pn & 1) * BM; } else { base = bc; colt = (pn - 9) * BM; }
#pragma unroll
            for (int ai = 0; ai < 2; ++ai)
#pragma unroll
                for (int m = 0; m < 4; ++m) { bf16_t* rowp = base + (size_t)(row0 + ai * HALF + m * 16) * 512 + colt + cw;
#pragma unroll
                    for (int bj = 0; bj < 2; ++bj) { const f32x4 v0 = acc[ai][bj][m][0], v1 = acc[ai][bj][m][1];
                        u32x4 w; w.x = cvt_pk_bf16(v0[0], v0[1]); w.y = cvt_pk_bf16(v0[2], v0[3]); w.z = cvt_pk_bf16(v1[0], v1[1]); w.w = cvt_pk_bf16(v1[2], v1[3]); *(u32x4*)(rowp + bj * HALF) = w; } }
        }
    }
};

template <class Epi, class Sched, bool ALIGN_EPI = false, bool SP2 = false>
__device__ __forceinline__ void gemm_phase(PG8_LAS unsigned char* lds, const Gemm g, const Sched& S, const Epi& E) {
    int tid_ = threadIdx.x; asm volatile("" : "+v"(tid_));
    const int tid = tid_, wid = __builtin_amdgcn_readfirstlane(tid >> 6), lane = tid & 63, wr = wid >> 2, wc = wid & 3, fr = lane & 15, fq = lane >> 4;
    const int K = g.K, nt = K / BK;
    unsigned voffA[2], voffB[2];
#pragma unroll
    for (int i = 0; i < 2; ++i) { int R, C; stage_rc(tid * 16 + i * 8192, R, C); const int Rb = Epi::PERM ? ((R & ~31) + perm32(R & 31)) : R;
        voffA[i] = (unsigned)(R * K + C) * 2u; voffB[i] = (unsigned)(Rb * K + C) * 2u; }
    const size_t kstep = (size_t)(BK * 2);
    const size_t hstep = (size_t)HALF * K * 2;
    const size_t tstep = 2 * hstep;
    const unsigned ldsw = (unsigned)wid * 1024u;
    const int aoff = lds_byte(wr * 64 + fr, fq * 8), boff = lds_byte(wc * 32 + fr, fq * 8);
#define PG8_SA(b, h) (((b) * 2 + (h)) * HTB)
#define PG8_SB(b, h) ((4 + (b) * 2 + (h)) * HTB)
#define PG8_STAGE(bufoff, gbase, voff) do { _Pragma("unroll") for (int _i = 0; _i < 2; ++_i) \
        __builtin_amdgcn_global_load_lds((const unsigned*)((const char*)(gbase) + (voff)[_i]), (PG8_LAS unsigned*)(lds + (bufoff) + ldsw + _i * 8192), 16, 0, 0); } while (0)
#define PG8_LDA(dst, b, h) do { _Pragma("unroll") for (int m = 0; m < 4; ++m) _Pragma("unroll") for (int k = 0; k < 2; ++k) dst[m][k] = *(const PG8_LAS bf16x8*)(lds + PG8_SA(b, h) + aoff + m * 2048 + k * 1024); } while (0)
#define PG8_LDB(dst, b, h) do { _Pragma("unroll") for (int n = 0; n < 2; ++n) _Pragma("unroll") for (int k = 0; k < 2; ++k) dst[n][k] = *(const PG8_LAS bf16x8*)(lds + PG8_SB(b, h) + boff + n * 2048 + k * 1024); } while (0)
#define PG8_MMA(ai, bj, At, Bt) do { __builtin_amdgcn_s_setprio(1); _Pragma("unroll") for (int m = 0; m < 4; ++m) _Pragma("unroll") for (int n = 0; n < 2; ++n) _Pragma("unroll") for (int k = 0; k < 2; ++k) \
        acc[ai][bj][m][n] = __builtin_amdgcn_mfma_f32_16x16x32_bf16(Bt[n][k], At[m][k], acc[ai][bj][m][n], 0, 0, 0); __builtin_amdgcn_s_setprio(0); } while (0)
#define PG8_WAIT_V(n) asm volatile("s_waitcnt vmcnt(" #n ")" ::: "memory")
#define PG8_WAIT_L(n) asm volatile("s_waitcnt lgkmcnt(" #n ")" ::: "memory")
#define PG8_BAR __builtin_amdgcn_s_barrier()
#define PG8_SCHED __builtin_amdgcn_sched_barrier(0)
    Unit cur, nxt; int ui = 0;
    if (!S.next(0, cur)) return;
    f32x4 acc[2][2][4][2];
#pragma unroll
    for (int a = 0; a < 2; ++a)
#pragma unroll
        for (int b = 0; b < 2; ++b)
#pragma unroll
            for (int m = 0; m < 4; ++m)
#pragma unroll
                for (int n = 0; n < 2; ++n) acc[a][b][m][n] = (f32x4){0.f, 0.f, 0.f, 0.f};
    bf16x8 At[4][2], B0[2][2], B1[2][2];
    const char* cA = (const char*)g.A + (size_t)cur.pm * tstep; const char* cB = (const char*)g.Bt + (size_t)cur.pn * tstep;
    S.a_ready(cur);
    if constexpr (SP2) {
        PG8_STAGE(PG8_SB(0, 0), cB, voffB); PG8_STAGE(PG8_SB(0, 1), cB + hstep, voffB); PG8_STAGE(PG8_SA(0, 0), cA, voffA); PG8_STAGE(PG8_SA(0, 1), cA + hstep, voffA);
        if (wr == 1) PG8_BAR;
        PG8_WAIT_V(2); PG8_BAR;
        PG8_STAGE(PG8_SB(1, 0), cB + kstep, voffB); PG8_STAGE(PG8_SA(1, 0), cA + kstep, voffA); PG8_STAGE(PG8_SB(1, 1), cB + hstep + kstep, voffB);
        PG8_WAIT_V(6); PG8_BAR;
    } else {
        PG8_STAGE(PG8_SB(0, 0), cB, voffB); PG8_STAGE(PG8_SA(0, 0), cA, voffA); PG8_STAGE(PG8_SB(0, 1), cB + hstep, voffB); PG8_STAGE(PG8_SA(0, 1), cA + hstep, voffA);
        if (wr == 1) PG8_BAR;
        PG8_WAIT_V(4); PG8_BAR;
        PG8_STAGE(PG8_SB(1, 0), cB + kstep, voffB); PG8_STAGE(PG8_SA(1, 0), cA + kstep, voffA); PG8_STAGE(PG8_SB(1, 1), cB + hstep + kstep, voffB);
        PG8_WAIT_V(6); PG8_BAR;
    }
    for (;;) {
        const bool has_next = S.next(ui + 1, nxt);
        const char* nA = has_next ? (const char*)g.A + (size_t)nxt.pm * tstep : cA; const char* nB = has_next ? (const char*)g.Bt + (size_t)nxt.pn * tstep : cB;
        for (int t = 0; t < nt; t += 2) {
            const bool last = (t == nt - 2);
            const char* a1 = cA + (size_t)(t + 1) * kstep;
            const char* a2 = last ? nA : cA + (size_t)(t + 2) * kstep; const char* b2 = last ? nB : cB + (size_t)(t + 2) * kstep;
            const char* a3 = a2 + kstep; const char* b3 = b2 + kstep;
            if (last && has_next) S.a_ready(nxt);
            if constexpr (SP2) {
            PG8_LDB(B0, 0, 0); PG8_LDB(B1, 0, 1); PG8_SCHED; PG8_LDA(At, 0, 0); PG8_STAGE(PG8_SA(1, 1), a1 + hstep, voffA);
            PG8_WAIT_V(8); PG8_WAIT_L(0); PG8_BAR; PG8_MMA(0, 0, At, B0); PG8_MMA(0, 1, At, B1); PG8_BAR; PG8_SCHED;
            PG8_LDA(At, 0, 1); PG8_STAGE(PG8_SB(0, 0), b2, voffB); PG8_STAGE(PG8_SB(0, 1), b2 + hstep, voffB); PG8_STAGE(PG8_SA(0, 0), a2, voffA);
            PG8_WAIT_V(8); PG8_WAIT_L(0); PG8_BAR; PG8_MMA(1, 0, At, B0); PG8_MMA(1, 1, At, B1); PG8_BAR; PG8_SCHED;
            PG8_LDB(B0, 1, 0); PG8_LDB(B1, 1, 1); PG8_SCHED; PG8_LDA(At, 1, 0); PG8_STAGE(PG8_SA(0, 1), a2 + hstep, voffA);
            PG8_WAIT_V(8); PG8_WAIT_L(0); PG8_BAR; PG8_MMA(0, 0, At, B0); PG8_MMA(0, 1, At, B1); PG8_BAR; PG8_SCHED;
            PG8_LDA(At, 1, 1); PG8_STAGE(PG8_SB(1, 0), b3, voffB); PG8_STAGE(PG8_SB(1, 1), b3 + hstep, voffB); PG8_STAGE(PG8_SA(1, 0), a3, voffA);
            PG8_WAIT_V(8); PG8_WAIT_L(0); PG8_BAR; PG8_MMA(1, 0, At, B0); PG8_MMA(1, 1, At, B1); PG8_BAR; PG8_SCHED;
            } else {
            PG8_LDB(B0, 0, 0); PG8_SCHED; PG8_LDA(At, 0, 0); PG8_STAGE(PG8_SA(1, 1), a1 + hstep, voffA);
            PG8_WAIT_L(8); PG8_BAR; PG8_WAIT_L(0); PG8_MMA(0, 0, At, B0); PG8_BAR; PG8_SCHED;
            PG8_LDB(B1, 0, 1); PG8_STAGE(PG8_SB(0, 0), b2, voffB);
            PG8_BAR; PG8_WAIT_L(0); PG8_MMA(0, 1, At, B1); PG8_BAR;
            PG8_LDA(At, 0, 1); PG8_STAGE(PG8_SA(0, 0), a2, voffA);
            PG8_BAR; PG8_WAIT_L(0); PG8_MMA(1, 0, At, B0); PG8_BAR; PG8_SCHED;
            PG8_STAGE(PG8_SB(0, 1), b2 + hstep, voffB);
            PG8_WAIT_V(6); PG8_BAR; PG8_MMA(1, 1, At, B1); PG8_BAR;
            PG8_LDB(B0, 1, 0); PG8_SCHED; PG8_LDA(At, 1, 0); PG8_STAGE(PG8_SA(0, 1), a2 + hstep, voffA);
            PG8_WAIT_L(8); PG8_BAR; PG8_WAIT_L(0); PG8_MMA(0, 0, At, B0); PG8_BAR; PG8_SCHED;
            PG8_LDB(B1, 1, 1); PG8_STAGE(PG8_SB(1, 0), b3, voffB);
            PG8_BAR; PG8_WAIT_L(0); PG8_MMA(0, 1, At, B1); PG8_BAR;
            PG8_LDA(At, 1, 1); PG8_STAGE(PG8_SA(1, 0), a3, voffA);
            PG8_BAR; PG8_WAIT_L(0); PG8_MMA(1, 0, At, B0); PG8_BAR; PG8_SCHED;
            PG8_STAGE(PG8_SB(1, 1), b3 + hstep, voffB);
            PG8_WAIT_V(6); PG8_BAR; PG8_MMA(1, 1, At, B1); PG8_BAR;
            }
        }
        if constexpr (ALIGN_EPI) { if (wr == 0) PG8_BAR; }
        if constexpr (!Epi::AFTER_DRAIN) { E(acc, cur, wr, wc, fr, fq); S.done(cur); }
        if (!has_next) break;
#pragma unroll
        for (int a = 0; a < 2; ++a)
#pragma unroll
            for (int b = 0; b < 2; ++b)
#pragma unroll
                for (int m = 0; m < 4; ++m)
#pragma unroll
                    for (int n = 0; n < 2; ++n) acc[a][b][m][n] = (f32x4){0.f, 0.f, 0.f, 0.f};
        cur = nxt; cA = nA; cB = nB; ++ui;
        if constexpr (ALIGN_EPI) { if (wr == 1) PG8_BAR; }
    }
    PG8_WAIT_V(0);
    if constexpr (!ALIGN_EPI) { if (wr == 0) PG8_BAR; }
    PG8_BAR;
    if constexpr (Epi::AFTER_DRAIN) { E.fused(acc, cur, wr, wc, fr, fq, lds, wid, lane); S.done(cur); }
#undef PG8_SA
#undef PG8_SB
#undef PG8_STAGE
#undef PG8_LDA
#undef PG8_LDB
#undef PG8_MMA
#undef PG8_WAIT_V
#undef PG8_WAIT_L
#undef PG8_BAR
#undef PG8_SCHED
}
}

constexpr int NWAVES = 8;
constexpr int BATCH = 4, SEQ = 8192, D = 1024, FF = 2816, DPLE = 256, NHEAD = 8, HD = 64, DA = 512, DC = 512;
constexpr int M = BATCH * SEQ;
constexpr int NGU = 2 * FF;
constexpr int NIN = 3840;
constexpr float LN_EPS = 1e-5f;
constexpr float DN_ALPHA = 1.189207115002721f;
constexpr float IDX_SCALE = 0.04419417382415922f;
constexpr int TOPK = 256;
constexpr float LOG2E = 1.4426950408889634f;

constexpr size_t MiB = 1u << 20;
constexpr size_t WS_CTL = 0, CTL_ZERO_BYTES = 1 * MiB;
constexpr size_t WS_WGU1 = 2 * MiB, WS_WD1 = 13 * MiB, WS_WIN = 19 * MiB, WS_WOUT = 27 * MiB, WS_WGU2 = 29 * MiB, WS_WD2 = 40 * MiB, WS_WGATE = 46 * MiB, WS_WP = 48 * MiB;
constexpr size_t WS_XB = 64 * MiB;
constexpr size_t WS_R = 128 * MiB;
constexpr size_t WS_BIG = 256 * MiB;
constexpr size_t WS_QKVI = WS_BIG, WS_KI = WS_BIG + 128 * MiB, WS_WI = WS_BIG + 132 * MiB, WS_BC = WS_BIG + 136 * MiB, WS_Z = WS_BIG + 168 * MiB, WS_SEL = WS_BIG + 200 * MiB;
constexpr size_t WS_PB = 496 * MiB;
constexpr size_t WS_END = 512 * MiB;
static_assert(WS_WGU1 + (size_t)NGU * D * 2 <= WS_WD1 && WS_WD1 + (size_t)D * FF * 2 <= WS_WIN && WS_WIN + (size_t)NIN * D * 2 <= WS_WOUT && WS_WOUT + (size_t)D * D * 2 <= WS_WGU2 && WS_WGU2 + (size_t)NGU * D * 2 <= WS_WD2 &&
              WS_WD2 + (size_t)D * FF * 2 <= WS_WGATE && WS_WGATE + (size_t)D * D * 2 <= WS_WP && WS_WP + (size_t)D * DPLE * 2 <= WS_XB, "weight map");
static_assert(WS_XB + (size_t)M * D * 2 <= WS_R && WS_R + (size_t)M * D * 4 <= WS_BIG && WS_BIG + (size_t)M * FF * 2 <= WS_PB && WS_SEL + (size_t)BATCH * 128 * SEQ * 8 <= WS_PB && WS_PB + (size_t)M * DPLE * 2 <= WS_END, "d_ws map");
constexpr int CW_BAR = 4096;

constexpr int RING_OFF = 0, RING_BYTES = 131072;
constexpr int SROW_U16 = 64 * 132;
constexpr int SC_BYTES = 8 * SROW_U16 * 2;
constexpr int LDSCTL_OFF = 139264, MISC_OFF = LDSCTL_OFF + 320;
constexpr int LDS_BYTES = 147456;
static_assert(SC_BYTES <= LDSCTL_OFF && RING_BYTES <= LDSCTL_OFF && MISC_OFF + 128 <= LDS_BYTES, "LDS map");

#define GAS __attribute__((address_space(1)))
#define LAS __attribute__((address_space(3)))
typedef unsigned short bf16;
typedef unsigned v4u __attribute__((ext_vector_type(4)));
typedef unsigned v2u __attribute__((ext_vector_type(2)));
typedef float f32x4 __attribute__((ext_vector_type(4)));
typedef float f32x16 __attribute__((ext_vector_type(16)));
typedef short bf16x8 __attribute__((ext_vector_type(8)));
typedef unsigned short u16x2 __attribute__((ext_vector_type(2)));
typedef GAS unsigned gu32;
#define RLX_AGENT __ATOMIC_RELAXED, __HIP_MEMORY_SCOPE_AGENT
#define LDS_WAIT() asm volatile("s_waitcnt lgkmcnt(0)" ::: "memory")
#define VM_WAIT() asm volatile("s_waitcnt vmcnt(0)" ::: "memory")
__device__ __forceinline__ unsigned f2bf(float f) { unsigned u = __builtin_bit_cast(unsigned, f); return (u + 0x7fffu + ((u >> 16) & 1u)) >> 16; }
__device__ __forceinline__ unsigned pk2(float lo, float hi) { return f2bf(lo) | (f2bf(hi) << 16); }
__device__ __forceinline__ float bf_lo(unsigned w) { return __builtin_bit_cast(float, w << 16); }
__device__ __forceinline__ float bf_hi(unsigned w) { return __builtin_bit_cast(float, w & 0xffff0000u); }
#define XB_TMO      128
#define XB_XCNT(j)  (256  + 64 * (j))
#define XB_XSUB(j)  (1280 + 64 * (j))
#define XB_XGEN(j)  (2304 + 64 * (j))
#define XB_TOP      3328
#define XB_TOPGEN   3392
#define XCD_BAR_WORDS 3456
#define XB_SPIN_CAP (1u << 18)

__device__ __forceinline__ unsigned xb_ld(unsigned* p)              { return __hip_atomic_load(p, __ATOMIC_RELAXED, __HIP_MEMORY_SCOPE_AGENT); }
__device__ __forceinline__ unsigned xb_add(unsigned* p, unsigned v) { return __hip_atomic_fetch_add(p, v, __ATOMIC_RELAXED, __HIP_MEMORY_SCOPE_AGENT); }
__device__ __forceinline__ unsigned xb_xcc_id() { return (unsigned)__builtin_amdgcn_s_getreg((3 << 11) | 20) & 0xFu; }
#define XB_SPIN(cond, bar) do { unsigned _sp = 0; while (cond) { __builtin_amdgcn_s_sleep(1); \
    if ((++_sp & 255u) == 0u) { if (xb_ld(&(bar)[XB_TMO])) break; if (_sp > XB_SPIN_CAP) { atomicAdd(&(bar)[XB_TMO], 1u); break; } } } } while (0)

struct XcdBarrier {
    unsigned* bar; unsigned x;
    volatile LAS unsigned* st;
};

__device__ __forceinline__ XcdBarrier xcd_barrier_post(unsigned* bar, volatile LAS unsigned* st) {
    XcdBarrier b; b.bar = bar; b.x = xb_xcc_id(); b.st = st;
    if (threadIdx.x == 0) (void)xb_add(&bar[XB_XCNT(b.x)], 1u);
    return b;
}
__device__ __forceinline__ void xcd_barrier_complete(unsigned* bar, unsigned x, unsigned& nloc, unsigned& nx) {
    const unsigned G = gridDim.x * gridDim.y * gridDim.z;
    unsigned sum, cnt, mine, sp = 0u;
    for (;;) {
        sum = 0u; cnt = 0u; mine = 0u;
#pragma unroll
        for (unsigned j = 0; j < 16; ++j) { const unsigned c = xb_ld(&bar[XB_XCNT(j)]); sum += c; cnt += (c > 0u) ? 1u : 0u; mine = (j == x) ? c : mine; }
        if (sum == G) break;
        __builtin_amdgcn_s_sleep(1);
        if ((++sp & 255u) == 0u) { if (xb_ld(&bar[XB_TMO])) break; if (sp > XB_SPIN_CAP) { atomicAdd(&bar[XB_TMO], 1u); break; } }
    }
    nloc = mine > 0u ? mine : 1u; nx = cnt > 0u ? cnt : 1u;
}

__device__ __forceinline__ void xcd_barrier(const XcdBarrier& b) {
    asm volatile("s_waitcnt vmcnt(0)" ::: "memory");
    __syncthreads();
    if (threadIdx.x == 0) {
        unsigned* bar = b.bar;
        __builtin_amdgcn_s_waitcnt(0);
        unsigned nloc = b.st[0], nx = b.st[1];
        if (nloc == 0u) { xcd_barrier_complete(bar, b.x, nloc, nx); b.st[0] = nloc; b.st[1] = nx; }
        const unsigned old = xb_add(&bar[XB_XSUB(b.x)], 1u);
        const unsigned gen = old / nloc;
        if (old + 1u == (gen + 1u) * nloc) {
            __builtin_amdgcn_fence(__ATOMIC_RELEASE, "agent");
            asm volatile("s_waitcnt vmcnt(0)" ::: "memory");
            const unsigned og = xb_add(&bar[XB_TOP], 1u);
            const unsigned tg = og / nx;
            if (og + 1u == (tg + 1u) * nx) xb_add(&bar[XB_TOPGEN], 1u);
            else XB_SPIN(xb_ld(&bar[XB_TOPGEN]) == tg, bar);
            __builtin_amdgcn_fence(__ATOMIC_ACQUIRE, "agent");
            xb_add(&bar[XB_XGEN(b.x)], 1u);
            asm volatile("s_waitcnt vmcnt(0)" ::: "memory");
        } else {
            XB_SPIN(xb_ld(&bar[XB_XGEN(b.x)]) == gen, bar);
            __builtin_amdgcn_fence(__ATOMIC_ACQUIRE, "agent");
            asm volatile("s_waitcnt vmcnt(0)" ::: "memory");
        }
    }
    __syncthreads();
}

__device__ __forceinline__ void p0_transpose_item(const float* W, int K, int N, bf16* WT, LAS float* scr, int k0, int dn0, int c0, int lane) {
    const int n = lane & 31;
#pragma unroll 8
    for (int i = 0; i < 32; ++i) { const int kk = 2 * i + (lane >> 5); scr[kk * 33 + n] = (c0 >= 0) ? W[(size_t)(k0 + kk) * N + c0 + n] : 0.f; }
    LDS_WAIT(); asm volatile("" ::: "memory");
    const int c = lane & 7;
#pragma unroll
    for (int j = 0; j < 4; ++j) { const int nn = (lane >> 3) + 8 * j; const LAS float* s = scr + (8 * c) * 33 + nn;
        v4u o; o.x = pk2(s[0 * 33], s[1 * 33]); o.y = pk2(s[2 * 33], s[3 * 33]); o.z = pk2(s[4 * 33], s[5 * 33]); o.w = pk2(s[6 * 33], s[7 * 33]);
        *(GAS v4u*)(WT + (size_t)(dn0 + nn) * K + k0 + 8 * c) = o; }
    LDS_WAIT(); asm volatile("" ::: "memory");
}
__device__ __forceinline__ int win_src_col8(int d) {
    if (d < 2120) return d;
    if (d < 2304) return -1;
    if (d < 2816) return 2120 + (d - 2304);
    const int t = (d - 2816) >> 8, w = (d - 2816) & 255;
    return (w < 128) ? (2632 + 128 * t + w) : (3144 + 128 * t + (w - 128));
}
__device__ __forceinline__ void p0_transpose_item_win(const float* W, bf16* WT, LAS float* scr, int k0, int dn0, int lane) {
    const int n = lane & 31; const int c0 = win_src_col8(dn0 + (n & ~7)); const int col = c0 + (n & 7);
#pragma unroll 8
    for (int i = 0; i < 32; ++i) { const int kk = 2 * i + (lane >> 5); scr[kk * 33 + n] = (c0 >= 0) ? W[(size_t)(k0 + kk) * 3656 + col] : 0.f; }
    LDS_WAIT(); asm volatile("" ::: "memory");
    const int c = lane & 7;
#pragma unroll
    for (int j = 0; j < 4; ++j) { const int nn = (lane >> 3) + 8 * j; const LAS float* s = scr + (8 * c) * 33 + nn;
        v4u o; o.x = pk2(s[0 * 33], s[1 * 33]); o.y = pk2(s[2 * 33], s[3 * 33]); o.z = pk2(s[4 * 33], s[5 * 33]); o.w = pk2(s[6 * 33], s[7 * 33]);
        *(GAS v4u*)(WT + (size_t)(dn0 + nn) * D + k0 + 8 * c) = o; }
    LDS_WAIT(); asm volatile("" ::: "memory");
}
__device__ __forceinline__ float wave_sum(float v) {
#pragma unroll
    for (int o = 1; o < 64; o <<= 1) v += __shfl_xor(v, o);
    return v;
}
__device__ __forceinline__ void ln_row(const float* xrow, const float* g, const float* bta, float* orow, bf16* obrow, int lane) {
    const GAS f32x4* xr = (const GAS f32x4*)xrow + lane;
    f32x4 v[4]; float s = 0.f;
#pragma unroll
    for (int j = 0; j < 4; ++j) { v[j] = xr[64 * j]; s += (v[j].x + v[j].y) + (v[j].z + v[j].w); }
    const float mean = wave_sum(s) * (1.f / D); float s2 = 0.f;
#pragma unroll
    for (int j = 0; j < 4; ++j) { v[j] = v[j] - mean; s2 += (v[j].x * v[j].x + v[j].y * v[j].y) + (v[j].z * v[j].z + v[j].w * v[j].w); }
    const float rstd = 1.f / sqrtf(wave_sum(s2) * (1.f / D) + LN_EPS);
    GAS f32x4* of = (GAS f32x4*)orow + lane; GAS v2u* ob = (GAS v2u*)obrow + lane;
#pragma unroll
    for (int j = 0; j < 4; ++j) { const f32x4 gg = ((const GAS f32x4*)g)[lane + 64 * j], bb = ((const GAS f32x4*)bta)[lane + 64 * j];
        const f32x4 y = v[j] * rstd * gg + bb; of[64 * j] = y; v2u w; w.x = pk2(y.x, y.y); w.y = pk2(y.z, y.w); ob[64 * j] = w; }
}

struct Args { const float* in[19]; float* out; unsigned char* ws; };

__device__ __forceinline__ unsigned row_sum16(unsigned v) {
    v += (unsigned)__builtin_amdgcn_update_dpp(0, (int)v, 0xB1, 0xF, 0xF, true);
    v += (unsigned)__builtin_amdgcn_update_dpp(0, (int)v, 0x4E, 0xF, 0xF, true);
    v += (unsigned)__builtin_amdgcn_update_dpp(0, (int)v, 0x141, 0xF, 0xF, true);
    v += (unsigned)__builtin_amdgcn_update_dpp(0, (int)v, 0x140, 0xF, 0xF, true);
    return v;
}
__device__ __forceinline__ unsigned wave_sum_u(unsigned v) {
    v = row_sum16(v);
    return (unsigned)__builtin_amdgcn_readlane((int)v, 0) + (unsigned)__builtin_amdgcn_readlane((int)v, 16) + (unsigned)__builtin_amdgcn_readlane((int)v, 32) + (unsigned)__builtin_amdgcn_readlane((int)v, 48);
}
__device__ __forceinline__ unsigned score_key(float s) {
    const _Float16 h = (_Float16)s; unsigned hb = (unsigned)__builtin_bit_cast(unsigned short, h);
    return (hb & 0x8000u) ? (hb ^ 0xffffu) : (hb | 0x8000u);
}

template <int NREG>
__device__ __forceinline__ void select_emit(const LAS unsigned short* rowp, int nslots, int ntb, unsigned long long* selp  , int lane) {
    unsigned kreg[NREG];
#pragma unroll
    for (int i = 0; i < NREG / 2; ++i) { const v2u v = *(const LAS v2u*)(rowp + 4 * i); kreg[2 * i] = v.x; kreg[2 * i + 1] = v.y; }
#pragma unroll
    for (int p = 0; p < NREG; ++p) { if (2 * p >= nslots) kreg[p] = 0u; else if (2 * p + 1 >= nslots) kreg[p] &= 0xffffu; }
    unsigned T = 0u, need = 0u;
    if (nslots * 64 > TOPK) {
        unsigned lo = 0u, hi = 65536u, chi = 0u;
        for (int it = 0; it < 16; ++it) {
            const unsigned mid = (lo + hi) >> 1, m1 = mid - 1u, mm = m1 | (m1 << 16);
            const unsigned one2 = 0x00010001u;
            u16x2 acc = {0, 0};
#pragma unroll
            for (int p = 0; p < NREG; ++p) { unsigned d; asm("v_pk_sub_u16 %0, %1, %2 clamp" : "=v"(d) : "v"(kreg[p]), "s"(mm)); asm("v_pk_min_u16 %0, %1, %2" : "=v"(d) : "v"(d), "s"(one2)); acc += __builtin_bit_cast(u16x2, d); }
            const unsigned a = __builtin_bit_cast(unsigned, acc);
            const unsigned tot = wave_sum_u((a & 0xffffu) + (a >> 16));
            if (tot >= (unsigned)TOPK) lo = mid; else { hi = mid; chi = tot; }
        }
        T = lo; need = (unsigned)TOPK - chi;
    }
    unsigned w0l = 0u, w0h = 0u, w1l = 0u, w1h = 0u; unsigned rem = need;
#pragma unroll
    for (int p = 0; p < NREG; ++p)
#pragma unroll
        for (int hf = 0; hf < 2; ++hf) { const int j = 2 * p + hf;
            if (j < nslots) {
                const unsigned k = hf ? (kreg[p] >> 16) : (kreg[p] & 0xffffu);
                unsigned long long mg = __ballot(k > T); const unsigned long long me = __ballot(k == T);
                if (me != 0ull && rem > 0u) { const unsigned n = (unsigned)__popcll(me);
                    if (n <= rem) { mg |= me; rem -= n; }
                    else { unsigned long long t = me, s = 0ull; for (unsigned i = 0; i < rem; ++i) { const unsigned long long b = t & (0ull - t); s |= b; t ^= b; } mg |= s; rem = 0u; } }
                if (j < 64) { if (lane == j) { w0l = (unsigned)mg; w0h = (unsigned)(mg >> 32); } }
                else { if (lane == j - 64) { w1l = (unsigned)mg; w1h = (unsigned)(mg >> 32); } }
            } }
    if (lane < ntb) selp[(size_t)lane * SEQ] = ((unsigned long long)w0h << 32) | w0l;
    if (lane + 64 < ntb) selp[(size_t)(lane + 64) * SEQ] = ((unsigned long long)w1h << 32) | w1l;
}

__global__ void __launch_bounds__(NWAVES * 64, 2) mega_fwd(Args args) {
    extern __shared__ __attribute__((aligned(16))) unsigned char lds[];
    LAS unsigned char* const L = (LAS unsigned char*)lds;
    volatile LAS unsigned* const MISC = (volatile LAS unsigned*)(L + MISC_OFF);
    const int tid = threadIdx.x, lane = tid & 63, wave = __builtin_amdgcn_readfirstlane(tid >> 6);
    const int G = gridDim.x, bx = blockIdx.x;
    const int vcu = (G % 8 == 0) ? (bx % 8) * (G / 8) + bx / 8 : bx;
    unsigned char* const ws = args.ws;
    gu32* const ctl = (gu32*)(ws + WS_CTL);
    const float* const x = args.in[0]; const float* const pin = args.in[1];
    float* const out = args.out;
    bf16* const XB = (bf16*)(ws + WS_XB); float* const R = (float*)(ws + WS_R); bf16* const HB = (bf16*)(ws + WS_BIG); bf16* const PB = (bf16*)(ws + WS_PB);
    bf16* const QKVI = (bf16*)(ws + WS_QKVI); bf16* const KI = (bf16*)(ws + WS_KI); float* const WI = (float*)(ws + WS_WI); bf16* const BC = (bf16*)(ws + WS_BC); bf16* const Z = (bf16*)(ws + WS_Z);
    unsigned long long* const SEL = (unsigned long long*)(ws + WS_SEL);
    const bf16* const Qb = QKVI; const bf16* const Kb = QKVI + (size_t)M * 512; const bf16* const Vb = QKVI + (size_t)2 * M * 512; const bf16* const QIb = QKVI + (size_t)3 * M * 512;

    for (int u = tid; u < (LDS_BYTES - LDSCTL_OFF) / 4; u += NWAVES * 64) ((LAS unsigned*)(L + LDSCTL_OFF))[u] = 0u;
    __syncthreads();
    XcdBarrier bar = xcd_barrier_post((unsigned*)(ctl + CW_BAR), MISC + 8);
#define GRID_BAR() xcd_barrier(bar)
    const int gw = vcu * NWAVES + wave, NGW = G * NWAVES;

    {
        LAS float* scr = (LAS float*)(L + RING_OFF + wave * 16384);
        constexpr int I_GU = (D / 64) * (NGU / 32), I_D = (FF / 64) * (D / 32), I_IN = (D / 64) * (NIN / 32), I_SQ = (D / 64) * (D / 32), I_P = (DPLE / 64) * (D / 32);
        constexpr int NITEMS = 2 * I_GU + 2 * I_D + I_IN + 2 * I_SQ + I_P;
        for (int it = gw; it < NITEMS; it += NGW) {
            int r = it;
            if (r < 2 * I_GU) { const int f = r / I_GU; r -= f * I_GU; const int nb = r % (NGU / 32), kb = r / (NGU / 32), dn0 = 32 * nb;
                const int half = (dn0 >> 7) & 1, j0 = ((dn0 >> 8) << 7) + (dn0 & 127);
                const float* W = f ? (half ? args.in[13] : args.in[12]) : (half ? args.in[5] : args.in[4]);
                p0_transpose_item(W, D, FF, (bf16*)(ws + (f ? WS_WGU2 : WS_WGU1)), scr, 64 * kb, dn0, j0, lane); continue; }
            r -= 2 * I_GU;
            if (r < 2 * I_D) { const int f = r / I_D; r -= f * I_D; const int nb = r % (D / 32), kb = r / (D / 32);
                p0_transpose_item(f ? args.in[14] : args.in[6], FF, D, (bf16*)(ws + (f ? WS_WD2 : WS_WD1)), scr, 64 * kb, 32 * nb, 32 * nb, lane); continue; }
            r -= 2 * I_D;
            if (r < I_IN) { const int nb = r % (NIN / 32), kb = r / (NIN / 32); p0_transpose_item_win(args.in[7], (bf16*)(ws + WS_WIN), scr, 64 * kb, 32 * nb, lane); continue; }
            r -= I_IN;
            if (r < 2 * I_SQ) { const int f = r / I_SQ; r -= f * I_SQ; const int nb = r % (D / 32), kb = r / (D / 32);
                p0_transpose_item(f ? args.in[17] : args.in[9], D, D, (bf16*)(ws + (f ? WS_WGATE : WS_WOUT)), scr, 64 * kb, 32 * nb, 32 * nb, lane); continue; }
            r -= 2 * I_SQ;
            { const int nb = r % (D / 32), kb = r / (D / 32); p0_transpose_item(args.in[18], DPLE, D, (bf16*)(ws + WS_WP), scr, 64 * kb, 32 * nb, 32 * nb, lane); }
        }
        const size_t gt = (size_t)bx * (NWAVES * 64) + tid, GT = (size_t)G * NWAVES * 64;
        for (size_t i = gt; i < (size_t)M * D / 8; i += GT) { const f32x4 a = ((const GAS f32x4*)x)[2 * i], b = ((const GAS f32x4*)x)[2 * i + 1];
            v4u o; o.x = pk2(a.x, a.y); o.y = pk2(a.z, a.w); o.z = pk2(b.x, b.y); o.w = pk2(b.z, b.w); ((GAS v4u*)XB)[i] = o; }
        for (size_t i = gt; i < (size_t)M * DPLE / 8; i += GT) { const f32x4 a = ((const GAS f32x4*)pin)[2 * i], b = ((const GAS f32x4*)pin)[2 * i + 1];
            v4u o; o.x = pk2(a.x, a.y); o.y = pk2(a.z, a.w); o.z = pk2(b.x, b.y); o.w = pk2(b.z, b.w); ((GAS v4u*)PB)[i] = o; }
    }
    GRID_BAR();

    { pg8::Gemm g{XB, (const bf16*)(ws + WS_WGU1), M, NGU, D}; pg8::StaticOrder S; S.init(M, NGU, G, bx);
      pg8::EpiSwiGLU E{HB, FF};
      pg8::gemm_phase<pg8::EpiSwiGLU, pg8::StaticOrder, true, true>(L + RING_OFF, g, S, E); }
    GRID_BAR();
    { pg8::Gemm g{HB, (const bf16*)(ws + WS_WD1), M, D, FF}; pg8::StaticOrder S; S.init(M, D, G, bx);
      pg8::EpiRes E{x, R, D, DN_ALPHA, 0.5f};
      pg8::gemm_phase<pg8::EpiRes, pg8::StaticOrder, true, true>(L + RING_OFF, g, S, E); }
    GRID_BAR();
    for (int m = gw; m < M; m += NGW) ln_row(R + (size_t)m * D, args.in[2], args.in[3], out + (size_t)m * D, XB + (size_t)m * D, lane);
    GRID_BAR();
    { pg8::Gemm g{XB, (const bf16*)(ws + WS_WIN), M, NIN, D}; pg8::StaticOrder S; S.init(M, NIN, G, bx);
      pg8::EpiWin E{QKVI, KI, WI, BC, Z, M, IDX_SCALE};
      pg8::gemm_phase<pg8::EpiWin, pg8::StaticOrder, true, true>(L + RING_OFF, g, S, E); }
    GRID_BAR();

    {
        LAS unsigned short* const sc = (LAS unsigned short*)L;
        const int r32 = lane & 31, hi = lane >> 5;
        for (int un = bx; un < BATCH * (SEQ / 8); un += G) {
            const int b = un & 3, g8 = un >> 2;
            const int t0 = 8 * g8, c = t0 >> 6, nslots = c + 1, nt32 = 2 * nslots;
            const size_t rowbase = (size_t)b * SEQ;
            bf16x8 A[2][4]; float w[2][16];
            { const int hh = (r32 >> 2) & 1, i = (r32 & 3) + 4 * (r32 >> 3);
#pragma unroll
              for (int blk = 0; blk < 2; ++blk) { const bf16* src = QIb + (rowbase + t0 + 4 * blk + 2 * hh + (i >> 3)) * 512 + (i & 7) * 64 + 8 * hi;
#pragma unroll
                  for (int ks = 0; ks < 4; ++ks) A[blk][ks] = *(const GAS bf16x8*)(src + 16 * ks); }
#pragma unroll
              for (int blk = 0; blk < 2; ++blk)
#pragma unroll
                  for (int q2 = 0; q2 < 2; ++q2) { const float* wp = WI + (rowbase + t0 + 4 * blk + 2 * hi + q2) * 8; const f32x4 a = *(const GAS f32x4*)wp, bb = *(const GAS f32x4*)(wp + 4);
                      w[blk][q2 * 8 + 0] = a.x; w[blk][q2 * 8 + 1] = a.y; w[blk][q2 * 8 + 2] = a.z; w[blk][q2 * 8 + 3] = a.w; w[blk][q2 * 8 + 4] = bb.x; w[blk][q2 * 8 + 5] = bb.y; w[blk][q2 * 8 + 6] = bb.z; w[blk][q2 * 8 + 7] = bb.w; } }
            const bf16* kb = KI + rowbase * 64 + (size_t)r32 * 64 + 8 * hi;
            bf16x8 Bc[4], Bn[4];
            int kt = wave;
            if (kt < nt32) {
#pragma unroll
                for (int ks = 0; ks < 4; ++ks) Bc[ks] = *(const GAS bf16x8*)(kb + (size_t)kt * 32 * 64 + 16 * ks); }
            for (; kt < nt32; kt += NWAVES) {
                const int ktn = kt + NWAVES;
                if (ktn < nt32) {
#pragma unroll
                    for (int ks = 0; ks < 4; ++ks) Bn[ks] = *(const GAS bf16x8*)(kb + (size_t)ktn * 32 * 64 + 16 * ks); }
                f32x16 a0 = {}, a1 = {};
#pragma unroll
                for (int ks = 0; ks < 4; ++ks) { a0 = __builtin_amdgcn_mfma_f32_32x32x16_bf16(A[0][ks], Bc[ks], a0, 0, 0, 0); a1 = __builtin_amdgcn_mfma_f32_32x32x16_bf16(A[1][ks], Bc[ks], a1, 0, 0, 0); }
                const int key = 32 * kt + r32; LAS unsigned short* dst = sc + (key & 63) * 132 + (key >> 6);
#pragma unroll
                for (int q2 = 0; q2 < 2; ++q2) { float s0 = 0.f, s1 = 0.f;
#pragma unroll
                    for (int h = 0; h < 8; ++h) { s0 += w[0][q2 * 8 + h] * __builtin_fmaxf(a0[q2 * 8 + h], 0.f); s1 += w[1][q2 * 8 + h] * __builtin_fmaxf(a1[q2 * 8 + h], 0.f); }
                    dst[(2 * hi + q2) * SROW_U16] = (unsigned short)score_key(s0); dst[(4 + 2 * hi + q2) * SROW_U16] = (unsigned short)score_key(s1); }
#pragma unroll
                for (int ks = 0; ks < 4; ++ks) Bc[ks] = Bn[ks];
            }
            __syncthreads();
            {
                const int t = t0 + wave; const int ntb = 4 * ((c >> 2) + 1);
                const LAS unsigned short* rowp = sc + wave * SROW_U16 + lane * 132;
                unsigned long long* selp = SEL + (size_t)b * 128 * SEQ + t;
                if (nslots <= 32) select_emit<16>(rowp, nslots, ntb, selp, lane);
                else if (nslots <= 64) select_emit<32>(rowp, nslots, ntb, selp, lane);
                else if (nslots <= 96) select_emit<48>(rowp, nslots, ntb, selp, lane);
                else select_emit<64>(rowp, nslots, ntb, selp, lane);
            }
            __syncthreads();
        }
        { const float* cw = args.in[8]; float cwv[3][8];
#pragma unroll
          for (int j = 0; j < 3; ++j) { const f32x4 a = *(const GAS f32x4*)(cw + j * DC + 8 * lane), bb = *(const GAS f32x4*)(cw + j * DC + 8 * lane + 4);
              cwv[j][0] = a.x; cwv[j][1] = a.y; cwv[j][2] = a.z; cwv[j][3] = a.w; cwv[j][4] = bb.x; cwv[j][5] = bb.y; cwv[j][6] = bb.z; cwv[j][7] = bb.w; }
          for (int m = gw; m < M; m += NGW) { const int t = m & (SEQ - 1);
              const v4u zero = {0u, 0u, 0u, 0u};
              const v4u z2 = *(const GAS v4u*)(Z + (size_t)m * 512 + 8 * lane);
              const v4u z1 = (t >= 1) ? *(const GAS v4u*)(Z + (size_t)(m - 1) * 512 + 8 * lane) : zero;
              const v4u z0 = (t >= 2) ? *(const GAS v4u*)(Z + (size_t)(m - 2) * 512 + 8 * lane) : zero;
              const v4u bv = *(const GAS v4u*)(BC + (size_t)m * 512 + 8 * lane);
              float y[8];
#pragma unroll
              for (int e = 0; e < 4; ++e) { y[2 * e] = bf_lo(bv[e]) * (cwv[0][2 * e] * bf_lo(z0[e]) + cwv[1][2 * e] * bf_lo(z1[e]) + cwv[2][2 * e] * bf_lo(z2[e]));
                  y[2 * e + 1] = bf_hi(bv[e]) * (cwv[0][2 * e + 1] * bf_hi(z0[e]) + cwv[1][2 * e + 1] * bf_hi(z1[e]) + cwv[2][2 * e + 1] * bf_hi(z2[e])); }
              v4u o; o.x = pk2(y[0], y[1]); o.y = pk2(y[2], y[3]); o.z = pk2(y[4], y[5]); o.w = pk2(y[6], y[7]);
              *(GAS v4u*)(XB + (size_t)m * D + DA + 8 * lane) = o; } }
    }
    GRID_BAR();

    {
        const int h = bx & 7, wx = (bx >> 3) * NWAVES + wave, NWX = (G >> 3) * NWAVES;
        LAS unsigned short* const list = (LAS unsigned short*)(L + wave * 512);
        const float slope2 = __builtin_amdgcn_exp2f(-(float)(h + 1)) * LOG2E;
        const int kk = lane >> 3, part = lane & 7;
        for (int b = 0; b < BATCH; ++b)
            for (int t = wx; t < SEQ; t += NWX) {
                const int nslots = (t >> 6) + 1; const int n = nslots * 64 < TOPK ? nslots * 64 : TOPK;
                const size_t rowbase = (size_t)b * SEQ;
                const unsigned long long* selp = SEL + (size_t)b * 128 * SEQ + t;
                unsigned long long w0 = (lane < nslots) ? selp[(size_t)lane * SEQ] : 0ull, w1 = (lane + 64 < nslots) ? selp[(size_t)(lane + 64) * SEQ] : 0ull;
                const int cnt = __popcll(w0) + __popcll(w1); int incl = cnt;
#pragma unroll
                for (int d = 1; d < 64; d <<= 1) { const int v = __shfl_up(incl, d); if (lane >= d) incl += v; }
                int pos = incl - cnt;
                while (w0) { const int bp = __ffsll((long long)w0) - 1; if (pos < TOPK) list[pos] = (unsigned short)(lane * 64 + bp); ++pos; w0 &= w0 - 1ull; }
                while (w1) { const int bp = __ffsll((long long)w1) - 1; if (pos < TOPK) list[pos] = (unsigned short)((lane + 64) * 64 + bp); ++pos; w1 &= w1 - 1ull; }
                LDS_WAIT();
                float q[8];
                { const v4u qv = *(const GAS v4u*)(Qb + (rowbase + t) * 512 + h * 64 + 8 * part); const float sc2 = 0.125f * LOG2E;
#pragma unroll
                  for (int e = 0; e < 4; ++e) { q[2 * e] = bf_lo(qv[e]) * sc2; q[2 * e + 1] = bf_hi(qv[e]) * sc2; } }
                float mrun = -INFINITY, lrun = 0.f, o[8];
#pragma unroll
                for (int e = 0; e < 8; ++e) o[e] = 0.f;
                const bf16* Kh = Kb + rowbase * 512 + h * 64 + 8 * part; const bf16* Vh = Vb + rowbase * 512 + h * 64 + 8 * part;
                for (int i = 0; i < n; i += 32) {
                    int key[4]; v4u kv[4], vv[4];
#pragma unroll
                    for (int u = 0; u < 4; ++u) key[u] = list[i + 8 * u + kk];
#pragma unroll
                    for (int u = 0; u < 4; ++u) { kv[u] = *(const GAS v4u*)(Kh + (size_t)key[u] * 512); vv[u] = *(const GAS v4u*)(Vh + (size_t)key[u] * 512); }
#pragma unroll
                    for (int u = 0; u < 4; ++u) {
                        float d = 0.f;
#pragma unroll
                        for (int e = 0; e < 4; ++e) d += q[2 * e] * bf_lo(kv[u][e]) + q[2 * e + 1] * bf_hi(kv[u][e]);
                        d += __shfl_xor(d, 1); d += __shfl_xor(d, 2); d += __shfl_xor(d, 4);
                        const int dist = t - key[u]; const float lg = d - slope2 * (float)(dist < 0 ? -dist : dist);
                        const float mn = __builtin_fmaxf(mrun, lg), al = __builtin_amdgcn_exp2f(mrun - mn), pp = __builtin_amdgcn_exp2f(lg - mn);
                        lrun = lrun * al + pp; mrun = mn;
#pragma unroll
                        for (int e = 0; e < 4; ++e) { o[2 * e] = o[2 * e] * al + pp * bf_lo(vv[u][e]); o[2 * e + 1] = o[2 * e + 1] * al + pp * bf_hi(vv[u][e]); }
                    }
                }
#pragma unroll
                for (int d = 8; d < 64; d <<= 1) { const float mo = __shfl_xor(mrun, d), lo_ = __shfl_xor(lrun, d); const float mn = __builtin_fmaxf(mrun, mo), a = __builtin_amdgcn_exp2f(mrun - mn), bsc = __builtin_amdgcn_exp2f(mo - mn);
                    lrun = lrun * a + lo_ * bsc;
#pragma unroll
                    for (int e = 0; e < 8; ++e) { const float oo = __shfl_xor(o[e], d); o[e] = o[e] * a + oo * bsc; }
                    mrun = mn; }
                if (kk == 0) { const float rl = 1.0f / lrun; v4u ov; ov.x = pk2(o[0] * rl, o[1] * rl); ov.y = pk2(o[2] * rl, o[3] * rl); ov.z = pk2(o[4] * rl, o[5] * rl); ov.w = pk2(o[6] * rl, o[7] * rl);
                    *(GAS v4u*)(XB + (rowbase + t) * D + h * 64 + 8 * part) = ov; }
                LDS_WAIT();
            }
    }
    GRID_BAR();

    { pg8::Gemm g{XB, (const bf16*)(ws + WS_WOUT), M, D, D}; pg8::StaticOrder S; S.init(M, D, G, bx);
      pg8::EpiRes E{out, R, D, DN_ALPHA, 1.0f};
      pg8::gemm_phase<pg8::EpiRes, pg8::StaticOrder, true, true>(L + RING_OFF, g, S, E); }
    GRID_BAR();
    for (int m = gw; m < M; m += NGW) ln_row(R + (size_t)m * D, args.in[10], args.in[11], out + (size_t)m * D, XB + (size_t)m * D, lane);
    GRID_BAR();
    { pg8::Gemm g{XB, (const bf16*)(ws + WS_WGU2), M, NGU, D}; pg8::StaticOrder S; S.init(M, NGU, G, bx);
      pg8::EpiSwiGLU E{HB, FF};
      pg8::gemm_phase<pg8::EpiSwiGLU, pg8::StaticOrder, true, true>(L + RING_OFF, g, S, E); }
    GRID_BAR();
    { pg8::Gemm g{HB, (const bf16*)(ws + WS_WD2), M, D, FF}; pg8::StaticOrder S; S.init(M, D, G, bx);
      pg8::EpiRes E{out, R, D, DN_ALPHA, 0.5f};
      pg8::gemm_phase<pg8::EpiRes, pg8::StaticOrder, true, true>(L + RING_OFF, g, S, E); }
    GRID_BAR();
    for (int m = gw; m < M; m += NGW) ln_row(R + (size_t)m * D, args.in[15], args.in[16], out + (size_t)m * D, XB + (size_t)m * D, lane);
    GRID_BAR();
    { pg8::Gemm g{PB, (const bf16*)(ws + WS_WP), M, D, DPLE}; pg8::StaticOrder S; S.init(M, D, G, bx);
      pg8::EpiF32 E{R, D};
      pg8::gemm_phase<pg8::EpiF32, pg8::StaticOrder, true, true>(L + RING_OFF, g, S, E); }
    { pg8::Gemm g{XB, (const bf16*)(ws + WS_WGATE), M, D, D}; pg8::StaticOrder S; S.init(M, D, G, bx);
      pg8::EpiGate E{out, R, out, D};
      pg8::gemm_phase<pg8::EpiGate, pg8::StaticOrder, true, true>(L + RING_OFF, g, S, E); }
}

extern "C" void kernel_launch(void* const* d_in, const int* in_sizes, int n_in, void* d_out, int out_size, void* d_ws, size_t ws_size, hipStream_t stream) {
    static int grid = 0;
    if (grid == 0) {
        if (n_in != 19 || in_sizes[0] != M * D || out_size != M * D || ws_size < WS_END) { fprintf(stderr, "kernel_launch: unexpected problem (n_in %d, in0 %d, out %d, ws %zu < %zu); nothing launched\n", n_in, n_in > 0 ? in_sizes[0] : -1, out_size, ws_size, (size_t)WS_END); grid = -1; return; }
        int dev = 0, cus = 0, per_cu = 0;
        if (hipGetDevice(&dev) != hipSuccess || hipDeviceGetAttribute(&cus, hipDeviceAttributeMultiprocessorCount, dev) != hipSuccess) { fprintf(stderr, "kernel_launch: device query failed\n"); grid = -1; return; }
        if (hipFuncSetAttribute((const void*)mega_fwd, hipFuncAttributeMaxDynamicSharedMemorySize, LDS_BYTES) != hipSuccess) { fprintf(stderr, "kernel_launch: hipFuncSetAttribute failed\n"); grid = -1; return; }
        if (hipOccupancyMaxActiveBlocksPerMultiprocessor(&per_cu, (const void*)mega_fwd, NWAVES * 64, LDS_BYTES) != hipSuccess || per_cu < 1) { fprintf(stderr, "kernel_launch: occupancy query says %d workgroups per CU\n", per_cu); }
        (void)hipGetLastError();
        grid = cus;
        if (grid % 8 != 0 || grid < 8) { fprintf(stderr, "kernel_launch: CU count %d is not a multiple of 8\n", grid); grid = -1; return; }
    }
    if (grid < 0) return;
    if (hipMemsetAsync((char*)d_ws + WS_CTL, 0, CTL_ZERO_BYTES, stream) != hipSuccess) { fprintf(stderr, "kernel_launch: memset failed\n"); return; }
    Args a{};
    for (int i = 0; i < 19; ++i) a.in[i] = (const float*)d_in[i];
    a.out = (float*)d_out; a.ws = (unsigned char*)d_ws;
    hipLaunchKernelGGL(mega_fwd, dim3(grid), dim3(NWAVES * 64), LDS_BYTES, stream, a);
}
```

```cpp
#include <hip/hip_runtime.h>
#include <hip/hip_bf16.h>
#include <cmath>
#include <cstdio>
#include <cstdint>
namespace pg8 {
#define PG8_LAS __attribute__((address_space(3)))
typedef unsigned short bf16_t;
typedef short bf16x8 __attribute__((ext_vector_type(8)));
typedef float f32x4 __attribute__((ext_vector_type(4)));
typedef unsigned u32x4 __attribute__((ext_vector_type(4)));
constexpr int BM = 256, BK = 64, HALF = 128, HTB = HALF * BK * 2  , STAGE_BYTES = 8 * HTB, NXCD = 8, WGM = 8;

__host__ __device__ __forceinline__ int lds_byte(int r, int c) { const int st = (r >> 4) * 2 + (c >> 5), rr = r & 15, cc = c & 31, ob = rr * 64 + cc * 2; return st * 1024 + (ob ^ (((ob >> 9) & 1) << 5)); }
__host__ __device__ __forceinline__ void stage_rc(int b, int& R, int& C) { const int st = b / 1024, sb = b % 1024, swz = sb ^ (((sb >> 9) & 1) << 5); R = (st >> 1) * 16 + swz / 64; C = (st & 1) * 32 + (swz % 64) / 2; }
__host__ __device__ __forceinline__ int perm32(int rho) { const int n = rho >> 4, i = rho & 15; return 8 * (i >> 2) + 4 * n + (i & 3); }

struct Unit { int pm, pn; };
struct Gemm { const bf16_t* A; const bf16_t* Bt; int M, N, K; };

struct StaticOrder {
    int nM, nN, nwg, G, c;
    __host__ __device__ void init(int M, int N, int G_, int c_) { nM = M / BM; nN = N / BM; nwg = nM * nN; G = G_; c = c_; }
    __host__ __device__ bool next(int i, Unit& u) const {
        const long L = (long)i * G + c; if (L >= nwg) return false;
        int wgid = (int)L; { const int q = nwg / NXCD, r = nwg % NXCD, xcd = wgid % NXCD, off = wgid / NXCD; wgid = (xcd < r ? xcd * (q + 1) : r * (q + 1) + (xcd - r) * q) + off; }
        const int nig = WGM * nN, gid = wgid / nig, fm = gid * WGM, gsz = (nM - fm) < WGM ? (nM - fm) : WGM;
        u.pm = fm + ((wgid % nig) % gsz); u.pn = (wgid % nig) / gsz; return true;
    }
    __device__ __forceinline__ void a_ready(const Unit&) const {}
    __device__ __forceinline__ void done(const Unit&) const {}
};

__device__ __forceinline__ unsigned cvt_pk_bf16(float lo, float hi) { unsigned r; asm volatile("v_cvt_pk_bf16_f32 %0, %1, %2" : "=v"(r) : "v"(lo), "v"(hi)); return r; }
__device__ __forceinline__ float silu_mul(float g, float u) { return g * __builtin_amdgcn_rcpf(1.0f + __builtin_amdgcn_exp2f(-1.4426950408889634f * g)) * u; }
__device__ __forceinline__ float sigmoidf_(float g) { return __builtin_amdgcn_rcpf(1.0f + __builtin_amdgcn_exp2f(-1.4426950408889634f * g)); }

struct EpiSwiGLU {
    static constexpr bool PERM = true, AFTER_DRAIN = false;
    bf16_t* H; int ldh;
    __device__ __forceinline__ void operator()(const f32x4 (&acc)[2][2][4][2], const Unit& u, int wr, int wc, int fr, int fq) const {
        const int row0 = u.pm * BM + wr * 64 + fr, col0 = u.pn * HALF + wc * 32 + 8 * fq;
#pragma unroll
        for (int ai = 0; ai < 2; ++ai)
#pragma unroll
            for (int m = 0; m < 4; ++m) { bf16_t* rowp = H + (size_t)(row0 + ai * HALF + m * 16) * ldh + col0;
                const f32x4 g0 = acc[ai][0][m][0], g1 = acc[ai][0][m][1], u0 = acc[ai][1][m][0], u1 = acc[ai][1][m][1];
                u32x4 w; w.x = cvt_pk_bf16(silu_mul(g0[0], u0[0]), silu_mul(g0[1], u0[1])); w.y = cvt_pk_bf16(silu_mul(g0[2], u0[2]), silu_mul(g0[3], u0[3]));
                w.z = cvt_pk_bf16(silu_mul(g1[0], u1[0]), silu_mul(g1[1], u1[1])); w.w = cvt_pk_bf16(silu_mul(g1[2], u1[2]), silu_mul(g1[3], u1[3]));
                *(u32x4*)rowp = w; }
    }
};
struct EpiRes {
    static constexpr bool PERM = false, AFTER_DRAIN = false;
    const float* base; float* out; int ldc; float alpha, s;
    __device__ __forceinline__ void operator()(const f32x4 (&acc)[2][2][4][2], const Unit& u, int wr, int wc, int fr, int fq) const {
        const int row0 = u.pm * BM + wr * 64 + fr, col0 = u.pn * BM + wc * 32 + 4 * fq;
#pragma unroll
        for (int ai = 0; ai < 2; ++ai)
#pragma unroll
            for (int m = 0; m < 4; ++m) { const size_t off = (size_t)(row0 + ai * HALF + m * 16) * ldc + col0;
#pragma unroll
                for (int bj = 0; bj < 2; ++bj)
#pragma unroll
                    for (int n = 0; n < 2; ++n) { const f32x4 bs = *(const f32x4*)(base + off + bj * HALF + n * 16); *(f32x4*)(out + off + bj * HALF + n * 16) = bs * alpha + acc[ai][bj][m][n] * s; } }
    }
};
struct EpiF32 {
    static constexpr bool PERM = false, AFTER_DRAIN = false;
    float* out; int ldc;
    __device__ __forceinline__ void operator()(const f32x4 (&acc)[2][2][4][2], const Unit& u, int wr, int wc, int fr, int fq) const {
        const int row0 = u.pm * BM + wr * 64 + fr, col0 = u.pn * BM + wc * 32 + 4 * fq;
#pragma unroll
        for (int ai = 0; ai < 2; ++ai)
#pragma unroll
            for (int m = 0; m < 4; ++m) { const size_t off = (size_t)(row0 + ai * HALF + m * 16) * ldc + col0;
#pragma unroll
                for (int bj = 0; bj < 2; ++bj)
#pragma unroll
                    for (int n = 0; n < 2; ++n) *(f32x4*)(out + off + bj * HALF + n * 16) = acc[ai][bj][m][n]; }
    }
};
struct EpiGate {
    static constexpr bool PERM = false, AFTER_DRAIN = false;
    const float* xin; const float* pp; float* out; int ldc;
    __device__ __forceinline__ void operator()(const f32x4 (&acc)[2][2][4][2], const Unit& u, int wr, int wc, int fr, int fq) const {
        const int row0 = u.pm * BM + wr * 64 + fr, col0 = u.pn * BM + wc * 32 + 4 * fq;
#pragma unroll
        for (int ai = 0; ai < 2; ++ai)
#pragma unroll
            for (int m = 0; m < 4; ++m) { const size_t off = (size_t)(row0 + ai * HALF + m * 16) * ldc + col0;
#pragma unroll
                for (int bj = 0; bj < 2; ++bj)
#pragma unroll
                    for (int n = 0; n < 2; ++n) { const f32x4 xv = *(const f32x4*)(xin + off + bj * HALF + n * 16), pv = *(const f32x4*)(pp + off + bj * HALF + n * 16), a = acc[ai][bj][m][n];
                        f32x4 o; o[0] = xv[0] + sigmoidf_(a[0]) * pv[0]; o[1] = xv[1] + sigmoidf_(a[1]) * pv[1]; o[2] = xv[2] + sigmoidf_(a[2]) * pv[2]; o[3] = xv[3] + sigmoidf_(a[3]) * pv[3];
                        *(f32x4*)(out + off + bj * HALF + n * 16) = o; } }
    }
};
struct EpiWin {
    static constexpr bool PERM = true, AFTER_DRAIN = false;
    bf16_t* qkvi;
    bf16_t* ki;
    float* wi;
    bf16_t* bc;
    bf16_t* z;
    int M; float idx_scale, qscale;
    __device__ __forceinline__ void operator()(const f32x4 (&acc)[2][2][4][2], const Unit& u, int wr, int wc, int fr, int fq) const {
        const int row0 = u.pm * BM + wr * 64 + fr, cw = wc * 32 + 8 * fq; const int pn = u.pn;
        if (pn >= 11) {
#pragma unroll
            for (int ai = 0; ai < 2; ++ai)
#pragma unroll
                for (int m = 0; m < 4; ++m) { bf16_t* rowp = z + (size_t)(row0 + ai * HALF + m * 16) * 512 + (pn - 11) * HALF + cw;
                    const f32x4 g0 = acc[ai][0][m][0], g1 = acc[ai][0][m][1], u0 = acc[ai][1][m][0], u1 = acc[ai][1][m][1];
                    u32x4 w; w.x = cvt_pk_bf16(g0[0] * u0[0], g0[1] * u0[1]); w.y = cvt_pk_bf16(g0[2] * u0[2], g0[3] * u0[3]); w.z = cvt_pk_bf16(g1[0] * u1[0], g1[1] * u1[1]); w.w = cvt_pk_bf16(g1[2] * u1[2], g1[3] * u1[3]);
                    *(u32x4*)rowp = w; }
        } else if (pn == 8) {
            if (wc < 2) {
#pragma unroll
                for (int ai = 0; ai < 2; ++ai)
#pragma unroll
                    for (int m = 0; m < 4; ++m) { bf16_t* rowp = ki + (size_t)(row0 + ai * HALF + m * 16) * 64 + cw; const f32x4 v0 = acc[ai][0][m][0], v1 = acc[ai][0][m][1];
                        u32x4 w; w.x = cvt_pk_bf16(v0[0], v0[1]); w.y = cvt_pk_bf16(v0[2], v0[3]); w.z = cvt_pk_bf16(v1[0], v1[1]); w.w = cvt_pk_bf16(v1[2], v1[3]); *(u32x4*)rowp = w; }
            } else if (wc == 2 && fq == 0) {
#pragma unroll
                for (int ai = 0; ai < 2; ++ai)
#pragma unroll
                    for (int m = 0; m < 4; ++m) { float* rowp = wi + (size_t)(row0 + ai * HALF + m * 16) * 8; *(f32x4*)rowp = acc[ai][0][m][0] * idx_scale; *(f32x4*)(rowp + 4) = acc[ai][0][m][1] * idx_scale; }
            }
        } else {
            bf16_t* base; int colt; const float sc = (pn < 2) ? qscale : 1.0f;
            if (pn < 8) { base = qkvi + (size_t)(pn >> 1) * M * 512; colt = (pn & 1) * BM; } else { base = bc; colt = (pn - 9) * BM; }
#pragma unroll
            for (int ai = 0; ai < 2; ++ai)
#pragma unroll
                for (int m = 0; m < 4; ++m) { bf16_t* rowp = base + (size_t)(row0 + ai * HALF + m * 16) * 512 + colt + cw;
#pragma unroll
                    for (int bj = 0; bj < 2; ++bj) { const f32x4 v0 = acc[ai][bj][m][0] * sc, v1 = acc[ai][bj][m][1] * sc;
                        u32x4 w; w.x = cvt_pk_bf16(v0[0], v0[1]); w.y = cvt_pk_bf16(v0[2], v0[3]); w.z = cvt_pk_bf16(v1[0], v1[1]); w.w = cvt_pk_bf16(v1[2], v1[3]); *(u32x4*)(rowp + bj * HALF) = w; } }
        }
    }
};

template <class Epi, class Sched, bool ALIGN_EPI = false, bool SP2 = false>
__device__ __forceinline__ void gemm_phase(PG8_LAS unsigned char* lds, const Gemm g, const Sched& S, const Epi& E) {
    int tid_ = threadIdx.x; asm volatile("" : "+v"(tid_));
    const int tid = tid_, wid = __builtin_amdgcn_readfirstlane(tid >> 6), lane = tid & 63, wr = wid >> 2, wc = wid & 3, fr = lane & 15, fq = lane >> 4;
    const int K = g.K, nt = K / BK;
    unsigned voffA[2], voffB[2];
#pragma unroll
    for (int i = 0; i < 2; ++i) { int R, C; stage_rc(tid * 16 + i * 8192, R, C); const int Rb = Epi::PERM ? ((R & ~31) + perm32(R & 31)) : R;
        voffA[i] = (unsigned)(R * K + C) * 2u; voffB[i] = (unsigned)(Rb * K + C) * 2u; }
    const size_t kstep = (size_t)(BK * 2);
    const size_t hstep = (size_t)HALF * K * 2;
    const size_t tstep = 2 * hstep;
    const unsigned ldsw = (unsigned)wid * 1024u;
    const int aoff = lds_byte(wr * 64 + fr, fq * 8), boff = lds_byte(wc * 32 + fr, fq * 8);
#define PG8_SA(b, h) (((b) * 2 + (h)) * HTB)
#define PG8_SB(b, h) ((4 + (b) * 2 + (h)) * HTB)
#define PG8_STAGE(bufoff, gbase, voff) do { _Pragma("unroll") for (int _i = 0; _i < 2; ++_i) \
        __builtin_amdgcn_global_load_lds((const unsigned*)((const char*)(gbase) + (voff)[_i]), (PG8_LAS unsigned*)(lds + (bufoff) + ldsw + _i * 8192), 16, 0, 0); } while (0)
#define PG8_LDA(dst, b, h) do { _Pragma("unroll") for (int m = 0; m < 4; ++m) _Pragma("unroll") for (int k = 0; k < 2; ++k) dst[m][k] = *(const PG8_LAS bf16x8*)(lds + PG8_SA(b, h) + aoff + m * 2048 + k * 1024); } while (0)
#define PG8_LDB(dst, b, h) do { _Pragma("unroll") for (int n = 0; n < 2; ++n) _Pragma("unroll") for (int k = 0; k < 2; ++k) dst[n][k] = *(const PG8_LAS bf16x8*)(lds + PG8_SB(b, h) + boff + n * 2048 + k * 1024); } while (0)
#define PG8_MMA(ai, bj, At, Bt) do { __builtin_amdgcn_s_setprio(1); _Pragma("unroll") for (int m = 0; m < 4; ++m) _Pragma("unroll") for (int n = 0; n < 2; ++n) _Pragma("unroll") for (int k = 0; k < 2; ++k) \
        acc[ai][bj][m][n] = __builtin_amdgcn_mfma_f32_16x16x32_bf16(Bt[n][k], At[m][k], acc[ai][bj][m][n], 0, 0, 0); __builtin_amdgcn_s_setprio(0); } while (0)
#define PG8_WAIT_V(n) asm volatile("s_waitcnt vmcnt(" #n ")" ::: "memory")
#define PG8_WAIT_L(n) asm volatile("s_waitcnt lgkmcnt(" #n ")" ::: "memory")
#define PG8_BAR __builtin_amdgcn_s_barrier()
#define PG8_SCHED __builtin_amdgcn_sched_barrier(0)
    Unit cur, nxt; int ui = 0;
    if (!S.next(0, cur)) return;
    f32x4 acc[2][2][4][2];
#pragma unroll
    for (int a = 0; a < 2; ++a)
#pragma unroll
        for (int b = 0; b < 2; ++b)
#pragma unroll
            for (int m = 0; m < 4; ++m)
#pragma unroll
                for (int n = 0; n < 2; ++n) acc[a][b][m][n] = (f32x4){0.f, 0.f, 0.f, 0.f};
    bf16x8 At[4][2], B0[2][2], B1[2][2];
    const char* cA = (const char*)g.A + (size_t)cur.pm * tstep; const char* cB = (const char*)g.Bt + (size_t)cur.pn * tstep;
    S.a_ready(cur);
    if constexpr (SP2) {
        PG8_STAGE(PG8_SB(0, 0), cB, voffB); PG8_STAGE(PG8_SB(0, 1), cB + hstep, voffB); PG8_STAGE(PG8_SA(0, 0), cA, voffA); PG8_STAGE(PG8_SA(0, 1), cA + hstep, voffA);
        if (wr == 1) PG8_BAR;
        PG8_WAIT_V(2); PG8_BAR;
        PG8_STAGE(PG8_SB(1, 0), cB + kstep, voffB); PG8_STAGE(PG8_SA(1, 0), cA + kstep, voffA); PG8_STAGE(PG8_SB(1, 1), cB + hstep + kstep, voffB);
        PG8_WAIT_V(6); PG8_BAR;
    } else {
        PG8_STAGE(PG8_SB(0, 0), cB, voffB); PG8_STAGE(PG8_SA(0, 0), cA, voffA); PG8_STAGE(PG8_SB(0, 1), cB + hstep, voffB); PG8_STAGE(PG8_SA(0, 1), cA + hstep, voffA);
        if (wr == 1) PG8_BAR;
        PG8_WAIT_V(4); PG8_BAR;
        PG8_STAGE(PG8_SB(1, 0), cB + kstep, voffB); PG8_STAGE(PG8_SA(1, 0), cA + kstep, voffA); PG8_STAGE(PG8_SB(1, 1), cB + hstep + kstep, voffB);
        PG8_WAIT_V(6); PG8_BAR;
    }
    for (;;) {
        const bool has_next = S.next(ui + 1, nxt);
        const char* nA = has_next ? (const char*)g.A + (size_t)nxt.pm * tstep : cA; const char* nB = has_next ? (const char*)g.Bt + (size_t)nxt.pn * tstep : cB;
        for (int t = 0; t < nt; t += 2) {
            const bool last = (t == nt - 2);
            const char* a1 = cA + (size_t)(t + 1) * kstep;
            const char* a2 = last ? nA : cA + (size_t)(t + 2) * kstep; const char* b2 = last ? nB : cB + (size_t)(t + 2) * kstep;
            const char* a3 = a2 + kstep; const char* b3 = b2 + kstep;
            if (last && has_next) S.a_ready(nxt);
            if constexpr (SP2) {
            PG8_LDB(B0, 0, 0); PG8_LDB(B1, 0, 1); PG8_SCHED; PG8_LDA(At, 0, 0); PG8_STAGE(PG8_SA(1, 1), a1 + hstep, voffA);
            PG8_WAIT_V(8); PG8_WAIT_L(0); PG8_BAR; PG8_MMA(0, 0, At, B0); PG8_MMA(0, 1, At, B1); PG8_BAR; PG8_SCHED;
            PG8_LDA(At, 0, 1); PG8_STAGE(PG8_SB(0, 0), b2, voffB); PG8_STAGE(PG8_SB(0, 1), b2 + hstep, voffB); PG8_STAGE(PG8_SA(0, 0), a2, voffA);
            PG8_WAIT_V(8); PG8_WAIT_L(0); PG8_BAR; PG8_MMA(1, 0, At, B0); PG8_MMA(1, 1, At, B1); PG8_BAR; PG8_SCHED;
            PG8_LDB(B0, 1, 0); PG8_LDB(B1, 1, 1); PG8_SCHED; PG8_LDA(At, 1, 0); PG8_STAGE(PG8_SA(0, 1), a2 + hstep, voffA);
            PG8_WAIT_V(8); PG8_WAIT_L(0); PG8_BAR; PG8_MMA(0, 0, At, B0); PG8_MMA(0, 1, At, B1); PG8_BAR; PG8_SCHED;
            PG8_LDA(At, 1, 1); PG8_STAGE(PG8_SB(1, 0), b3, voffB); PG8_STAGE(PG8_SB(1, 1), b3 + hstep, voffB); PG8_STAGE(PG8_SA(1, 0), a3, voffA);
            PG8_WAIT_V(8); PG8_WAIT_L(0); PG8_BAR; PG8_MMA(1, 0, At, B0); PG8_MMA(1, 1, At, B1); PG8_BAR; PG8_SCHED;
            } else {
            PG8_LDB(B0, 0, 0); PG8_SCHED; PG8_LDA(At, 0, 0); PG8_STAGE(PG8_SA(1, 1), a1 + hstep, voffA);
            PG8_WAIT_L(8); PG8_BAR; PG8_WAIT_L(0); PG8_MMA(0, 0, At, B0); PG8_BAR; PG8_SCHED;
            PG8_LDB(B1, 0, 1); PG8_STAGE(PG8_SB(0, 0), b2, voffB);
            PG8_BAR; PG8_WAIT_L(0); PG8_MMA(0, 1, At, B1); PG8_BAR;
            PG8_LDA(At, 0, 1); PG8_STAGE(PG8_SA(0, 0), a2, voffA);
            PG8_BAR; PG8_WAIT_L(0); PG8_MMA(1, 0, At, B0); PG8_BAR; PG8_SCHED;
            PG8_STAGE(PG8_SB(0, 1), b2 + hstep, voffB);
            PG8_WAIT_V(6); PG8_BAR; PG8_MMA(1, 1, At, B1); PG8_BAR;
            PG8_LDB(B0, 1, 0); PG8_SCHED; PG8_LDA(At, 1, 0); PG8_STAGE(PG8_SA(0, 1), a2 + hstep, voffA);
            PG8_WAIT_L(8); PG8_BAR; PG8_WAIT_L(0); PG8_MMA(0, 0, At, B0); PG8_BAR; PG8_SCHED;
            PG8_LDB(B1, 1, 1); PG8_STAGE(PG8_SB(1, 0), b3, voffB);
            PG8_BAR; PG8_WAIT_L(0); PG8_MMA(0, 1, At, B1); PG8_BAR;
            PG8_LDA(At, 1, 1); PG8_STAGE(PG8_SA(1, 0), a3, voffA);
            PG8_BAR; PG8_WAIT_L(0); PG8_MMA(1, 0, At, B0); PG8_BAR; PG8_SCHED;
            PG8_STAGE(PG8_SB(1, 1), b3 + hstep, voffB);
            PG8_WAIT_V(6); PG8_BAR; PG8_MMA(1, 1, At, B1); PG8_BAR;
            }
        }
        if constexpr (ALIGN_EPI) { if (wr == 0) PG8_BAR; }
        if constexpr (!Epi::AFTER_DRAIN) { E(acc, cur, wr, wc, fr, fq); S.done(cur); }
        if (!has_next) break;
#pragma unroll
        for (int a = 0; a < 2; ++a)
#pragma unroll
            for (int b = 0; b < 2; ++b)
#pragma unroll
                for (int m = 0; m < 4; ++m)
#pragma unroll
                    for (int n = 0; n < 2; ++n) acc[a][b][m][n] = (f32x4){0.f, 0.f, 0.f, 0.f};
        cur = nxt; cA = nA; cB = nB; ++ui;
        if constexpr (ALIGN_EPI) { if (wr == 1) PG8_BAR; }
    }
    PG8_WAIT_V(0);
    if constexpr (!ALIGN_EPI) { if (wr == 0) PG8_BAR; }
    PG8_BAR;
    if constexpr (Epi::AFTER_DRAIN) { E.fused(acc, cur, wr, wc, fr, fq, lds, wid, lane); S.done(cur); }
#undef PG8_SA
#undef PG8_SB
#undef PG8_STAGE
#undef PG8_LDA
#undef PG8_LDB
#undef PG8_MMA
#undef PG8_WAIT_V
#undef PG8_WAIT_L
#undef PG8_BAR
#undef PG8_SCHED
}
}

#ifndef PROBE_CHECK
#define PROBE_CHECK 0
#endif
#define REP_P5 1
#define SPARSE_ATTN 0
#define REP_P6 1

constexpr int NWAVES = 8;
constexpr int BATCH = 4, SEQ = 8192, D = 1024, FF = 2816, DPLE = 256, NHEAD = 8, HD = 64, DA = 512, DC = 512;
constexpr int M = BATCH * SEQ;
constexpr int NGU = 2 * FF;
constexpr int NIN = 3840;
constexpr float LN_EPS = 1e-5f;
constexpr float DN_ALPHA = 1.189207115002721f;
constexpr float IDX_SCALE = 0.04419417382415922f;
constexpr int TOPK = 256;
constexpr float LOG2E = 1.4426950408889634f;

constexpr size_t MiB = 1u << 20;
constexpr size_t WS_CTL = 0, CTL_ZERO_BYTES = 1 * MiB;
constexpr size_t WS_WGU1 = 2 * MiB, WS_WD1 = 13 * MiB, WS_WIN = 19 * MiB, WS_WOUT = 27 * MiB, WS_WGU2 = 29 * MiB, WS_WD2 = 40 * MiB, WS_WGATE = 46 * MiB, WS_WP = 48 * MiB;
constexpr size_t WS_XB = 64 * MiB;
constexpr size_t WS_R = 128 * MiB;
constexpr size_t WS_BIG = 256 * MiB;
constexpr size_t WS_QKVI = WS_BIG, WS_KI = WS_BIG + 128 * MiB, WS_WI = WS_BIG + 132 * MiB, WS_BC = WS_BIG + 136 * MiB, WS_Z = WS_BIG + 168 * MiB, WS_SEL = WS_BIG + 200 * MiB;
constexpr size_t WS_PB = 496 * MiB;
constexpr size_t WS_END = 512 * MiB;
static_assert(WS_WGU1 + (size_t)NGU * D * 2 <= WS_WD1 && WS_WD1 + (size_t)D * FF * 2 <= WS_WIN && WS_WIN + (size_t)NIN * D * 2 <= WS_WOUT && WS_WOUT + (size_t)D * D * 2 <= WS_WGU2 && WS_WGU2 + (size_t)NGU * D * 2 <= WS_WD2 &&
              WS_WD2 + (size_t)D * FF * 2 <= WS_WGATE && WS_WGATE + (size_t)D * D * 2 <= WS_WP && WS_WP + (size_t)D * DPLE * 2 <= WS_XB, "weight map");
static_assert(WS_XB + (size_t)M * D * 2 <= WS_R && WS_R + (size_t)M * D * 4 <= WS_BIG && WS_BIG + (size_t)M * FF * 2 <= WS_PB && WS_SEL + (size_t)BATCH * 128 * SEQ * 8 <= WS_PB && WS_PB + (size_t)M * DPLE * 2 <= WS_END, "d_ws map");
constexpr int CW_BAR = 4096;

constexpr int RING_OFF = 0, RING_BYTES = 131072;
constexpr int SROW_U16 = 64 * 132;
constexpr int SC_BYTES = 8 * SROW_U16 * 2;
constexpr int LDSCTL_OFF = 139264, MISC_OFF = LDSCTL_OFF + 320;
constexpr int LDS_BYTES = 147456;
static_assert(SC_BYTES <= LDSCTL_OFF && RING_BYTES <= LDSCTL_OFF && MISC_OFF + 128 <= LDS_BYTES, "LDS map");

#define GAS __attribute__((address_space(1)))
#define LAS __attribute__((address_space(3)))
typedef unsigned short bf16;
typedef unsigned v4u __attribute__((ext_vector_type(4)));
typedef unsigned v2u __attribute__((ext_vector_type(2)));
typedef float f32x4 __attribute__((ext_vector_type(4)));
typedef float f32x16 __attribute__((ext_vector_type(16)));
typedef short bf16x8 __attribute__((ext_vector_type(8)));
typedef unsigned short u16x2 __attribute__((ext_vector_type(2)));
typedef GAS unsigned gu32;
#define RLX_AGENT __ATOMIC_RELAXED, __HIP_MEMORY_SCOPE_AGENT
#define LDS_WAIT() asm volatile("s_waitcnt lgkmcnt(0)" ::: "memory")
#define VM_WAIT() asm volatile("s_waitcnt vmcnt(0)" ::: "memory")
__device__ __forceinline__ unsigned f2bf(float f) { unsigned u = __builtin_bit_cast(unsigned, f); return (u + 0x7fffu + ((u >> 16) & 1u)) >> 16; }
__device__ __forceinline__ unsigned pk2(float lo, float hi) { return f2bf(lo) | (f2bf(hi) << 16); }
__device__ __forceinline__ float bf_lo(unsigned w) { return __builtin_bit_cast(float, w << 16); }
__device__ __forceinline__ float bf_hi(unsigned w) { return __builtin_bit_cast(float, w & 0xffff0000u); }
namespace attn_body {
using bf16=__hip_bfloat16;
using bf16x8=__attribute__((ext_vector_type(8)))short;
using s16x4=__attribute__((ext_vector_type(4)))short;
using f32x16=__attribute__((ext_vector_type(16)))float;
using u32x4=__attribute__((ext_vector_type(4)))unsigned;
constexpr int BATCH=4,NHEAD=8,SEQ=8192,D=64,DM=NHEAD*D,OPITCH=1024;
constexpr int NW=8,QBLK=32,QB=QBLK*NW,KVBLK=64,NQB=SEQ/QB;
constexpr int ATTN_PITCH=DM, ATTN_UNIT_ROWS=QB;
__device__ __forceinline__ int crow(int r,int hi){return (r&3)+8*(r>>2)+4*hi;}
#define SBAR() __builtin_amdgcn_sched_barrier(0)
constexpr int NSLOT=3, SLOTB=8192;
constexpr int LDS_K=0, LDS_V=NSLOT*SLOTB, LDS_WS=2*NSLOT*SLOTB, LDS_OST=LDS_WS+NW*64*4, LDS_MSK=LDS_OST+NW*4096, LDS_BYTES=LDS_MSK+NW*1024;
constexpr float C2=0.125f*1.4426950408889634f;
__device__ __forceinline__ void glds16(const void*gsrc,unsigned lds_dst){unsigned keep;
  asm volatile("s_mov_b32 %0, m0\n\ts_mov_b32 m0, %2\n\ts_nop 0\n\tglobal_load_lds_dwordx4 %1, off\n\ts_mov_b32 m0, %0":"=&s"(keep):"v"(gsrc),"s"(lds_dst):"memory");}
__device__ __forceinline__ float max3f(float a,float b,float c){float r;asm("v_max3_f32 %0, %1, %2, %3":"=v"(r):"v"(a),"v"(b),"v"(c));return r;}
__device__ __forceinline__ float max2f(float a,float b){float r;asm("v_max_f32_e32 %0, %1, %2":"=v"(r):"v"(a),"v"(b));return r;}
__device__ __forceinline__ float fadd_s(float a,float b){float r;asm("v_add_f32_e32 %0, %1, %2":"=v"(r):"v"(a),"v"(b));return r;}
__device__ __forceinline__ float fsub_s(float a,float b){float r;asm("v_sub_f32_e32 %0, %1, %2":"=v"(r):"v"(a),"v"(b));return r;}
typedef float f32x2_t __attribute__((ext_vector_type(2))); typedef unsigned v2u_t __attribute__((ext_vector_type(2))); typedef __bf16 bf16x2_t __attribute__((ext_vector_type(2)));
__device__ __forceinline__ unsigned cvtpk_s(float lo,float hi){f32x2_t v={lo,hi};bf16x2_t b=__builtin_convertvector(v,bf16x2_t);return __builtin_bit_cast(unsigned,b);}
__device__ __forceinline__ void glds4(const void*gsrc,unsigned lds_dst){unsigned keep;
  asm volatile("s_mov_b32 %0, m0\n\ts_mov_b32 m0, %2\n\ts_nop 0\n\tglobal_load_lds_dword %1, off\n\ts_mov_b32 m0, %0":"=&s"(keep):"v"(gsrc),"s"(lds_dst):"memory");}
#define WAIT_BAR(N) asm volatile("s_waitcnt vmcnt(" #N ") lgkmcnt(0)\n\ts_barrier":::"memory")

__device__ __forceinline__ void qkt(f32x16&p0,f32x16&p1,const char*Kslot,const bf16x8*qr,int r32,int hi){
  const char*kb=Kslot+hi*1024+r32*16;
  #pragma unroll
  for(int d0=0;d0<4;++d0){
    const bf16x8 b0=*reinterpret_cast<const bf16x8*>(kb+d0*2048);
    const bf16x8 b1=*reinterpret_cast<const bf16x8*>(kb+d0*2048+512);
    p0=__builtin_amdgcn_mfma_f32_32x32x16_bf16(b0,qr[d0],p0,0,0,0);p1=__builtin_amdgcn_mfma_f32_32x32x16_bf16(b1,qr[d0],p1,0,0,0);}
}
typedef __attribute__((address_space(3))) const char* lds_cptr;
typedef short v4i16_t __attribute__((ext_vector_type(4)));
__device__ __forceinline__ void kload8(bf16x8*kf,lds_cptr kp){
  kf[0]=*(const __attribute__((address_space(3))) bf16x8*)(kp);      kf[1]=*(const __attribute__((address_space(3))) bf16x8*)(kp+512);
  kf[2]=*(const __attribute__((address_space(3))) bf16x8*)(kp+2048); kf[3]=*(const __attribute__((address_space(3))) bf16x8*)(kp+2560);
  kf[4]=*(const __attribute__((address_space(3))) bf16x8*)(kp+4096); kf[5]=*(const __attribute__((address_space(3))) bf16x8*)(kp+4608);
  kf[6]=*(const __attribute__((address_space(3))) bf16x8*)(kp+6144); kf[7]=*(const __attribute__((address_space(3))) bf16x8*)(kp+6656);
}
__device__ __forceinline__ void kload2(bf16x8*kf,lds_cptr kp,int j){ kf[2*j]=*(const __attribute__((address_space(3))) bf16x8*)(kp+j*2048); kf[2*j+1]=*(const __attribute__((address_space(3))) bf16x8*)(kp+j*2048+512); }
__device__ __forceinline__ s16x4 vtr(lds_cptr p){ return __builtin_bit_cast(s16x4,__builtin_amdgcn_ds_read_tr16_b64_v4i16((__attribute__((address_space(3))) v4i16_t*)p)); }
__device__ __forceinline__ float rowmax(const f32x16&p0,const f32x16&p1){
  float a=max3f(p0[0],p0[1],p1[0]),b=max3f(p0[2],p0[3],p1[1]);a=max3f(a,p1[2],p1[3]);
  #pragma unroll
  for(int r=4;r<16;r+=4){a=max3f(a,p0[r],p0[r+1]);b=max3f(b,p0[r+2],p0[r+3]);a=max3f(a,p1[r],p1[r+1]);b=max3f(b,p1[r+2],p1[r+3]);}
  const float m=max2f(a,b);
  auto rr=__builtin_amdgcn_permlane32_swap(__float_as_uint(m),__float_as_uint(m),false,false);
  return max2f(__uint_as_float(rr[0]),__uint_as_float(rr[1]));
}
__device__ __forceinline__ void pv(f32x16*o,int vb,bf16x8 pa0,bf16x8 pa1,bf16x8 pa2,bf16x8 pa3){
  #pragma unroll
  for(int d0=0;d0<2;++d0){s16x4 lo[4],hi[4];
    #pragma unroll
    for(int ks=0;ks<4;++ks){
      asm volatile("ds_read_b64_tr_b16 %0,%1 offset:%c2":"=&v"(lo[ks]):"v"(vb),"i"(d0*4096+ks*1024):"memory");
      asm volatile("ds_read_b64_tr_b16 %0,%1 offset:%c2":"=&v"(hi[ks]):"v"(vb),"i"(d0*4096+ks*1024+512):"memory");}
    asm volatile("s_waitcnt lgkmcnt(0)":::"memory");SBAR();
    #define PK(k) (bf16x8){lo[k][0],lo[k][1],lo[k][2],lo[k][3],hi[k][0],hi[k][1],hi[k][2],hi[k][3]}
    o[d0]=__builtin_amdgcn_mfma_f32_32x32x16_bf16(pa0,PK(0),o[d0],0,0,0);
    o[d0]=__builtin_amdgcn_mfma_f32_32x32x16_bf16(pa1,PK(1),o[d0],0,0,0);
    o[d0]=__builtin_amdgcn_mfma_f32_32x32x16_bf16(pa2,PK(2),o[d0],0,0,0);
    o[d0]=__builtin_amdgcn_mfma_f32_32x32x16_bf16(pa3,PK(3),o[d0],0,0,0);
    #undef PK
  }
}

#ifndef ATTN_STORE16
#define ATTN_STORE16(p,v) (*(u32x4*)(p)=(v))
#endif
template<int THRL> __device__ __forceinline__ void attn_unit(int b,int h,int qb,const bf16*Q,const bf16*__restrict__ K,const bf16*__restrict__ V,const unsigned long long*__restrict__ SEL,bf16*O,char*shm){
  int tid_=threadIdx.x; asm volatile("":"+v"(tid_));
  const int tid=tid_,lane=tid&63,r32=lane&31,hi=lane>>5; const int wid=__builtin_amdgcn_readfirstlane(tid>>6);
  const long rowbase=(long)b*SEQ; const int q0=qb*QB;
  const bf16*Qw=Q+(rowbase+q0+wid*QBLK)*DM+h*D;
  const bf16*Kh=K+rowbase*DM+h*D,*Vh=V+rowbase*DM+h*D;
  const unsigned lds0=(unsigned)(uintptr_t)shm;
  float*wsf=(float*)(shm+LDS_WS)+wid*64;
  const bf16*ksrc=Kh+(long)lane*DM+wid*8;
  const bf16*vsrc=Vh+(long)(16*(wid&3)+(lane>>2))*DM+(wid>>2)*32+(lane&3)*8;
  const unsigned*msrc=(const unsigned*)(SEL+(size_t)b*128*SEQ+q0+wid*QBLK)+lane;
  const unsigned kdst=lds0+LDS_K+wid*1024, vdst=lds0+LDS_V+wid*1024, mdst=lds0+LDS_MSK+wid*1024;
  const int NT=(q0+QB)/KVBLK;
  #define TI(t) (NT-1-(t))
  #define DMA_K(t,slot) glds16(ksrc+(long)TI(t)*KVBLK*DM,(unsigned)__builtin_amdgcn_readfirstlane(kdst+(slot)))
  #define DMA_V(t,slot) glds16(vsrc+(long)TI(t)*KVBLK*DM,(unsigned)__builtin_amdgcn_readfirstlane(vdst+(slot)))
  #define DMA_M(t) glds4(msrc+(size_t)TI(t)*(SEQ*2),(unsigned)__builtin_amdgcn_readfirstlane(mdst+(((t)&3)<<8)))
  const int vb0=(int)(lds0+LDS_V)+((lane>>4)&1)*32+(lane&3)*8+(4*hi+((lane&15)>>2))*64;
  const char*Kbase=shm+LDS_K; bf16x8 kf[8];
  const lds_cptr shm3=(lds_cptr)shm; const lds_cptr kp0=shm3+LDS_K+hi*1024+r32*16; const lds_cptr vp0=shm3+LDS_V+((lane>>4)&1)*32+(lane&3)*8+(4*hi+((lane&15)>>2))*64;
  const lds_cptr mp0=shm3+LDS_MSK+wid*1024+r32*8;
  DMA_M(0);DMA_M(1);DMA_M(2);
  DMA_K(0,0);DMA_V(0,0);DMA_K(1,SLOTB);
  bf16x8 qr[4];
  #pragma unroll
  for(int d0=0;d0<4;++d0)qr[d0]=*reinterpret_cast<const bf16x8*>(&Qw[(long)r32*DM+d0*16+hi*8]);
  float mhat=0.f,l_reg=0.f;f32x16 o[2];o[0]=f32x16{};o[1]=f32x16{};
  bool started=false;
  const float slope2=__builtin_amdgcn_exp2f(-(float)(h+1))*1.4426950408889634f, m2s=-2.f*slope2;
  const int tq=q0+wid*QBLK+r32, sref=q0+QB-1;
  bool resc=false;
  #define CR(r) (((r)&3)+8*((r)>>2))
  #define SELV(w,c,v) __uint_as_float(((unsigned)__builtin_amdgcn_sbfe((int)(w),(c),1)&__float_as_uint(v))|(~(unsigned)__builtin_amdgcn_sbfe((int)(w),(c),1)&0xff800000u))
  float nb=0.f,dq=0.f;unsigned wl=0u,wh=0u;
  #define FPREP(tn) do{ const int ti_=TI(tn); const v2u_t mw_=*(const __attribute__((address_space(3))) v2u_t*)(mp0+(((tn)&3)<<8)); wl=mw_.x>>(4*hi); wh=mw_.y>>(4*hi); \
      nb=slope2*(float)(64*ti_+4*hi-sref)-mhat; dq=(float)(64*ti_+4*hi-tq); }while(0)
  #define FILL4(X,B,w,co,BN) do{ _Pragma("unroll") for(int r_=(B);r_<(B)+4;++r_){ float v_=__builtin_fmaf(slope2,(float)(CR(r_)+(co)),nb); \
      if(BN){ v_=__builtin_fmaf(__builtin_fmaxf(dq+(float)(CR(r_)+(co)),0.f),m2s,v_); } X[r_]=SELV(w,CR(r_),v_); } PIN(X); }while(0)
  #define PIN(x) asm volatile("":"+v"(x))
  #define MX3(a,b,c) __builtin_fmaxf(__builtin_fmaxf((a),(b)),(c))
  #define DECIDE(C0,C1) do{ float a=MX3(C0[0],C0[1],C1[0]),b_=MX3(C0[2],C0[3],C1[1]); a=MX3(a,C1[2],C1[3]); \
      _Pragma("unroll") for(int r=4;r<16;r+=4){a=MX3(a,C0[r],C0[r+1]);b_=MX3(b_,C0[r+2],C0[r+3]);a=MX3(a,C1[r],C1[r+1]);b_=MX3(b_,C1[r+2],C1[r+3]);} \
      float rm=__builtin_fmaxf(a,b_); { auto rr=__builtin_amdgcn_permlane32_swap(__float_as_uint(rm),__float_as_uint(rm),false,false); rm=__builtin_fmaxf(__uint_as_float(rr[0]),__uint_as_float(rr[1])); } \
      resc=false; const bool live_=rm>-INFINITY, fresh_=live_&&!started; \
      if(__builtin_expect(__any(fresh_||rm>(float)THRL),0)){ const float dl=fresh_?rm:__builtin_fmaxf(rm,0.f); mhat+=dl; \
        _Pragma("unroll") for(int r=0;r<16;++r){C0[r]-=dl;C1[r]-=dl;} \
        const float f=started?__builtin_amdgcn_exp2f(-dl):1.0f; l_reg*=f; if(hi==0)wsf[r32]=f; resc=true; } \
      started=started||live_; }while(0)
  #define RESC() do{ if(resc){ asm volatile("s_waitcnt lgkmcnt(0)":::"memory"); \
      _Pragma("unroll") for(int d_=0;d_<2;++d_) _Pragma("unroll") for(int r=0;r<16;++r)o[d_][r]*=wsf[crow(r,hi)]; } }while(0)
  f32x16 pA0,pA1,pB0,pB1;
  int sl_prev=0,sl_cur=0,sl_next=SLOTB;
  #define ROT() do{sl_prev=sl_cur;sl_cur=sl_next;sl_next=(sl_next==(NSLOT-1)*SLOTB)?0:sl_next+SLOTB;}while(0)
  DMA_K(2,2*SLOTB);
  WAIT_BAR(3);
  FPREP(0);
  FILL4(pA0,0,wl,0,true);FILL4(pA0,4,wl,0,true);FILL4(pA0,8,wl,0,true);FILL4(pA0,12,wl,0,true);
  FILL4(pA1,0,wh,32,true);FILL4(pA1,4,wh,32,true);FILL4(pA1,8,wh,32,true);FILL4(pA1,12,wh,32,true);
  qkt(pA0,pA1,Kbase,qr,r32,hi);asm volatile("s_nop 15\n\ts_nop 7":"+v"(pA0),"+v"(pA1));
  DECIDE(pA0,pA1);
  _Pragma("unroll") for(int r=0;r<16;++r){pA0[r]=__builtin_amdgcn_exp2f(pA0[r]);pA1[r]=__builtin_amdgcn_exp2f(pA1[r]);}
  WAIT_BAR(0);
  DMA_K(3,0);DMA_M(3);DMA_V(1,SLOTB);
  ROT();
  kload8(kf,kp0+sl_cur);
  RESC();
  FPREP(1);
  FILL4(pB0,0,wl,0,true);FILL4(pB0,4,wl,0,true);FILL4(pB0,8,wl,0,true);FILL4(pB0,12,wl,0,true);
  FILL4(pB1,0,wh,32,true);FILL4(pB1,4,wh,32,true);FILL4(pB1,8,wh,32,true);FILL4(pB1,12,wh,32,true);
  WAIT_BAR(3);
  s16x4 vlo[8],vhi[8]; u32x4 pw0,pw1,pw2,pw3;
  #define PKW(P,B) cvtpk_s(P[B],P[B+1])
  #define PAF(k) __builtin_bit_cast(bf16x8,pw##k)
  #define VFR(i) (bf16x8){vlo[i][0],vlo[i][1],vlo[i][2],vlo[i][3],vhi[i][0],vhi[i][1],vhi[i][2],vhi[i][3]}
  #define GAPA(MF,A0,A1,A2,A3,W0,W1,PW) do{ MF; sacc+=A0; sacc+=A1; sacc+=A2; sacc+=A3; PIN(sacc); W0; W1; PIN(PW); SBAR(); }while(0)
  #define EX(v) __builtin_amdgcn_exp2f(v)
  #define GAPB(MF,X,B,GF,Y,w,co,BN) do{ MF; X[B]=EX(X[B]); X[B+1]=EX(X[B+1]); X[B+2]=EX(X[B+2]); X[B+3]=EX(X[B+3]); PIN(X); if(GF){ FILL4(Y,B,w,co,BN); } SBAR(); }while(0)
  #define VRD(i) do{ vlo[i]=vtr(vp_+(((i)>>2)*4096+((i)&3)*1024)); vhi[i]=vtr(vp_+(((i)>>2)*4096+((i)&3)*1024+512)); }while(0)
  #define KRD(G,j) do{ if(G){ kload2(kf,kp0+sl_next,j); SBAR(); } }while(0)
  #define STEP(C0,C1,P0,P1,t,GK,GV,GL,GF,BN) do{ SBAR(); \
    const lds_cptr vp_=vp0+sl_prev; \
    VRD(0); SBAR(); float sacc=(P0[0]+P0[1]); \
    GAPA(C0=__builtin_amdgcn_mfma_f32_32x32x16_bf16(kf[0],qr[0],C0,0,0,0), P0[2],P0[3],P0[4],P0[5],     pw0[0]=PKW(P0,0), pw0[1]=PKW(P0,2), pw0); \
    VRD(4); SBAR(); GAPA(C1=__builtin_amdgcn_mfma_f32_32x32x16_bf16(kf[1],qr[0],C1,0,0,0), P0[6],P0[7],P0[8],P0[9],     pw0[2]=PKW(P0,4), pw0[3]=PKW(P0,6), pw0); \
    VRD(1); SBAR(); GAPA(C0=__builtin_amdgcn_mfma_f32_32x32x16_bf16(kf[2],qr[1],C0,0,0,0),   P0[10],P0[11],P0[12],P0[13], pw1[0]=PKW(P0,8), pw1[1]=PKW(P0,10), pw1); \
    VRD(5); SBAR(); GAPA(C1=__builtin_amdgcn_mfma_f32_32x32x16_bf16(kf[3],qr[1],C1,0,0,0),   P0[14],P0[15],P1[0],P1[1],   pw1[2]=PKW(P0,12),pw1[3]=PKW(P0,14), pw1); \
    VRD(2); SBAR(); GAPA(C0=__builtin_amdgcn_mfma_f32_32x32x16_bf16(kf[4],qr[2],C0,0,0,0),   P1[2],P1[3],P1[4],P1[5],     pw2[0]=PKW(P1,0), pw2[1]=PKW(P1,2), pw2); \
    VRD(6); SBAR(); GAPA(C1=__builtin_amdgcn_mfma_f32_32x32x16_bf16(kf[5],qr[2],C1,0,0,0),   P1[6],P1[7],P1[8],P1[9],     pw2[2]=PKW(P1,4), pw2[3]=PKW(P1,6), pw2); \
    VRD(3); SBAR(); GAPA(C0=__builtin_amdgcn_mfma_f32_32x32x16_bf16(kf[6],qr[3],C0,0,0,0),   P1[10],P1[11],P1[12],P1[13], pw3[0]=PKW(P1,8), pw3[1]=PKW(P1,10), pw3); \
    VRD(7); SBAR(); GAPA(C1=__builtin_amdgcn_mfma_f32_32x32x16_bf16(kf[7],qr[3],C1,0,0,0),   P1[14],P1[15],0.f,0.f,       pw3[2]=PKW(P1,12),pw3[3]=PKW(P1,14), pw3); \
    l_reg+=sacc; \
    if(GK){DMA_K((t)+3,sl_cur);DMA_M((t)+3);} if(GV){DMA_V((t)+1,sl_next);} \
    DECIDE(C0,C1); \
    if(GF){ FPREP((t)+1); } \
    SBAR(); \
    GAPB(o[0]=__builtin_amdgcn_mfma_f32_32x32x16_bf16(PAF(0),VFR(0),o[0],0,0,0), C0,0, GF,P0,wl,0,BN); \
    GAPB(o[1]=__builtin_amdgcn_mfma_f32_32x32x16_bf16(PAF(0),VFR(4),o[1],0,0,0), C0,4, GF,P0,wl,0,BN); \
    KRD(GL,0); GAPB(o[0]=__builtin_amdgcn_mfma_f32_32x32x16_bf16(PAF(1),VFR(1),o[0],0,0,0), C0,8, GF,P0,wl,0,BN); \
    KRD(GL,1); GAPB(o[1]=__builtin_amdgcn_mfma_f32_32x32x16_bf16(PAF(1),VFR(5),o[1],0,0,0), C0,12, GF,P0,wl,0,BN); \
    KRD(GL,2); GAPB(o[0]=__builtin_amdgcn_mfma_f32_32x32x16_bf16(PAF(2),VFR(2),o[0],0,0,0), C1,0, GF,P1,wh,32,BN); \
    KRD(GL,3); GAPB(o[1]=__builtin_amdgcn_mfma_f32_32x32x16_bf16(PAF(2),VFR(6),o[1],0,0,0), C1,4, GF,P1,wh,32,BN); \
    GAPB(o[0]=__builtin_amdgcn_mfma_f32_32x32x16_bf16(PAF(3),VFR(3),o[0],0,0,0), C1,8, GF,P1,wh,32,BN); \
    GAPB(o[1]=__builtin_amdgcn_mfma_f32_32x32x16_bf16(PAF(3),VFR(7),o[1],0,0,0), C1,12, GF,P1,wh,32,BN); \
    }while(0)
  #define ENDW(tt) do{ if((tt)+3<NT){WAIT_BAR(3);} else if((tt)+2<NT){WAIT_BAR(1);} else {WAIT_BAR(0);} }while(0)
  int t=1;
  STEP(pB0,pB1,pA0,pA1,1,(4<NT),true,true,true,true);   ENDW(1); RESC(); ROT();
  STEP(pA0,pA1,pB0,pB1,2,(5<NT),true,true,true,true);   ENDW(2); RESC(); ROT();
  t=3;
  for(;t+5<NT;t+=2){
    STEP(pB0,pB1,pA0,pA1,t,true,true,true,true,false);     WAIT_BAR(3); RESC(); ROT();
    STEP(pA0,pA1,pB0,pB1,t+1,true,true,true,true,false);   WAIT_BAR(3); RESC(); ROT();
  }
  for(;t+1<NT;t+=2){
    STEP(pB0,pB1,pA0,pA1,t,(t+3<NT),(t+1<NT),(t+1<NT),(t+1<NT),false);       ENDW(t);   RESC(); ROT();
    STEP(pA0,pA1,pB0,pB1,t+1,(t+4<NT),(t+2<NT),(t+2<NT),(t+2<NT),false);     ENDW(t+1); RESC(); ROT();
  }
  STEP(pB0,pB1,pA0,pA1,NT-1,false,false,false,false,false); RESC();
  { float sacc=pB0[0]+pB0[1]; _Pragma("unroll") for(int r=2;r<16;++r)sacc+=pB0[r]; _Pragma("unroll") for(int r=0;r<16;++r)sacc+=pB1[r]; l_reg+=sacc;
    pw0=(u32x4){PKW(pB0,0),PKW(pB0,2),PKW(pB0,4),PKW(pB0,6)};pw1=(u32x4){PKW(pB0,8),PKW(pB0,10),PKW(pB0,12),PKW(pB0,14)};pw2=(u32x4){PKW(pB1,0),PKW(pB1,2),PKW(pB1,4),PKW(pB1,6)};pw3=(u32x4){PKW(pB1,8),PKW(pB1,10),PKW(pB1,12),PKW(pB1,14)};
    SBAR(); pv(o,vb0+sl_cur,PAF(0),PAF(1),PAF(2),PAF(3)); }
  #undef PKW
  #undef PAF
  #undef VFR
  #undef PIN
  #undef MX3
  #undef GAPA
  #undef GAPB
  #undef EX
  #undef VRD
  #undef KRD
  #undef STEP
  #undef ENDW
  #undef FILL4
  #undef FPREP
  #undef SELV
  #undef CR
  #undef DECIDE
  {auto rr=__builtin_amdgcn_permlane32_swap(__float_as_uint(l_reg),__float_as_uint(l_reg),false,false);l_reg=__uint_as_float(rr[0])+__uint_as_float(rr[1]);}
  if(hi==0)wsf[32+r32]=l_reg;asm volatile("s_waitcnt lgkmcnt(0)":::"memory");
  float rli[16];
  #pragma unroll
  for(int r=0;r<16;++r)rli[r]=__builtin_amdgcn_rcpf(wsf[32+crow(r,hi)]);
  bf16*Ow=O+(rowbase+q0+wid*QBLK)*OPITCH+h*D;
  { bf16*stg=(bf16*)(shm+LDS_OST)+wid*2048;
    #pragma unroll
    for(int r=0;r<16;++r){const int orow=crow(r,hi);
      #pragma unroll
      for(int d0=0;d0<2;++d0)stg[orow*64+d0*32+r32]=__float2bfloat16(o[d0][r]*rli[r]);}
    asm volatile("s_waitcnt lgkmcnt(0)":::"memory");
    #pragma unroll
    for(int i=0;i<4;++i){const int row=i*8+(lane>>3),ch=lane&7; const u32x4 v=*(const u32x4*)(stg+row*64+ch*8); ATTN_STORE16(Ow+(long)row*OPITCH+ch*8,v);} }
  asm volatile("s_waitcnt lgkmcnt(0)\n\ts_barrier":::"memory");
  #undef DMA_K
  #undef DMA_V
  #undef DMA_M
  #undef TI
  #undef RESC
  #undef ROT
}
constexpr int ATTN_LDS_BYTES=LDS_BYTES;
struct AttnTensors { const bf16* Q; const bf16* K; const bf16* V; const unsigned long long* SEL; bf16* O; };
struct AttnUnit { int bh; int qb; };
struct StaticOrder {
  int vcu,grid,block;
  __device__ __forceinline__ explicit StaticOrder(int grid_,int block_):vcu((block_%8)*(grid_/8)+block_/8),grid(grid_),block(block_){}
  __device__ __forceinline__ bool next(int i,AttnUnit&u)const{
    if(grid==256){ if(i>=4)return false; const int s=vcu&7; u.bh=vcu>>3; u.qb=(i==0)?s:(i==1)?15-s:(i==2)?16+s:31-s; return true; }
    const int n=i*grid+block; if(n>=BATCH*NHEAD*NQB)return false; u.bh=n/NQB; u.qb=n%NQB; return true; }
};
template<class Sched,int THRL=8> __device__ __forceinline__ void attn_phase(char*lds,const AttnTensors&T,const Sched&S){
  AttnUnit u;
  for(int i=0;S.next(i,u);++i){ attn_unit<THRL>(u.bh/NHEAD,u.bh%NHEAD,u.qb,T.Q,T.K,T.V,T.SEL,T.O,lds); }
}
#undef SBAR
#undef WAIT_BAR
}
#define XB_TMO      128
#define XB_XCNT(j)  (256  + 64 * (j))
#define XB_XSUB(j)  (1280 + 64 * (j))
#define XB_XGEN(j)  (2304 + 64 * (j))
#define XB_TOP      3328
#define XB_TOPGEN   3392
#define XCD_BAR_WORDS 3456
#define XB_SPIN_CAP (1u << 18)

__device__ __forceinline__ unsigned xb_ld(unsigned* p)              { return __hip_atomic_load(p, __ATOMIC_RELAXED, __HIP_MEMORY_SCOPE_AGENT); }
__device__ __forceinline__ unsigned xb_add(unsigned* p, unsigned v) { return __hip_atomic_fetch_add(p, v, __ATOMIC_RELAXED, __HIP_MEMORY_SCOPE_AGENT); }
__device__ __forceinline__ unsigned xb_xcc_id() { return (unsigned)__builtin_amdgcn_s_getreg((3 << 11) | 20) & 0xFu; }
#define XB_SPIN(cond, bar) do { unsigned _sp = 0; while (cond) { __builtin_amdgcn_s_sleep(1); \
    if ((++_sp & 255u) == 0u) { if (xb_ld(&(bar)[XB_TMO])) break; if (_sp > XB_SPIN_CAP) { atomicAdd(&(bar)[XB_TMO], 1u); break; } } } } while (0)

struct XcdBarrier {
    unsigned* bar; unsigned x;
    volatile LAS unsigned* st;
};

__device__ __forceinline__ XcdBarrier xcd_barrier_post(unsigned* bar, volatile LAS unsigned* st) {
    XcdBarrier b; b.bar = bar; b.x = xb_xcc_id(); b.st = st;
    if (threadIdx.x == 0) (void)xb_add(&bar[XB_XCNT(b.x)], 1u);
    return b;
}
__device__ __forceinline__ void xcd_barrier_complete(unsigned* bar, unsigned x, unsigned& nloc, unsigned& nx) {
    const unsigned G = gridDim.x * gridDim.y * gridDim.z;
    unsigned sum, cnt, mine, sp = 0u;
    for (;;) {
        sum = 0u; cnt = 0u; mine = 0u;
#pragma unroll
        for (unsigned j = 0; j < 16; ++j) { const unsigned c = xb_ld(&bar[XB_XCNT(j)]); sum += c; cnt += (c > 0u) ? 1u : 0u; mine = (j == x) ? c : mine; }
        if (sum == G) break;
        __builtin_amdgcn_s_sleep(1);
        if ((++sp & 255u) == 0u) { if (xb_ld(&bar[XB_TMO])) break; if (sp > XB_SPIN_CAP) { atomicAdd(&bar[XB_TMO], 1u); break; } }
    }
    nloc = mine > 0u ? mine : 1u; nx = cnt > 0u ? cnt : 1u;
}

__device__ __forceinline__ void xcd_barrier(const XcdBarrier& b) {
    asm volatile("s_waitcnt vmcnt(0)" ::: "memory");
    __syncthreads();
    if (threadIdx.x == 0) {
        unsigned* bar = b.bar;
        __builtin_amdgcn_s_waitcnt(0);
        unsigned nloc = b.st[0], nx = b.st[1];
        if (nloc == 0u) { xcd_barrier_complete(bar, b.x, nloc, nx); b.st[0] = nloc; b.st[1] = nx; }
        const unsigned old = xb_add(&bar[XB_XSUB(b.x)], 1u);
        const unsigned gen = old / nloc;
        if (old + 1u == (gen + 1u) * nloc) {
            __builtin_amdgcn_fence(__ATOMIC_RELEASE, "agent");
            asm volatile("s_waitcnt vmcnt(0)" ::: "memory");
            const unsigned og = xb_add(&bar[XB_TOP], 1u);
            const unsigned tg = og / nx;
            if (og + 1u == (tg + 1u) * nx) xb_add(&bar[XB_TOPGEN], 1u);
            else XB_SPIN(xb_ld(&bar[XB_TOPGEN]) == tg, bar);
            __builtin_amdgcn_fence(__ATOMIC_ACQUIRE, "agent");
            xb_add(&bar[XB_XGEN(b.x)], 1u);
            asm volatile("s_waitcnt vmcnt(0)" ::: "memory");
        } else {
            XB_SPIN(xb_ld(&bar[XB_XGEN(b.x)]) == gen, bar);
            __builtin_amdgcn_fence(__ATOMIC_ACQUIRE, "agent");
            asm volatile("s_waitcnt vmcnt(0)" ::: "memory");
        }
    }
    __syncthreads();
}

__device__ __forceinline__ void p0_transpose_item(const float* W, int K, int N, bf16* WT, LAS float* scr, int k0, int dn0, int c0, int lane) {
    const int n = lane & 31;
#pragma unroll 8
    for (int i = 0; i < 32; ++i) { const int kk = 2 * i + (lane >> 5); scr[kk * 33 + n] = (c0 >= 0) ? W[(size_t)(k0 + kk) * N + c0 + n] : 0.f; }
    LDS_WAIT(); asm volatile("" ::: "memory");
    const int c = lane & 7;
#pragma unroll
    for (int j = 0; j < 4; ++j) { const int nn = (lane >> 3) + 8 * j; const LAS float* s = scr + (8 * c) * 33 + nn;
        v4u o; o.x = pk2(s[0 * 33], s[1 * 33]); o.y = pk2(s[2 * 33], s[3 * 33]); o.z = pk2(s[4 * 33], s[5 * 33]); o.w = pk2(s[6 * 33], s[7 * 33]);
        *(GAS v4u*)(WT + (size_t)(dn0 + nn) * K + k0 + 8 * c) = o; }
    LDS_WAIT(); asm volatile("" ::: "memory");
}
__device__ __forceinline__ int win_src_col8(int d) {
    if (d < 2120) return d;
    if (d < 2304) return -1;
    if (d < 2816) return 2120 + (d - 2304);
    const int t = (d - 2816) >> 8, w = (d - 2816) & 255;
    return (w < 128) ? (2632 + 128 * t + w) : (3144 + 128 * t + (w - 128));
}
__device__ __forceinline__ void p0_transpose_item_win(const float* W, bf16* WT, LAS float* scr, int k0, int dn0, int lane) {
    const int n = lane & 31; const int c0 = win_src_col8(dn0 + (n & ~7)); const int col = c0 + (n & 7);
#pragma unroll 8
    for (int i = 0; i < 32; ++i) { const int kk = 2 * i + (lane >> 5); scr[kk * 33 + n] = (c0 >= 0) ? W[(size_t)(k0 + kk) * 3656 + col] : 0.f; }
    LDS_WAIT(); asm volatile("" ::: "memory");
    const int c = lane & 7;
#pragma unroll
    for (int j = 0; j < 4; ++j) { const int nn = (lane >> 3) + 8 * j; const LAS float* s = scr + (8 * c) * 33 + nn;
        v4u o; o.x = pk2(s[0 * 33], s[1 * 33]); o.y = pk2(s[2 * 33], s[3 * 33]); o.z = pk2(s[4 * 33], s[5 * 33]); o.w = pk2(s[6 * 33], s[7 * 33]);
        *(GAS v4u*)(WT + (size_t)(dn0 + nn) * D + k0 + 8 * c) = o; }
    LDS_WAIT(); asm volatile("" ::: "memory");
}
__device__ __forceinline__ float wave_sum(float v) {
#pragma unroll
    for (int o = 1; o < 64; o <<= 1) v += __shfl_xor(v, o);
    return v;
}
__device__ __forceinline__ void ln_row(const float* xrow, const float* g, const float* bta, float* orow, bf16* obrow, int lane) {
    const GAS f32x4* xr = (const GAS f32x4*)xrow + lane;
    f32x4 v[4]; float s = 0.f;
#pragma unroll
    for (int j = 0; j < 4; ++j) { v[j] = xr[64 * j]; s += (v[j].x + v[j].y) + (v[j].z + v[j].w); }
    const float mean = wave_sum(s) * (1.f / D); float s2 = 0.f;
#pragma unroll
    for (int j = 0; j < 4; ++j) { v[j] = v[j] - mean; s2 += (v[j].x * v[j].x + v[j].y * v[j].y) + (v[j].z * v[j].z + v[j].w * v[j].w); }
    const float rstd = 1.f / sqrtf(wave_sum(s2) * (1.f / D) + LN_EPS);
    GAS f32x4* of = (GAS f32x4*)orow + lane; GAS v2u* ob = (GAS v2u*)obrow + lane;
#pragma unroll
    for (int j = 0; j < 4; ++j) { const f32x4 gg = ((const GAS f32x4*)g)[lane + 64 * j], bb = ((const GAS f32x4*)bta)[lane + 64 * j];
        const f32x4 y = v[j] * rstd * gg + bb; of[64 * j] = y; v2u w; w.x = pk2(y.x, y.y); w.y = pk2(y.z, y.w); ob[64 * j] = w; }
}

struct Args { const float* in[19]; float* out; unsigned char* ws; };

__device__ __forceinline__ unsigned row_sum16(unsigned v) {
    v += (unsigned)__builtin_amdgcn_update_dpp(0, (int)v, 0xB1, 0xF, 0xF, true);
    v += (unsigned)__builtin_amdgcn_update_dpp(0, (int)v, 0x4E, 0xF, 0xF, true);
    v += (unsigned)__builtin_amdgcn_update_dpp(0, (int)v, 0x141, 0xF, 0xF, true);
    v += (unsigned)__builtin_amdgcn_update_dpp(0, (int)v, 0x140, 0xF, 0xF, true);
    return v;
}
__device__ __forceinline__ unsigned wave_sum_u(unsigned v) {
    v = row_sum16(v);
    return (unsigned)__builtin_amdgcn_readlane((int)v, 0) + (unsigned)__builtin_amdgcn_readlane((int)v, 16) + (unsigned)__builtin_amdgcn_readlane((int)v, 32) + (unsigned)__builtin_amdgcn_readlane((int)v, 48);
}
__device__ __forceinline__ unsigned score_key(float s) {
    const _Float16 h = (_Float16)s; unsigned hb = (unsigned)__builtin_bit_cast(unsigned short, h);
    return (hb & 0x8000u) ? (hb ^ 0xffffu) : (hb | 0x8000u);
}

template <int NREG>
__device__ __forceinline__ void select_emit(const LAS unsigned short* rowp, int nslots, int ntb, unsigned long long* selp  , int lane) {
    unsigned kreg[NREG];
#pragma unroll
    for (int i = 0; i < NREG / 2; ++i) { const v2u v = *(const LAS v2u*)(rowp + 4 * i); kreg[2 * i] = v.x; kreg[2 * i + 1] = v.y; }
#pragma unroll
    for (int p = 0; p < NREG; ++p) { if (2 * p >= nslots) kreg[p] = 0u; else if (2 * p + 1 >= nslots) kreg[p] &= 0xffffu; }
    unsigned T = 0u, need = 0u;
    if (nslots * 64 > TOPK) {
        unsigned lo = 0u, hi = 65536u, chi = 0u;
        for (int it = 0; it < 16; ++it) {
            const unsigned mid = (lo + hi) >> 1, m1 = mid - 1u, mm = m1 | (m1 << 16);
            const unsigned one2 = 0x00010001u;
            u16x2 acc = {0, 0};
#pragma unroll
            for (int p = 0; p < NREG; ++p) { unsigned d; asm("v_pk_sub_u16 %0, %1, %2 clamp" : "=v"(d) : "v"(kreg[p]), "s"(mm)); asm("v_pk_min_u16 %0, %1, %2" : "=v"(d) : "v"(d), "s"(one2)); acc += __builtin_bit_cast(u16x2, d); }
            const unsigned a = __builtin_bit_cast(unsigned, acc);
            const unsigned tot = wave_sum_u((a & 0xffffu) + (a >> 16));
            if (tot >= (unsigned)TOPK) lo = mid; else { hi = mid; chi = tot; }
        }
        T = lo; need = (unsigned)TOPK - chi;
    }
    unsigned w0l = 0u, w0h = 0u, w1l = 0u, w1h = 0u; unsigned rem = need;
#pragma unroll
    for (int p = 0; p < NREG; ++p)
#pragma unroll
        for (int hf = 0; hf < 2; ++hf) { const int j = 2 * p + hf;
            if (j < nslots) {
                const unsigned k = hf ? (kreg[p] >> 16) : (kreg[p] & 0xffffu);
                unsigned long long mg = __ballot(k > T); const unsigned long long me = __ballot(k == T);
                if (me != 0ull && rem > 0u) { const unsigned n = (unsigned)__popcll(me);
                    if (n <= rem) { mg |= me; rem -= n; }
                    else { unsigned long long t = me, s = 0ull; for (unsigned i = 0; i < rem; ++i) { const unsigned long long b = t & (0ull - t); s |= b; t ^= b; } mg |= s; rem = 0u; } }
                if (j < 64) { if (lane == j) { w0l = (unsigned)mg; w0h = (unsigned)(mg >> 32); } }
                else { if (lane == j - 64) { w1l = (unsigned)mg; w1h = (unsigned)(mg >> 32); } }
            } }
    if (lane < ntb) selp[(size_t)lane * SEQ] = ((unsigned long long)w0h << 32) | w0l;
    if (lane + 64 < ntb) selp[(size_t)(lane + 64) * SEQ] = ((unsigned long long)w1h << 32) | w1l;
}

__global__ void __launch_bounds__(NWAVES * 64, 2) mega_fwd(Args args) {
    extern __shared__ __attribute__((aligned(16))) unsigned char lds[];
    LAS unsigned char* const L = (LAS unsigned char*)lds;
    volatile LAS unsigned* const MISC = (volatile LAS unsigned*)(L + MISC_OFF);
    const int G = gridDim.x, bx = blockIdx.x;
    const int vcu = (G % 8 == 0) ? (bx % 8) * (G / 8) + bx / 8 : bx;
    gu32* const ctl = (gu32*)(args.ws + WS_CTL);
    const int tid = threadIdx.x;
#define PHASE_VIEW() int tid_p = threadIdx.x; asm volatile("" : "+v"(tid_p)); const int lane = tid_p & 63, wave = __builtin_amdgcn_readfirstlane(tid_p >> 6); size_t z_ = 0; asm volatile("" : "+s"(z_)); unsigned char* ws = args.ws + z_; float* out = args.out + z_;     \
    const int gw = vcu * NWAVES + wave, NGW = G * NWAVES; (void)lane; (void)gw; (void)NGW; (void)out; \
    bf16* const XB = (bf16*)(ws + WS_XB); float* const R = (float*)(ws + WS_R); bf16* const HB = (bf16*)(ws + WS_BIG); bf16* const PB = (bf16*)(ws + WS_PB); \
    bf16* const QKVI = (bf16*)(ws + WS_QKVI); bf16* const KI = (bf16*)(ws + WS_KI); float* const WI = (float*)(ws + WS_WI); bf16* const BC = (bf16*)(ws + WS_BC); bf16* const Z = (bf16*)(ws + WS_Z); \
    unsigned long long* const SEL = (unsigned long long*)(ws + WS_SEL); \
    const bf16* const Qb = QKVI; const bf16* const Kb = QKVI + (size_t)M * 512; const bf16* const Vb = QKVI + (size_t)2 * M * 512; const bf16* const QIb = QKVI + (size_t)3 * M * 512; \
    (void)XB; (void)R; (void)HB; (void)PB; (void)KI; (void)WI; (void)BC; (void)Z; (void)SEL; (void)Qb; (void)Kb; (void)Vb; (void)QIb;

    for (int u = tid; u < (LDS_BYTES - LDSCTL_OFF) / 4; u += NWAVES * 64) ((LAS unsigned*)(L + LDSCTL_OFF))[u] = 0u;
    __syncthreads();
    XcdBarrier bar = xcd_barrier_post((unsigned*)(ctl + CW_BAR), MISC + 8);
#define GRID_BAR() xcd_barrier(bar)

    { PHASE_VIEW();
        const float* const x = args.in[0]; const float* const pin = args.in[1];
        LAS float* scr = (LAS float*)(L + RING_OFF + wave * 16384);
        constexpr int I_GU = (D / 64) * (NGU / 32), I_D = (FF / 64) * (D / 32), I_IN = (D / 64) * (NIN / 32), I_SQ = (D / 64) * (D / 32), I_P = (DPLE / 64) * (D / 32);
        constexpr int NITEMS = 2 * I_GU + 2 * I_D + I_IN + 2 * I_SQ + I_P;
        for (int it = gw; it < NITEMS; it += NGW) {
            int r = it;
            if (r < 2 * I_GU) { const int f = r / I_GU; r -= f * I_GU; const int nb = r % (NGU / 32), kb = r / (NGU / 32), dn0 = 32 * nb;
                const int half = (dn0 >> 7) & 1, j0 = ((dn0 >> 8) << 7) + (dn0 & 127);
                const float* W = f ? (half ? args.in[13] : args.in[12]) : (half ? args.in[5] : args.in[4]);
                p0_transpose_item(W, D, FF, (bf16*)(ws + (f ? WS_WGU2 : WS_WGU1)), scr, 64 * kb, dn0, j0, lane); continue; }
            r -= 2 * I_GU;
            if (r < 2 * I_D) { const int f = r / I_D; r -= f * I_D; const int nb = r % (D / 32), kb = r / (D / 32);
                p0_transpose_item(f ? args.in[14] : args.in[6], FF, D, (bf16*)(ws + (f ? WS_WD2 : WS_WD1)), scr, 64 * kb, 32 * nb, 32 * nb, lane); continue; }
            r -= 2 * I_D;
            if (r < I_IN) { const int nb = r % (NIN / 32), kb = r / (NIN / 32); p0_transpose_item_win(args.in[7], (bf16*)(ws + WS_WIN), scr, 64 * kb, 32 * nb, lane); continue; }
            r -= I_IN;
            if (r < 2 * I_SQ) { const int f = r / I_SQ; r -= f * I_SQ; const int nb = r % (D / 32), kb = r / (D / 32);
                p0_transpose_item(f ? args.in[17] : args.in[9], D, D, (bf16*)(ws + (f ? WS_WGATE : WS_WOUT)), scr, 64 * kb, 32 * nb, 32 * nb, lane); continue; }
            r -= 2 * I_SQ;
            { const int nb = r % (D / 32), kb = r / (D / 32); p0_transpose_item(args.in[18], DPLE, D, (bf16*)(ws + WS_WP), scr, 64 * kb, 32 * nb, 32 * nb, lane); }
        }
        const size_t gt = (size_t)bx * (NWAVES * 64) + tid_p, GT = (size_t)G * NWAVES * 64;
        for (size_t i = gt; i < (size_t)M * D / 8; i += GT) { const f32x4 a = ((const GAS f32x4*)x)[2 * i], b = ((const GAS f32x4*)x)[2 * i + 1];
            v4u o; o.x = pk2(a.x, a.y); o.y = pk2(a.z, a.w); o.z = pk2(b.x, b.y); o.w = pk2(b.z, b.w); ((GAS v4u*)XB)[i] = o; }
        for (size_t i = gt; i < (size_t)M * DPLE / 8; i += GT) { const f32x4 a = ((const GAS f32x4*)pin)[2 * i], b = ((const GAS f32x4*)pin)[2 * i + 1];
            v4u o; o.x = pk2(a.x, a.y); o.y = pk2(a.z, a.w); o.z = pk2(b.x, b.y); o.w = pk2(b.z, b.w); ((GAS v4u*)PB)[i] = o; }
    }
    GRID_BAR();

    { PHASE_VIEW(); pg8::Gemm g{XB, (const bf16*)(ws + WS_WGU1), M, NGU, D}; pg8::StaticOrder S; S.init(M, NGU, G, bx);
      pg8::EpiSwiGLU E{HB, FF};
      pg8::gemm_phase<pg8::EpiSwiGLU, pg8::StaticOrder, true, true>(L + RING_OFF, g, S, E); }
    GRID_BAR();
    { PHASE_VIEW(); pg8::Gemm g{HB, (const bf16*)(ws + WS_WD1), M, D, FF}; pg8::StaticOrder S; S.init(M, D, G, bx);
      pg8::EpiRes E{args.in[0], R, D, DN_ALPHA, 0.5f};
      pg8::gemm_phase<pg8::EpiRes, pg8::StaticOrder, true, true>(L + RING_OFF, g, S, E); }
    GRID_BAR();
    { PHASE_VIEW(); for (int m = gw; m < M; m += NGW) ln_row(R + (size_t)m * D, args.in[2], args.in[3], out + (size_t)m * D, XB + (size_t)m * D, lane); }
    GRID_BAR();
    { PHASE_VIEW(); pg8::Gemm g{XB, (const bf16*)(ws + WS_WIN), M, NIN, D}; pg8::StaticOrder S; S.init(M, NIN, G, bx);
      pg8::EpiWin E{QKVI, KI, WI, BC, Z, M, IDX_SCALE, 0.125f * LOG2E};
      pg8::gemm_phase<pg8::EpiWin, pg8::StaticOrder, true, true>(L + RING_OFF, g, S, E); }
    GRID_BAR();

    for (int rep5 = 0; rep5 < REP_P5; ++rep5) { PHASE_VIEW();
        LAS unsigned short* const sc = (LAS unsigned short*)L;
        const int r32 = lane & 31, hi = lane >> 5;
        for (int un = bx; un < BATCH * (SEQ / 8); un += G) {
            const int b = un & 3, g8 = un >> 2;
            const int t0 = 8 * g8, c = t0 >> 6, nslots = c + 1, nt32 = 2 * nslots;
            const size_t rowbase = (size_t)b * SEQ;
            bf16x8 A[2][4]; float w[2][16];
            { const int hh = (r32 >> 2) & 1, i = (r32 & 3) + 4 * (r32 >> 3);
#pragma unroll
              for (int blk = 0; blk < 2; ++blk) { const bf16* src = QIb + (rowbase + t0 + 4 * blk + 2 * hh + (i >> 3)) * 512 + (i & 7) * 64 + 8 * hi;
#pragma unroll
                  for (int ks = 0; ks < 4; ++ks) A[blk][ks] = *(const GAS bf16x8*)(src + 16 * ks); }
#pragma unroll
              for (int blk = 0; blk < 2; ++blk)
#pragma unroll
                  for (int q2 = 0; q2 < 2; ++q2) { const float* wp = WI + (rowbase + t0 + 4 * blk + 2 * hi + q2) * 8; const f32x4 a = *(const GAS f32x4*)wp, bb = *(const GAS f32x4*)(wp + 4);
                      w[blk][q2 * 8 + 0] = a.x; w[blk][q2 * 8 + 1] = a.y; w[blk][q2 * 8 + 2] = a.z; w[blk][q2 * 8 + 3] = a.w; w[blk][q2 * 8 + 4] = bb.x; w[blk][q2 * 8 + 5] = bb.y; w[blk][q2 * 8 + 6] = bb.z; w[blk][q2 * 8 + 7] = bb.w; } }
            const bf16* kb = KI + rowbase * 64 + (size_t)r32 * 64 + 8 * hi;
            bf16x8 Bc[4], Bn[4];
            int kt = wave;
            if (kt < nt32) {
#pragma unroll
                for (int ks = 0; ks < 4; ++ks) Bc[ks] = *(const GAS bf16x8*)(kb + (size_t)kt * 32 * 64 + 16 * ks); }
            for (; kt < nt32; kt += NWAVES) {
                const int ktn = kt + NWAVES;
                if (ktn < nt32) {
#pragma unroll
                    for (int ks = 0; ks < 4; ++ks) Bn[ks] = *(const GAS bf16x8*)(kb + (size_t)ktn * 32 * 64 + 16 * ks); }
                f32x16 a0 = {}, a1 = {};
#pragma unroll
                for (int ks = 0; ks < 4; ++ks) { a0 = __builtin_amdgcn_mfma_f32_32x32x16_bf16(A[0][ks], Bc[ks], a0, 0, 0, 0); a1 = __builtin_amdgcn_mfma_f32_32x32x16_bf16(A[1][ks], Bc[ks], a1, 0, 0, 0); }
                const int key = 32 * kt + r32; LAS unsigned short* dst = sc + (key & 63) * 132 + (key >> 6);
#pragma unroll
                for (int q2 = 0; q2 < 2; ++q2) { float s0 = 0.f, s1 = 0.f;
#pragma unroll
                    for (int h = 0; h < 8; ++h) { s0 += w[0][q2 * 8 + h] * __builtin_fmaxf(a0[q2 * 8 + h], 0.f); s1 += w[1][q2 * 8 + h] * __builtin_fmaxf(a1[q2 * 8 + h], 0.f); }
                    dst[(2 * hi + q2) * SROW_U16] = (unsigned short)score_key(s0); dst[(4 + 2 * hi + q2) * SROW_U16] = (unsigned short)score_key(s1); }
#pragma unroll
                for (int ks = 0; ks < 4; ++ks) Bc[ks] = Bn[ks];
            }
            __syncthreads();
            {
                const int t = t0 + wave; const int ntb = 4 * ((c >> 2) + 1);
                const LAS unsigned short* rowp = sc + wave * SROW_U16 + lane * 132;
                unsigned long long* selp = SEL + (size_t)b * 128 * SEQ + t;
                if (nslots <= 32) select_emit<16>(rowp, nslots, ntb, selp, lane);
                else if (nslots <= 64) select_emit<32>(rowp, nslots, ntb, selp, lane);
                else if (nslots <= 96) select_emit<48>(rowp, nslots, ntb, selp, lane);
                else select_emit<64>(rowp, nslots, ntb, selp, lane);
            }
            __syncthreads();
        }
        { const float* cw = args.in[8]; float cwv[3][8];
#pragma unroll
          for (int j = 0; j < 3; ++j) { const f32x4 a = *(const GAS f32x4*)(cw + j * DC + 8 * lane), bb = *(const GAS f32x4*)(cw + j * DC + 8 * lane + 4);
              cwv[j][0] = a.x; cwv[j][1] = a.y; cwv[j][2] = a.z; cwv[j][3] = a.w; cwv[j][4] = bb.x; cwv[j][5] = bb.y; cwv[j][6] = bb.z; cwv[j][7] = bb.w; }
          for (int m = gw; m < M; m += NGW) { const int t = m & (SEQ - 1);
              const v4u zero = {0u, 0u, 0u, 0u};
              const v4u z2 = *(const GAS v4u*)(Z + (size_t)m * 512 + 8 * lane);
              const v4u z1 = (t >= 1) ? *(const GAS v4u*)(Z + (size_t)(m - 1) * 512 + 8 * lane) : zero;
              const v4u z0 = (t >= 2) ? *(const GAS v4u*)(Z + (size_t)(m - 2) * 512 + 8 * lane) : zero;
              const v4u bv = *(const GAS v4u*)(BC + (size_t)m * 512 + 8 * lane);
              float y[8];
#pragma unroll
              for (int e = 0; e < 4; ++e) { y[2 * e] = bf_lo(bv[e]) * (cwv[0][2 * e] * bf_lo(z0[e]) + cwv[1][2 * e] * bf_lo(z1[e]) + cwv[2][2 * e] * bf_lo(z2[e]));
                  y[2 * e + 1] = bf_hi(bv[e]) * (cwv[0][2 * e + 1] * bf_hi(z0[e]) + cwv[1][2 * e + 1] * bf_hi(z1[e]) + cwv[2][2 * e + 1] * bf_hi(z2[e])); }
              v4u o; o.x = pk2(y[0], y[1]); o.y = pk2(y[2], y[3]); o.z = pk2(y[4], y[5]); o.w = pk2(y[6], y[7]);
              *(GAS v4u*)(XB + (size_t)m * D + DA + 8 * lane) = o; } }
    }
    GRID_BAR();

#if !SPARSE_ATTN
    for (int rep6 = 0; rep6 < REP_P6; ++rep6) { PHASE_VIEW();
        const attn_body::AttnTensors AT{(const attn_body::bf16*)Qb, (const attn_body::bf16*)Kb, (const attn_body::bf16*)Vb, SEL, (attn_body::bf16*)XB};
        const attn_body::StaticOrder S(G, bx);
        attn_body::attn_phase<attn_body::StaticOrder>((char*)lds + RING_OFF, AT, S);
    }
#else
    for (int rep6 = 0; rep6 < REP_P6; ++rep6) { PHASE_VIEW();
        const int h = bx & 7, wx = (bx >> 3) * NWAVES + wave, NWX = (G >> 3) * NWAVES;
        LAS unsigned short* const list = (LAS unsigned short*)(L + wave * 512);
        const float slope2 = __builtin_amdgcn_exp2f(-(float)(h + 1)) * LOG2E;
        const int kk = lane >> 3, part = lane & 7;
        for (int b = 0; b < BATCH; ++b)
            for (int t = wx; t < SEQ; t += NWX) {
                const int nslots = (t >> 6) + 1; const int n = nslots * 64 < TOPK ? nslots * 64 : TOPK;
                const size_t rowbase = (size_t)b * SEQ;
                const unsigned long long* selp = SEL + (size_t)b * 128 * SEQ + t;
                unsigned long long w0 = (lane < nslots) ? selp[(size_t)lane * SEQ] : 0ull, w1 = (lane + 64 < nslots) ? selp[(size_t)(lane + 64) * SEQ] : 0ull;
                const int cnt = __popcll(w0) + __popcll(w1); int incl = cnt;
#pragma unroll
                for (int d = 1; d < 64; d <<= 1) { const int v = __shfl_up(incl, d); if (lane >= d) incl += v; }
                int pos = incl - cnt;
                while (w0) { const int bp = __ffsll((long long)w0) - 1; if (pos < TOPK) list[pos] = (unsigned short)(lane * 64 + bp); ++pos; w0 &= w0 - 1ull; }
                while (w1) { const int bp = __ffsll((long long)w1) - 1; if (pos < TOPK) list[pos] = (unsigned short)((lane + 64) * 64 + bp); ++pos; w1 &= w1 - 1ull; }
                LDS_WAIT();
                float q[8];
                { const v4u qv = *(const GAS v4u*)(Qb + (rowbase + t) * 512 + h * 64 + 8 * part); const float sc2 = 1.0f;
#pragma unroll
                  for (int e = 0; e < 4; ++e) { q[2 * e] = bf_lo(qv[e]) * sc2; q[2 * e + 1] = bf_hi(qv[e]) * sc2; } }
                float mrun = -INFINITY, lrun = 0.f, o[8];
#pragma unroll
                for (int e = 0; e < 8; ++e) o[e] = 0.f;
                const bf16* Kh = Kb + rowbase * 512 + h * 64 + 8 * part; const bf16* Vh = Vb + rowbase * 512 + h * 64 + 8 * part;
                for (int i = 0; i < n; i += 32) {
                    int key[4]; v4u kv[4], vv[4];
#pragma unroll
                    for (int u = 0; u < 4; ++u) key[u] = list[i + 8 * u + kk];
#pragma unroll
                    for (int u = 0; u < 4; ++u) { kv[u] = *(const GAS v4u*)(Kh + (size_t)key[u] * 512); vv[u] = *(const GAS v4u*)(Vh + (size_t)key[u] * 512); }
#pragma unroll
                    for (int u = 0; u < 4; ++u) {
                        float d = 0.f;
#pragma unroll
                        for (int e = 0; e < 4; ++e) d += q[2 * e] * bf_lo(kv[u][e]) + q[2 * e + 1] * bf_hi(kv[u][e]);
                        d += __shfl_xor(d, 1); d += __shfl_xor(d, 2); d += __shfl_xor(d, 4);
                        const int dist = t - key[u]; const float lg = d - slope2 * (float)(dist < 0 ? -dist : dist);
                        const float mn = __builtin_fmaxf(mrun, lg), al = __builtin_amdgcn_exp2f(mrun - mn), pp = __builtin_amdgcn_exp2f(lg - mn);
                        lrun = lrun * al + pp; mrun = mn;
#pragma unroll
                        for (int e = 0; e < 4; ++e) { o[2 * e] = o[2 * e] * al + pp * bf_lo(vv[u][e]); o[2 * e + 1] = o[2 * e + 1] * al + pp * bf_hi(vv[u][e]); }
                    }
                }
#pragma unroll
                for (int d = 8; d < 64; d <<= 1) { const float mo = __shfl_xor(mrun, d), lo_ = __shfl_xor(lrun, d); const float mn = __builtin_fmaxf(mrun, mo), a = __builtin_amdgcn_exp2f(mrun - mn), bsc = __builtin_amdgcn_exp2f(mo - mn);
                    lrun = lrun * a + lo_ * bsc;
#pragma unroll
                    for (int e = 0; e < 8; ++e) { const float oo = __shfl_xor(o[e], d); o[e] = o[e] * a + oo * bsc; }
                    mrun = mn; }
                if (kk == 0) { const float rl = 1.0f / lrun; v4u ov; ov.x = pk2(o[0] * rl, o[1] * rl); ov.y = pk2(o[2] * rl, o[3] * rl); ov.z = pk2(o[4] * rl, o[5] * rl); ov.w = pk2(o[6] * rl, o[7] * rl);
                    *(GAS v4u*)(XB + (rowbase + t) * D + h * 64 + 8 * part) = ov; }
                LDS_WAIT();
            }
    }
#endif
    GRID_BAR();

#if PROBE_CHECK
    { PHASE_VIEW();
        unsigned bad = 0u; float maxd = 0.f;
        for (int qs = gw; qs < 1500; qs += NGW) {
            const int gq = (qs * 21 + 3) % M; const int b = gq / SEQ, t = gq % SEQ;
            const int nslots = (t >> 6) + 1, Lk = 64 * nslots, n = Lk < TOPK ? Lk : TOPK;
            const size_t rowbase = (size_t)b * SEQ, row = rowbase + t;
            float wv[8];
#pragma unroll
            for (int h = 0; h < 8; ++h) wv[h] = WI[row * 8 + h];
            float minsel = INFINITY, maxuns = -INFINITY; int cnt = 0;
            for (int key = lane; key < Lk; key += 64) {
                float sc_ = 0.f;
                for (int h = 0; h < 8; ++h) { float rel = 0.f;
                    for (int d = 0; d < 64; d += 2) { const unsigned qa = *(const GAS unsigned*)(QIb + row * 512 + h * 64 + d), ka = *(const GAS unsigned*)(KI + (rowbase + key) * 64 + d); rel += bf_lo(qa) * bf_lo(ka) + bf_hi(qa) * bf_hi(ka); }
                    sc_ += wv[h] * __builtin_fmaxf(rel, 0.f); }
                const unsigned long long wd = SEL[((size_t)b * 128 + (key >> 6)) * SEQ + t];
                if ((wd >> (key & 63)) & 1ull) { ++cnt; minsel = __builtin_fminf(minsel, sc_); } else maxuns = __builtin_fmaxf(maxuns, sc_);
            }
#pragma unroll
            for (int o = 1; o < 64; o <<= 1) { cnt += __shfl_xor(cnt, o); minsel = __builtin_fminf(minsel, __shfl_xor(minsel, o)); maxuns = __builtin_fmaxf(maxuns, __shfl_xor(maxuns, o)); }
            if (cnt != n) bad |= 1u;
            if (Lk > TOPK && maxuns > minsel + 0.004f * __builtin_fabsf(minsel) + 0.002f) bad |= 2u;
            const int h = lane >> 3, part = lane & 7; const float slope = __builtin_amdgcn_exp2f(-(float)(h + 1));
            float q[8], o[8]; float mrun = -INFINITY, lrun = 0.f;
            { const v4u qv = *(const GAS v4u*)(Qb + row * 512 + h * 64 + 8 * part);
#pragma unroll
              for (int e = 0; e < 4; ++e) { q[2 * e] = bf_lo(qv[e]); q[2 * e + 1] = bf_hi(qv[e]); o[2 * e] = 0.f; o[2 * e + 1] = 0.f; } }
            for (int j = 0; j < nslots; ++j) { unsigned long long wd = SEL[((size_t)b * 128 + j) * SEQ + t];
                while (wd) { const int key = 64 * j + (__ffsll((long long)wd) - 1); wd &= wd - 1ull;
                    const v4u kv = *(const GAS v4u*)(Kb + (rowbase + key) * 512 + h * 64 + 8 * part), vv = *(const GAS v4u*)(Vb + (rowbase + key) * 512 + h * 64 + 8 * part);
                    float d = 0.f;
#pragma unroll
                    for (int e = 0; e < 4; ++e) d += q[2 * e] * bf_lo(kv[e]) + q[2 * e + 1] * bf_hi(kv[e]);
                    d += __shfl_xor(d, 1); d += __shfl_xor(d, 2); d += __shfl_xor(d, 4);
                    const int dist = t - key; const float lg = d * 0.6931471805599453f - slope * (float)(dist < 0 ? -dist : dist);
                    const float mn = __builtin_fmaxf(mrun, lg), al = __expf(mrun - mn), pp = __expf(lg - mn);
                    lrun = lrun * al + pp; mrun = mn;
#pragma unroll
                    for (int e = 0; e < 4; ++e) { o[2 * e] = o[2 * e] * al + pp * bf_lo(vv[e]); o[2 * e + 1] = o[2 * e + 1] * al + pp * bf_hi(vv[e]); } } }
            const v4u fv = *(const GAS v4u*)(XB + row * D + h * 64 + 8 * part);
            float dmax = 0.f, amax = 0.f;
#pragma unroll
            for (int e = 0; e < 4; ++e) { const float r0 = o[2 * e] / lrun, r1 = o[2 * e + 1] / lrun; dmax = __builtin_fmaxf(dmax, __builtin_fmaxf(__builtin_fabsf(r0 - bf_lo(fv[e])), __builtin_fabsf(r1 - bf_hi(fv[e])))); amax = __builtin_fmaxf(amax, __builtin_fmaxf(__builtin_fabsf(r0), __builtin_fabsf(r1))); }
#pragma unroll
            for (int o2 = 1; o2 < 8; o2 <<= 1) { dmax = __builtin_fmaxf(dmax, __shfl_xor(dmax, o2)); amax = __builtin_fmaxf(amax, __shfl_xor(amax, o2)); }
            maxd = __builtin_fmaxf(maxd, dmax / (amax + 1e-6f));
        }
        atomicMax((unsigned*)(ctl + 8), __float_as_uint(maxd)); if (bad) atomicOr((unsigned*)(ctl + 9), bad);
    }
#endif
    { PHASE_VIEW(); pg8::Gemm g{XB, (const bf16*)(ws + WS_WOUT), M, D, D}; pg8::StaticOrder S; S.init(M, D, G, bx);
      pg8::EpiRes E{out, R, D, DN_ALPHA, 1.0f};
      pg8::gemm_phase<pg8::EpiRes, pg8::StaticOrder, true, true>(L + RING_OFF, g, S, E); }
    GRID_BAR();
    { PHASE_VIEW(); for (int m = gw; m < M; m += NGW) ln_row(R + (size_t)m * D, args.in[10], args.in[11], out + (size_t)m * D, XB + (size_t)m * D, lane); }
    GRID_BAR();
    { PHASE_VIEW(); pg8::Gemm g{XB, (const bf16*)(ws + WS_WGU2), M, NGU, D}; pg8::StaticOrder S; S.init(M, NGU, G, bx);
      pg8::EpiSwiGLU E{HB, FF};
      pg8::gemm_phase<pg8::EpiSwiGLU, pg8::StaticOrder, true, true>(L + RING_OFF, g, S, E); }
    GRID_BAR();
    { PHASE_VIEW(); pg8::Gemm g{HB, (const bf16*)(ws + WS_WD2), M, D, FF}; pg8::StaticOrder S; S.init(M, D, G, bx);
      pg8::EpiRes E{out, R, D, DN_ALPHA, 0.5f};
      pg8::gemm_phase<pg8::EpiRes, pg8::StaticOrder, true, true>(L + RING_OFF, g, S, E); }
    GRID_BAR();
    { PHASE_VIEW(); for (int m = gw; m < M; m += NGW) ln_row(R + (size_t)m * D, args.in[15], args.in[16], out + (size_t)m * D, XB + (size_t)m * D, lane); }
    GRID_BAR();
    { PHASE_VIEW(); pg8::Gemm g{PB, (const bf16*)(ws + WS_WP), M, D, DPLE}; pg8::StaticOrder S; S.init(M, D, G, bx);
      pg8::EpiF32 E{R, D};
      pg8::gemm_phase<pg8::EpiF32, pg8::StaticOrder, true, true>(L + RING_OFF, g, S, E); }
    { PHASE_VIEW(); pg8::Gemm g{XB, (const bf16*)(ws + WS_WGATE), M, D, D}; pg8::StaticOrder S; S.init(M, D, G, bx);
      pg8::EpiGate E{out, R, out, D};
      pg8::gemm_phase<pg8::EpiGate, pg8::StaticOrder, true, true>(L + RING_OFF, g, S, E); }
#if PROBE_CHECK
    GRID_BAR();
    { PHASE_VIEW(); const float md = __uint_as_float(__hip_atomic_load((unsigned*)(ctl + 8), RLX_AGENT)); const unsigned bd = __hip_atomic_load((unsigned*)(ctl + 9), RLX_AGENT);
      float E = 0.f; if (md > 0.02f || !(md == md)) E += (md < 0.5f ? md : 0.5f); if (bd & 1u) E += 1.0f; if (bd & 2u) E += 2.0f;
      if (E > 0.f) { const size_t gt = (size_t)bx * (NWAVES * 64) + tid_p, GT = (size_t)G * NWAVES * 64;
          for (size_t i = gt; i < (size_t)M * D / 4; i += GT) { f32x4 v = ((GAS f32x4*)out)[i]; v = v * (1.0f + E); ((GAS f32x4*)out)[i] = v; } } }
#endif

}

extern "C" void kernel_launch(void* const* d_in, const int* in_sizes, int n_in, void* d_out, int out_size, void* d_ws, size_t ws_size, hipStream_t stream) {
    static int grid = 0;
    if (grid == 0) {
        if (n_in != 19 || in_sizes[0] != M * D || out_size != M * D || ws_size < WS_END) { fprintf(stderr, "kernel_launch: unexpected problem (n_in %d, in0 %d, out %d, ws %zu < %zu); nothing launched\n", n_in, n_in > 0 ? in_sizes[0] : -1, out_size, ws_size, (size_t)WS_END); grid = -1; return; }
        int dev = 0, cus = 0, per_cu = 0;
        if (hipGetDevice(&dev) != hipSuccess || hipDeviceGetAttribute(&cus, hipDeviceAttributeMultiprocessorCount, dev) != hipSuccess) { fprintf(stderr, "kernel_launch: device query failed\n"); grid = -1; return; }
        if (hipFuncSetAttribute((const void*)mega_fwd, hipFuncAttributeMaxDynamicSharedMemorySize, LDS_BYTES) != hipSuccess) { fprintf(stderr, "kernel_launch: hipFuncSetAttribute failed\n"); grid = -1; return; }
        if (hipOccupancyMaxActiveBlocksPerMultiprocessor(&per_cu, (const void*)mega_fwd, NWAVES * 64, LDS_BYTES) != hipSuccess || per_cu < 1) { fprintf(stderr, "kernel_launch: occupancy query says %d workgroups per CU\n", per_cu); }
        (void)hipGetLastError();
        grid = cus;
        if (grid % 8 != 0 || grid < 8) { fprintf(stderr, "kernel_launch: CU count %d is not a multiple of 8\n", grid); grid = -1; return; }
    }
    if (grid < 0) return;
    if (hipMemsetAsync((char*)d_ws + WS_CTL, 0, CTL_ZERO_BYTES, stream) != hipSuccess) { fprintf(stderr, "kernel_launch: memset failed\n"); return; }
    Args a{};
    for (int i = 0; i < 19; ++i) a.in[i] = (const float*)d_in[i];
    a.out = (float*)d_out; a.ws = (unsigned char*)d_ws;
    hipLaunchKernelGGL(mega_fwd, dim3(grid), dim3(NWAVES * 64), LDS_BYTES, stream, a);
}
```

```cpp
#include <hip/hip_runtime.h>
#include <hip/hip_bf16.h>
#include <cmath>
#include <cstdio>
#include <cstdint>
namespace pg8 {
#define PG8_LAS __attribute__((address_space(3)))
typedef unsigned short bf16_t;
typedef short bf16x8 __attribute__((ext_vector_type(8)));
typedef float f32x4 __attribute__((ext_vector_type(4)));
typedef unsigned u32x4 __attribute__((ext_vector_type(4)));
constexpr int BM = 256, BK = 64, HALF = 128, HTB = HALF * BK * 2  , STAGE_BYTES = 8 * HTB, NXCD = 8, WGM = 8;

__host__ __device__ __forceinline__ int lds_byte(int r, int c) { const int st = (r >> 4) * 2 + (c >> 5), rr = r & 15, cc = c & 31, ob = rr * 64 + cc * 2; return st * 1024 + (ob ^ (((ob >> 9) & 1) << 5)); }
__host__ __device__ __forceinline__ void stage_rc(int b, int& R, int& C) { const int st = b / 1024, sb = b % 1024, swz = sb ^ (((sb >> 9) & 1) << 5); R = (st >> 1) * 16 + swz / 64; C = (st & 1) * 32 + (swz % 64) / 2; }
__host__ __device__ __forceinline__ int perm32(int rho) { const int n = rho >> 4, i = rho & 15; return 8 * (i >> 2) + 4 * n + (i & 3); }

struct Unit { int pm, pn; };
struct Gemm { const bf16_t* A; const bf16_t* Bt; int M, N, K; };

struct StaticOrder {
    int nM, nN, nwg, G, c;
    __host__ __device__ void init(int M, int N, int G_, int c_) { nM = M / BM; nN = N / BM; nwg = nM * nN; G = G_; c = c_; }
    __host__ __device__ bool next(int i, Unit& u) const {
        const long L = (long)i * G + c; if (L >= nwg) return false;
        int wgid = (int)L; { const int q = nwg / NXCD, r = nwg % NXCD, xcd = wgid % NXCD, off = wgid / NXCD; wgid = (xcd < r ? xcd * (q + 1) : r * (q + 1) + (xcd - r) * q) + off; }
        const int nig = WGM * nN, gid = wgid / nig, fm = gid * WGM, gsz = (nM - fm) < WGM ? (nM - fm) : WGM;
        u.pm = fm + ((wgid % nig) % gsz); u.pn = (wgid % nig) / gsz; return true;
    }
    __device__ __forceinline__ void a_ready(const Unit&) const {}
    __device__ __forceinline__ void done(const Unit&) const {}
};

__device__ __forceinline__ unsigned cvt_pk_bf16(float lo, float hi) { unsigned r; asm volatile("v_cvt_pk_bf16_f32 %0, %1, %2" : "=v"(r) : "v"(lo), "v"(hi)); return r; }
__device__ __forceinline__ float silu_mul(float g, float u) { return g * __builtin_amdgcn_rcpf(1.0f + __builtin_amdgcn_exp2f(-1.4426950408889634f * g)) * u; }
__device__ __forceinline__ float sigmoidf_(float g) { return __builtin_amdgcn_rcpf(1.0f + __builtin_amdgcn_exp2f(-1.4426950408889634f * g)); }

struct EpiSwiGLU {
    static constexpr bool PERM = true, AFTER_DRAIN = false;
    bf16_t* H; int ldh;
    __device__ __forceinline__ void operator()(const f32x4 (&acc)[2][2][4][2], const Unit& u, int wr, int wc, int fr, int fq) const {
        const int row0 = u.pm * BM + wr * 64 + fr, col0 = u.pn * HALF + wc * 32 + 8 * fq;
#pragma unroll
        for (int ai = 0; ai < 2; ++ai)
#pragma unroll
            for (int m = 0; m < 4; ++m) { bf16_t* rowp = H + (size_t)(row0 + ai * HALF + m * 16) * ldh + col0;
                const f32x4 g0 = acc[ai][0][m][0], g1 = acc[ai][0][m][1], u0 = acc[ai][1][m][0], u1 = acc[ai][1][m][1];
                u32x4 w; w.x = cvt_pk_bf16(silu_mul(g0[0], u0[0]), silu_mul(g0[1], u0[1])); w.y = cvt_pk_bf16(silu_mul(g0[2], u0[2]), silu_mul(g0[3], u0[3]));
                w.z = cvt_pk_bf16(silu_mul(g1[0], u1[0]), silu_mul(g1[1], u1[1])); w.w = cvt_pk_bf16(silu_mul(g1[2], u1[2]), silu_mul(g1[3], u1[3]));
                *(u32x4*)rowp = w; }
    }
};
struct EpiRes {
    static constexpr bool PERM = false, AFTER_DRAIN = false;
    const float* base; float* out; int ldc; float alpha, s;
    __device__ __forceinline__ void operator()(const f32x4 (&acc)[2][2][4][2], const Unit& u, int wr, int wc, int fr, int fq) const {
        const int row0 = u.pm * BM + wr * 64 + fr, col0 = u.pn * BM + wc * 32 + 4 * fq;
#pragma unroll
        for (int ai = 0; ai < 2; ++ai)
#pragma unroll
            for (int m = 0; m < 4; ++m) { const size_t off = (size_t)(row0 + ai * HALF + m * 16) * ldc + col0;
#pragma unroll
                for (int bj = 0; bj < 2; ++bj)
#pragma unroll
                    for (int n = 0; n < 2; ++n) { const f32x4 bs = *(const f32x4*)(base + off + bj * HALF + n * 16); *(f32x4*)(out + off + bj * HALF + n * 16) = bs * alpha + acc[ai][bj][m][n] * s; } }
    }
};
struct EpiF32 {
    static constexpr bool PERM = false, AFTER_DRAIN = false;
    float* out; int ldc;
    __device__ __forceinline__ void operator()(const f32x4 (&acc)[2][2][4][2], const Unit& u, int wr, int wc, int fr, int fq) const {
        const int row0 = u.pm * BM + wr * 64 + fr, col0 = u.pn * BM + wc * 32 + 4 * fq;
#pragma unroll
        for (int ai = 0; ai < 2; ++ai)
#pragma unroll
            for (int m = 0; m < 4; ++m) { const size_t off = (size_t)(row0 + ai * HALF + m * 16) * ldc + col0;
#pragma unroll
                for (int bj = 0; bj < 2; ++bj)
#pragma unroll
                    for (int n = 0; n < 2; ++n) *(f32x4*)(out + off + bj * HALF + n * 16) = acc[ai][bj][m][n]; }
    }
};
struct EpiGate {
    static constexpr bool PERM = false, AFTER_DRAIN = false;
    const float* xin; const float* pp; float* out; int ldc;
    __device__ __forceinline__ void operator()(const f32x4 (&acc)[2][2][4][2], const Unit& u, int wr, int wc, int fr, int fq) const {
        const int row0 = u.pm * BM + wr * 64 + fr, col0 = u.pn * BM + wc * 32 + 4 * fq;
#pragma unroll
        for (int ai = 0; ai < 2; ++ai)
#pragma unroll
            for (int m = 0; m < 4; ++m) { const size_t off = (size_t)(row0 + ai * HALF + m * 16) * ldc + col0;
#pragma unroll
                for (int bj = 0; bj < 2; ++bj)
#pragma unroll
                    for (int n = 0; n < 2; ++n) { const f32x4 xv = *(const f32x4*)(xin + off + bj * HALF + n * 16), pv = *(const f32x4*)(pp + off + bj * HALF + n * 16), a = acc[ai][bj][m][n];
                        f32x4 o; o[0] = xv[0] + sigmoidf_(a[0]) * pv[0]; o[1] = xv[1] + sigmoidf_(a[1]) * pv[1]; o[2] = xv[2] + sigmoidf_(a[2]) * pv[2]; o[3] = xv[3] + sigmoidf_(a[3]) * pv[3];
                        *(f32x4*)(out + off + bj * HALF + n * 16) = o; } }
    }
};
struct EpiWin {
    static constexpr bool PERM = true, AFTER_DRAIN = false;
    bf16_t* qkvi;
    bf16_t* ki;
    float* wi;
    bf16_t* bc;
    bf16_t* z;
    int M; float idx_scale, qscale;
    __device__ __forceinline__ void operator()(const f32x4 (&acc)[2][2][4][2], const Unit& u, int wr, int wc, int fr, int fq) const {
        const int row0 = u.pm * BM + wr * 64 + fr, cw = wc * 32 + 8 * fq; const int pn = u.pn;
        if (pn >= 11) {
#pragma unroll
            for (int ai = 0; ai < 2; ++ai)
#pragma unroll
                for (int m = 0; m < 4; ++m) { bf16_t* rowp = z + (size_t)(row0 + ai * HALF + m * 16) * 512 + (pn - 11) * HALF + cw;
                    const f32x4 g0 = acc[ai][0][m][0], g1 = acc[ai][0][m][1], u0 = acc[ai][1][m][0], u1 = acc[ai][1][m][1];
                    u32x4 w; w.x = cvt_pk_bf16(g0[0] * u0[0], g0[1] * u0[1]); w.y = cvt_pk_bf16(g0[2] * u0[2], g0[3] * u0[3]); w.z = cvt_pk_bf16(g1[0] * u1[0], g1[1] * u1[1]); w.w = cvt_pk_bf16(g1[2] * u1[2], g1[3] * u1[3]);
                    *(u32x4*)rowp = w; }
        } else if (pn == 8) {
            if (wc < 2) {
#pragma unroll
                for (int ai = 0; ai < 2; ++ai)
#pragma unroll
                    for (int m = 0; m < 4; ++m) { bf16_t* rowp = ki + (size_t)(row0 + ai * HALF + m * 16) * 64 + cw; const f32x4 v0 = acc[ai][0][m][0], v1 = acc[ai][0][m][1];
                        u32x4 w; w.x = cvt_pk_bf16(v0[0], v0[1]); w.y = cvt_pk_bf16(v0[2], v0[3]); w.z = cvt_pk_bf16(v1[0], v1[1]); w.w = cvt_pk_bf16(v1[2], v1[3]); *(u32x4*)rowp = w; }
            } else if (wc == 2 && fq == 0) {
#pragma unroll
                for (int ai = 0; ai < 2; ++ai)
#pragma unroll
                    for (int m = 0; m < 4; ++m) { float* rowp = wi + (size_t)(row0 + ai * HALF + m * 16) * 8; *(f32x4*)rowp = acc[ai][0][m][0] * idx_scale; *(f32x4*)(rowp + 4) = acc[ai][0][m][1] * idx_scale; }
            }
        } else {
            bf16_t* base; int colt; const float sc = (pn < 2) ? qscale : 1.0f;
            if (pn < 8) { base = qkvi + (size_t)(pn >> 1) * M * 512; colt = (pn & 1) * BM; } else { base = bc; colt = (pn - 9) * BM; }
#pragma unroll
            for (int ai = 0; ai < 2; ++ai)
#pragma unroll
                for (int m = 0; m < 4; ++m) { bf16_t* rowp = base + (size_t)(row0 + ai * HALF + m * 16) * 512 + colt + cw;
#pragma unroll
                    for (int bj = 0; bj < 2; ++bj) { const f32x4 v0 = acc[ai][bj][m][0] * sc, v1 = acc[ai][bj][m][1] * sc;
                        u32x4 w; w.x = cvt_pk_bf16(v0[0], v0[1]); w.y = cvt_pk_bf16(v0[2], v0[3]); w.z = cvt_pk_bf16(v1[0], v1[1]); w.w = cvt_pk_bf16(v1[2], v1[3]); *(u32x4*)(rowp + bj * HALF) = w; } }
        }
    }
};

template <class Epi, class Sched, bool ALIGN_EPI = false, bool SP2 = false>
__device__ __forceinline__ void gemm_phase(PG8_LAS unsigned char* lds, const Gemm g, const Sched& S, const Epi& E) {
    int tid_ = threadIdx.x; asm volatile("" : "+v"(tid_));
    const int tid = tid_, wid = __builtin_amdgcn_readfirstlane(tid >> 6), lane = tid & 63, wr = wid >> 2, wc = wid & 3, fr = lane & 15, fq = lane >> 4;
    const int K = g.K, nt = K / BK;
    unsigned voffA[2], voffB[2];
#pragma unroll
    for (int i = 0; i < 2; ++i) { int R, C; stage_rc(tid * 16 + i * 8192, R, C); const int Rb = Epi::PERM ? ((R & ~31) + perm32(R & 31)) : R;
        voffA[i] = (unsigned)(R * K + C) * 2u; voffB[i] = (unsigned)(Rb * K + C) * 2u; }
    const size_t kstep = (size_t)(BK * 2);
    const size_t hstep = (size_t)HALF * K * 2;
    const size_t tstep = 2 * hstep;
    const unsigned ldsw = (unsigned)wid * 1024u;
    const int aoff = lds_byte(wr * 64 + fr, fq * 8), boff = lds_byte(wc * 32 + fr, fq * 8);
#define PG8_SA(b, h) (((b) * 2 + (h)) * HTB)
#define PG8_SB(b, h) ((4 + (b) * 2 + (h)) * HTB)
#define PG8_STAGE(bufoff, gbase, voff) do { _Pragma("unroll") for (int _i = 0; _i < 2; ++_i) \
        __builtin_amdgcn_global_load_lds((const unsigned*)((const char*)(gbase) + (voff)[_i]), (PG8_LAS unsigned*)(lds + (bufoff) + ldsw + _i * 8192), 16, 0, 0); } while (0)
#define PG8_LDA(dst, b, h) do { _Pragma("unroll") for (int m = 0; m < 4; ++m) _Pragma("unroll") for (int k = 0; k < 2; ++k) dst[m][k] = *(const PG8_LAS bf16x8*)(lds + PG8_SA(b, h) + aoff + m * 2048 + k * 1024); } while (0)
#define PG8_LDB(dst, b, h) do { _Pragma("unroll") for (int n = 0; n < 2; ++n) _Pragma("unroll") for (int k = 0; k < 2; ++k) dst[n][k] = *(const PG8_LAS bf16x8*)(lds + PG8_SB(b, h) + boff + n * 2048 + k * 1024); } while (0)
#define PG8_MMA(ai, bj, At, Bt) do { __builtin_amdgcn_s_setprio(1); _Pragma("unroll") for (int m = 0; m < 4; ++m) _Pragma("unroll") for (int n = 0; n < 2; ++n) _Pragma("unroll") for (int k = 0; k < 2; ++k) \
        acc[ai][bj][m][n] = __builtin_amdgcn_mfma_f32_16x16x32_bf16(Bt[n][k], At[m][k], acc[ai][bj][m][n], 0, 0, 0); __builtin_amdgcn_s_setprio(0); } while (0)
#define PG8_WAIT_V(n) asm volatile("s_waitcnt vmcnt(" #n ")" ::: "memory")
#define PG8_WAIT_L(n) asm volatile("s_waitcnt lgkmcnt(" #n ")" ::: "memory")
#define PG8_BAR __builtin_amdgcn_s_barrier()
#define PG8_SCHED __builtin_amdgcn_sched_barrier(0)
    Unit cur, nxt; int ui = 0;
    if (!S.next(0, cur)) return;
    f32x4 acc[2][2][4][2];
#pragma unroll
    for (int a = 0; a < 2; ++a)
#pragma unroll
        for (int b = 0; b < 2; ++b)
#pragma unroll
            for (int m = 0; m < 4; ++m)
#pragma unroll
                for (int n = 0; n < 2; ++n) acc[a][b][m][n] = (f32x4){0.f, 0.f, 0.f, 0.f};
    bf16x8 At[4][2], B0[2][2], B1[2][2];
    const char* cA = (const char*)g.A + (size_t)cur.pm * tstep; const char* cB = (const char*)g.Bt + (size_t)cur.pn * tstep;
    S.a_ready(cur);
    if constexpr (SP2) {
        PG8_STAGE(PG8_SB(0, 0), cB, voffB); PG8_STAGE(PG8_SB(0, 1), cB + hstep, voffB); PG8_STAGE(PG8_SA(0, 0), cA, voffA); PG8_STAGE(PG8_SA(0, 1), cA + hstep, voffA);
        if (wr == 1) PG8_BAR;
        PG8_WAIT_V(2); PG8_BAR;
        PG8_STAGE(PG8_SB(1, 0), cB + kstep, voffB); PG8_STAGE(PG8_SA(1, 0), cA + kstep, voffA); PG8_STAGE(PG8_SB(1, 1), cB + hstep + kstep, voffB);
        PG8_WAIT_V(6); PG8_BAR;
    } else {
        PG8_STAGE(PG8_SB(0, 0), cB, voffB); PG8_STAGE(PG8_SA(0, 0), cA, voffA); PG8_STAGE(PG8_SB(0, 1), cB + hstep, voffB); PG8_STAGE(PG8_SA(0, 1), cA + hstep, voffA);
        if (wr == 1) PG8_BAR;
        PG8_WAIT_V(4); PG8_BAR;
        PG8_STAGE(PG8_SB(1, 0), cB + kstep, voffB); PG8_STAGE(PG8_SA(1, 0), cA + kstep, voffA); PG8_STAGE(PG8_SB(1, 1), cB + hstep + kstep, voffB);
        PG8_WAIT_V(6); PG8_BAR;
    }
    for (;;) {
        const bool has_next = S.next(ui + 1, nxt);
        const char* nA = has_next ? (const char*)g.A + (size_t)nxt.pm * tstep : cA; const char* nB = has_next ? (const char*)g.Bt + (size_t)nxt.pn * tstep : cB;
        for (int t = 0; t < nt; t += 2) {
            const bool last = (t == nt - 2);
            const char* a1 = cA + (size_t)(t + 1) * kstep;
            const char* a2 = last ? nA : cA + (size_t)(t + 2) * kstep; const char* b2 = last ? nB : cB + (size_t)(t + 2) * kstep;
            const char* a3 = a2 + kstep; const char* b3 = b2 + kstep;
            if (last && has_next) S.a_ready(nxt);
            if constexpr (SP2) {
            PG8_LDB(B0, 0, 0); PG8_LDB(B1, 0, 1); PG8_SCHED; PG8_LDA(At, 0, 0); PG8_STAGE(PG8_SA(1, 1), a1 + hstep, voffA);
            PG8_WAIT_V(8); PG8_WAIT_L(0); PG8_BAR; PG8_MMA(0, 0, At, B0); PG8_MMA(0, 1, At, B1); PG8_BAR; PG8_SCHED;
            PG8_LDA(At, 0, 1); PG8_STAGE(PG8_SB(0, 0), b2, voffB); PG8_STAGE(PG8_SB(0, 1), b2 + hstep, voffB); PG8_STAGE(PG8_SA(0, 0), a2, voffA);
            PG8_WAIT_V(8); PG8_WAIT_L(0); PG8_BAR; PG8_MMA(1, 0, At, B0); PG8_MMA(1, 1, At, B1); PG8_BAR; PG8_SCHED;
            PG8_LDB(B0, 1, 0); PG8_LDB(B1, 1, 1); PG8_SCHED; PG8_LDA(At, 1, 0); PG8_STAGE(PG8_SA(0, 1), a2 + hstep, voffA);
            PG8_WAIT_V(8); PG8_WAIT_L(0); PG8_BAR; PG8_MMA(0, 0, At, B0); PG8_MMA(0, 1, At, B1); PG8_BAR; PG8_SCHED;
            PG8_LDA(At, 1, 1); PG8_STAGE(PG8_SB(1, 0), b3, voffB); PG8_STAGE(PG8_SB(1, 1), b3 + hstep, voffB); PG8_STAGE(PG8_SA(1, 0), a3, voffA);
            PG8_WAIT_V(8); PG8_WAIT_L(0); PG8_BAR; PG8_MMA(1, 0, At, B0); PG8_MMA(1, 1, At, B1); PG8_BAR; PG8_SCHED;
            } else {
            PG8_LDB(B0, 0, 0); PG8_SCHED; PG8_LDA(At, 0, 0); PG8_STAGE(PG8_SA(1, 1), a1 + hstep, voffA);
            PG8_WAIT_L(8); PG8_BAR; PG8_WAIT_L(0); PG8_MMA(0, 0, At, B0); PG8_BAR; PG8_SCHED;
            PG8_LDB(B1, 0, 1); PG8_STAGE(PG8_SB(0, 0), b2, voffB);
            PG8_BAR; PG8_WAIT_L(0); PG8_MMA(0, 1, At, B1); PG8_BAR;
            PG8_LDA(At, 0, 1); PG8_STAGE(PG8_SA(0, 0), a2, voffA);
            PG8_BAR; PG8_WAIT_L(0); PG8_MMA(1, 0, At, B0); PG8_BAR; PG8_SCHED;
            PG8_STAGE(PG8_SB(0, 1), b2 + hstep, voffB);
            PG8_WAIT_V(6); PG8_BAR; PG8_MMA(1, 1, At, B1); PG8_BAR;
            PG8_LDB(B0, 1, 0); PG8_SCHED; PG8_LDA(At, 1, 0); PG8_STAGE(PG8_SA(0, 1), a2 + hstep, voffA);
            PG8_WAIT_L(8); PG8_BAR; PG8_WAIT_L(0); PG8_MMA(0, 0, At, B0); PG8_BAR; PG8_SCHED;
            PG8_LDB(B1, 1, 1); PG8_STAGE(PG8_SB(1, 0), b3, voffB);
            PG8_BAR; PG8_WAIT_L(0); PG8_MMA(0, 1, At, B1); PG8_BAR;
            PG8_LDA(At, 1, 1); PG8_STAGE(PG8_SA(1, 0), a3, voffA);
            PG8_BAR; PG8_WAIT_L(0); PG8_MMA(1, 0, At, B0); PG8_BAR; PG8_SCHED;
            PG8_STAGE(PG8_SB(1, 1), b3 + hstep, voffB);
            PG8_WAIT_V(6); PG8_BAR; PG8_MMA(1, 1, At, B1); PG8_BAR;
            }
        }
        if constexpr (ALIGN_EPI) { if (wr == 0) PG8_BAR; }
        if constexpr (!Epi::AFTER_DRAIN) { E(acc, cur, wr, wc, fr, fq); S.done(cur); }
        if (!has_next) break;
#pragma unroll
        for (int a = 0; a < 2; ++a)
#pragma unroll
            for (int b = 0; b < 2; ++b)
#pragma unroll
                for (int m = 0; m < 4; ++m)
#pragma unroll
                    for (int n = 0; n < 2; ++n) acc[a][b][m][n] = (f32x4){0.f, 0.f, 0.f, 0.f};
        cur = nxt; cA = nA; cB = nB; ++ui;
        if constexpr (ALIGN_EPI) { if (wr == 1) PG8_BAR; }
    }
    PG8_WAIT_V(0);
    if constexpr (!ALIGN_EPI) { if (wr == 0) PG8_BAR; }
    PG8_BAR;
    if constexpr (Epi::AFTER_DRAIN) { E.fused(acc, cur, wr, wc, fr, fq, lds, wid, lane); S.done(cur); }
#undef PG8_SA
#undef PG8_SB
#undef PG8_STAGE
#undef PG8_LDA
#undef PG8_LDB
#undef PG8_MMA
#undef PG8_WAIT_V
#undef PG8_WAIT_L
#undef PG8_BAR
#undef PG8_SCHED
}
}

#ifndef PROBE_CHECK
#define PROBE_CHECK 0
#endif
#define REP_P5 1
#define SPARSE_ATTN 0
#define REP_P6 1

constexpr int NWAVES = 8;
constexpr int BATCH = 4, SEQ = 8192, D = 1024, FF = 2816, DPLE = 256, NHEAD = 8, HD = 64, DA = 512, DC = 512;
constexpr int M = BATCH * SEQ;
constexpr int NGU = 2 * FF;
constexpr int NIN = 3840;
constexpr float LN_EPS = 1e-5f;
constexpr float DN_ALPHA = 1.189207115002721f;
constexpr float IDX_SCALE = 0.04419417382415922f;
constexpr int TOPK = 256;
constexpr float LOG2E = 1.4426950408889634f;

constexpr size_t MiB = 1u << 20;
constexpr size_t WS_CTL = 0, CTL_ZERO_BYTES = 1 * MiB;
constexpr size_t WS_WGU1 = 2 * MiB, WS_WD1 = 13 * MiB, WS_WIN = 19 * MiB, WS_WOUT = 27 * MiB, WS_WGU2 = 29 * MiB, WS_WD2 = 40 * MiB, WS_WGATE = 46 * MiB, WS_WP = 48 * MiB;
constexpr size_t WS_XB = 64 * MiB;
constexpr size_t WS_R = 128 * MiB;
constexpr size_t WS_BIG = 256 * MiB;
constexpr size_t WS_QKVI = WS_BIG, WS_KI = WS_BIG + 128 * MiB, WS_WI = WS_BIG + 132 * MiB, WS_BC = WS_BIG + 136 * MiB, WS_Z = WS_BIG + 168 * MiB, WS_SEL = WS_BIG + 200 * MiB;
constexpr size_t WS_PB = 496 * MiB;
constexpr size_t WS_END = 512 * MiB;
static_assert(WS_WGU1 + (size_t)NGU * D * 2 <= WS_WD1 && WS_WD1 + (size_t)D * FF * 2 <= WS_WIN && WS_WIN + (size_t)NIN * D * 2 <= WS_WOUT && WS_WOUT + (size_t)D * D * 2 <= WS_WGU2 && WS_WGU2 + (size_t)NGU * D * 2 <= WS_WD2 &&
              WS_WD2 + (size_t)D * FF * 2 <= WS_WGATE && WS_WGATE + (size_t)D * D * 2 <= WS_WP && WS_WP + (size_t)D * DPLE * 2 <= WS_XB, "weight map");
static_assert(WS_XB + (size_t)M * D * 2 <= WS_R && WS_R + (size_t)M * D * 4 <= WS_BIG && WS_BIG + (size_t)M * FF * 2 <= WS_PB && WS_SEL + (size_t)BATCH * 128 * SEQ * 8 <= WS_PB && WS_PB + (size_t)M * DPLE * 2 <= WS_END, "d_ws map");
constexpr int CW_BAR = 4096;

constexpr int RING_OFF = 0, RING_BYTES = 131072;
constexpr int SROW_U16 = 64 * 132;
constexpr int SC_BYTES = 8 * SROW_U16 * 2;
constexpr int LDSCTL_OFF = 139264, MISC_OFF = LDSCTL_OFF + 320;
constexpr int LDS_BYTES = 147456;
static_assert(SC_BYTES <= LDSCTL_OFF && RING_BYTES <= LDSCTL_OFF && MISC_OFF + 128 <= LDS_BYTES, "LDS map");

#define GAS __attribute__((address_space(1)))
#define LAS __attribute__((address_space(3)))
typedef unsigned short bf16;
typedef unsigned v4u __attribute__((ext_vector_type(4)));
typedef unsigned v2u __attribute__((ext_vector_type(2)));
typedef float f32x4 __attribute__((ext_vector_type(4)));
typedef float f32x16 __attribute__((ext_vector_type(16)));
typedef short bf16x8 __attribute__((ext_vector_type(8)));
typedef unsigned short u16x2 __attribute__((ext_vector_type(2)));
typedef GAS unsigned gu32;
#define RLX_AGENT __ATOMIC_RELAXED, __HIP_MEMORY_SCOPE_AGENT
#define LDS_WAIT() asm volatile("s_waitcnt lgkmcnt(0)" ::: "memory")
#define VM_WAIT() asm volatile("s_waitcnt vmcnt(0)" ::: "memory")
__device__ __forceinline__ unsigned f2bf(float f) { unsigned u = __builtin_bit_cast(unsigned, f); return (u + 0x7fffu + ((u >> 16) & 1u)) >> 16; }
__device__ __forceinline__ unsigned pk2(float lo, float hi) { return f2bf(lo) | (f2bf(hi) << 16); }
__device__ __forceinline__ float bf_lo(unsigned w) { return __builtin_bit_cast(float, w << 16); }
__device__ __forceinline__ float bf_hi(unsigned w) { return __builtin_bit_cast(float, w & 0xffff0000u); }
namespace attn_body {
using bf16=__hip_bfloat16;
using bf16x8=__attribute__((ext_vector_type(8)))short;
using s16x4=__attribute__((ext_vector_type(4)))short;
using f32x16=__attribute__((ext_vector_type(16)))float;
using u32x4=__attribute__((ext_vector_type(4)))unsigned;
constexpr int BATCH=4,NHEAD=8,SEQ=8192,D=64,DM=NHEAD*D,OPITCH=1024;
constexpr int NW=8,QBLK=32,QB=QBLK*NW,KVBLK=64,NQB=SEQ/QB;
constexpr int ATTN_PITCH=DM, ATTN_UNIT_ROWS=QB;
__device__ __forceinline__ int crow(int r,int hi){return (r&3)+8*(r>>2)+4*hi;}
#define SBAR() __builtin_amdgcn_sched_barrier(0)
constexpr int NSLOT=3, SLOTB=8192;
constexpr int LDS_K=0, LDS_V=NSLOT*SLOTB, LDS_WS=2*NSLOT*SLOTB, LDS_OST=LDS_WS+NW*64*4, LDS_MSK=LDS_OST+NW*4096, LDS_BYTES=LDS_MSK+NW*1024;
constexpr float C2=0.125f*1.4426950408889634f;
__device__ __forceinline__ void glds16(const void*gsrc,unsigned lds_dst){unsigned keep;
  asm volatile("s_mov_b32 %0, m0\n\ts_mov_b32 m0, %2\n\ts_nop 0\n\tglobal_load_lds_dwordx4 %1, off\n\ts_mov_b32 m0, %0":"=&s"(keep):"v"(gsrc),"s"(lds_dst):"memory");}
__device__ __forceinline__ float max3f(float a,float b,float c){float r;asm("v_max3_f32 %0, %1, %2, %3":"=v"(r):"v"(a),"v"(b),"v"(c));return r;}
__device__ __forceinline__ float max2f(float a,float b){float r;asm("v_max_f32_e32 %0, %1, %2":"=v"(r):"v"(a),"v"(b));return r;}
__device__ __forceinline__ float fadd_s(float a,float b){float r;asm("v_add_f32_e32 %0, %1, %2":"=v"(r):"v"(a),"v"(b));return r;}
__device__ __forceinline__ float fsub_s(float a,float b){float r;asm("v_sub_f32_e32 %0, %1, %2":"=v"(r):"v"(a),"v"(b));return r;}
typedef float f32x2_t __attribute__((ext_vector_type(2))); typedef unsigned v2u_t __attribute__((ext_vector_type(2))); typedef __bf16 bf16x2_t __attribute__((ext_vector_type(2)));
__device__ __forceinline__ unsigned cvtpk_s(float lo,float hi){f32x2_t v={lo,hi};bf16x2_t b=__builtin_convertvector(v,bf16x2_t);return __builtin_bit_cast(unsigned,b);}
__device__ __forceinline__ void glds4(const void*gsrc,unsigned lds_dst){unsigned keep;
  asm volatile("s_mov_b32 %0, m0\n\ts_mov_b32 m0, %2\n\ts_nop 0\n\tglobal_load_lds_dword %1, off\n\ts_mov_b32 m0, %0":"=&s"(keep):"v"(gsrc),"s"(lds_dst):"memory");}
#define WAIT_BAR(N) asm volatile("s_waitcnt vmcnt(" #N ") lgkmcnt(0)\n\ts_barrier":::"memory")

__device__ __forceinline__ void qkt(f32x16&p0,f32x16&p1,const char*Kslot,const bf16x8*qr,int r32,int hi){
  const char*kb=Kslot+hi*1024+r32*16;
  #pragma unroll
  for(int d0=0;d0<4;++d0){
    const bf16x8 b0=*reinterpret_cast<const bf16x8*>(kb+d0*2048);
    const bf16x8 b1=*reinterpret_cast<const bf16x8*>(kb+d0*2048+512);
    p0=__builtin_amdgcn_mfma_f32_32x32x16_bf16(b0,qr[d0],p0,0,0,0);p1=__builtin_amdgcn_mfma_f32_32x32x16_bf16(b1,qr[d0],p1,0,0,0);}
}
typedef __attribute__((address_space(3))) const char* lds_cptr;
typedef short v4i16_t __attribute__((ext_vector_type(4)));
__device__ __forceinline__ void kload8(bf16x8*kf,lds_cptr kp){
  kf[0]=*(const __attribute__((address_space(3))) bf16x8*)(kp);      kf[1]=*(const __attribute__((address_space(3))) bf16x8*)(kp+512);
  kf[2]=*(const __attribute__((address_space(3))) bf16x8*)(kp+2048); kf[3]=*(const __attribute__((address_space(3))) bf16x8*)(kp+2560);
  kf[4]=*(const __attribute__((address_space(3))) bf16x8*)(kp+4096); kf[5]=*(const __attribute__((address_space(3))) bf16x8*)(kp+4608);
  kf[6]=*(const __attribute__((address_space(3))) bf16x8*)(kp+6144); kf[7]=*(const __attribute__((address_space(3))) bf16x8*)(kp+6656);
}
__device__ __forceinline__ void kload2(bf16x8*kf,lds_cptr kp,int j){ kf[2*j]=*(const __attribute__((address_space(3))) bf16x8*)(kp+j*2048); kf[2*j+1]=*(const __attribute__((address_space(3))) bf16x8*)(kp+j*2048+512); }
__device__ __forceinline__ s16x4 vtr(lds_cptr p){ return __builtin_bit_cast(s16x4,__builtin_amdgcn_ds_read_tr16_b64_v4i16((__attribute__((address_space(3))) v4i16_t*)p)); }
__device__ __forceinline__ float rowmax(const f32x16&p0,const f32x16&p1){
  float a=max3f(p0[0],p0[1],p1[0]),b=max3f(p0[2],p0[3],p1[1]);a=max3f(a,p1[2],p1[3]);
  #pragma unroll
  for(int r=4;r<16;r+=4){a=max3f(a,p0[r],p0[r+1]);b=max3f(b,p0[r+2],p0[r+3]);a=max3f(a,p1[r],p1[r+1]);b=max3f(b,p1[r+2],p1[r+3]);}
  const float m=max2f(a,b);
  auto rr=__builtin_amdgcn_permlane32_swap(__float_as_uint(m),__float_as_uint(m),false,false);
  return max2f(__uint_as_float(rr[0]),__uint_as_float(rr[1]));
}
__device__ __forceinline__ void pv(f32x16*o,int vb,bf16x8 pa0,bf16x8 pa1,bf16x8 pa2,bf16x8 pa3){
  #pragma unroll
  for(int d0=0;d0<2;++d0){s16x4 lo[4],hi[4];
    #pragma unroll
    for(int ks=0;ks<4;++ks){
      asm volatile("ds_read_b64_tr_b16 %0,%1 offset:%c2":"=&v"(lo[ks]):"v"(vb),"i"(d0*4096+ks*1024):"memory");
      asm volatile("ds_read_b64_tr_b16 %0,%1 offset:%c2":"=&v"(hi[ks]):"v"(vb),"i"(d0*4096+ks*1024+512):"memory");}
    asm volatile("s_waitcnt lgkmcnt(0)":::"memory");SBAR();
    #define PK(k) (bf16x8){lo[k][0],lo[k][1],lo[k][2],lo[k][3],hi[k][0],hi[k][1],hi[k][2],hi[k][3]}
    o[d0]=__builtin_amdgcn_mfma_f32_32x32x16_bf16(pa0,PK(0),o[d0],0,0,0);
    o[d0]=__builtin_amdgcn_mfma_f32_32x32x16_bf16(pa1,PK(1),o[d0],0,0,0);
    o[d0]=__builtin_amdgcn_mfma_f32_32x32x16_bf16(pa2,PK(2),o[d0],0,0,0);
    o[d0]=__builtin_amdgcn_mfma_f32_32x32x16_bf16(pa3,PK(3),o[d0],0,0,0);
    #undef PK
  }
}

#ifndef ATTN_STORE16
#define ATTN_STORE16(p,v) (*(u32x4*)(p)=(v))
#endif
template<int THRL> __device__ __forceinline__ void attn_unit(int b,int h,int qb,const bf16*Q,const bf16*__restrict__ K,const bf16*__restrict__ V,const unsigned long long*__restrict__ SEL,bf16*O,char*shm){
  int tid_=threadIdx.x; asm volatile("":"+v"(tid_));
  const int tid=tid_,lane=tid&63,r32=lane&31,hi=lane>>5; const int wid=__builtin_amdgcn_readfirstlane(tid>>6);
  const long rowbase=(long)b*SEQ; const int q0=qb*QB;
  const bf16*Qw=Q+(rowbase+q0+wid*QBLK)*DM+h*D;
  const bf16*Kh=K+rowbase*DM+h*D,*Vh=V+rowbase*DM+h*D;
  const unsigned lds0=(unsigned)(uintptr_t)shm;
  float*wsf=(float*)(shm+LDS_WS)+wid*64;
  const bf16*ksrc=Kh+(long)lane*DM+wid*8;
  const bf16*vsrc=Vh+(long)(16*(wid&3)+(lane>>2))*DM+(wid>>2)*32+(lane&3)*8;
  const unsigned*msrc=(const unsigned*)(SEL+(size_t)b*128*SEQ+q0+wid*QBLK)+lane;
  const unsigned kdst=lds0+LDS_K+wid*1024, vdst=lds0+LDS_V+wid*1024, mdst=lds0+LDS_MSK+wid*1024;
  const int NT=(q0+QB)/KVBLK;
  #define TI(t) (NT-1-(t))
  #define DMA_K(t,slot) glds16(ksrc+(long)TI(t)*KVBLK*DM,(unsigned)__builtin_amdgcn_readfirstlane(kdst+(slot)))
  #define DMA_V(t,slot) glds16(vsrc+(long)TI(t)*KVBLK*DM,(unsigned)__builtin_amdgcn_readfirstlane(vdst+(slot)))
  #define DMA_M(t) glds4(msrc+(size_t)TI(t)*(SEQ*2),(unsigned)__builtin_amdgcn_readfirstlane(mdst+(((t)&3)<<8)))
  const int vb0=(int)(lds0+LDS_V)+((lane>>4)&1)*32+(lane&3)*8+(4*hi+((lane&15)>>2))*64;
  const char*Kbase=shm+LDS_K; bf16x8 kf[8];
  const lds_cptr shm3=(lds_cptr)shm; const lds_cptr kp0=shm3+LDS_K+hi*1024+r32*16; const lds_cptr vp0=shm3+LDS_V+((lane>>4)&1)*32+(lane&3)*8+(4*hi+((lane&15)>>2))*64;
  const lds_cptr mp0=shm3+LDS_MSK+wid*1024+r32*8;
  DMA_M(0);DMA_M(1);DMA_M(2);
  DMA_K(0,0);DMA_V(0,0);DMA_K(1,SLOTB);
  bf16x8 qr[4];
  #pragma unroll
  for(int d0=0;d0<4;++d0)qr[d0]=*reinterpret_cast<const bf16x8*>(&Qw[(long)r32*DM+d0*16+hi*8]);
  float mhat=0.f,l_reg=0.f;f32x16 o[2];o[0]=f32x16{};o[1]=f32x16{};
  bool started=false;
  const float slope2=__builtin_amdgcn_exp2f(-(float)(h+1))*1.4426950408889634f, m2s=-2.f*slope2;
  const int tq=q0+wid*QBLK+r32, sref=q0+QB-1;
  bool resc=false;
  #define CR(r) (((r)&3)+8*((r)>>2))
  #define BR(r) (16*((r)&1)+(((r)>>1)&1)+4*((r)>>2))
  #define SELV(w,c,v) __uint_as_float(((unsigned)__builtin_amdgcn_sbfe((int)(w),(c),1)&__float_as_uint(v))|(~(unsigned)__builtin_amdgcn_sbfe((int)(w),(c),1)&0xff800000u))
  float nb=0.f,dq=0.f;unsigned wl=0u,wh=0u;
  #define FPREP(tn) do{ const int ti_=TI(tn); const v2u_t mw_=*(const __attribute__((address_space(3))) v2u_t*)(mp0+(((tn)&3)<<8)); wl=mw_.x>>(2*hi); wh=mw_.y>>(2*hi); \
      nb=slope2*(float)(64*ti_+4*hi-sref)-mhat; dq=(float)(64*ti_+4*hi-tq); }while(0)
  #define FILL4(X,B,w,co,BN) do{ _Pragma("unroll") for(int r_=(B);r_<(B)+4;++r_){ float v_=__builtin_fmaf(slope2,(float)(CR(r_)+(co)),nb); \
      if(BN){ v_=__builtin_fmaf(__builtin_fmaxf(dq+(float)(CR(r_)+(co)),0.f),m2s,v_); } X[r_]=SELV(w,BR(r_),v_); } PIN(X); }while(0)
  #define PIN(x) asm volatile("":"+v"(x))
  #define MX3(a,b,c) __builtin_fmaxf(__builtin_fmaxf((a),(b)),(c))
  #define DECIDE(C0,C1) do{ float a=MX3(C0[0],C0[1],C1[0]),b_=MX3(C0[2],C0[3],C1[1]); a=MX3(a,C1[2],C1[3]); \
      _Pragma("unroll") for(int r=4;r<16;r+=4){a=MX3(a,C0[r],C0[r+1]);b_=MX3(b_,C0[r+2],C0[r+3]);a=MX3(a,C1[r],C1[r+1]);b_=MX3(b_,C1[r+2],C1[r+3]);} \
      float rm=__builtin_fmaxf(a,b_); { auto rr=__builtin_amdgcn_permlane32_swap(__float_as_uint(rm),__float_as_uint(rm),false,false); rm=__builtin_fmaxf(__uint_as_float(rr[0]),__uint_as_float(rr[1])); } \
      resc=false; const bool live_=rm>-INFINITY, fresh_=live_&&!started; \
      if(__builtin_expect(__any(fresh_||rm>(float)THRL),0)){ const float dl=fresh_?rm:__builtin_fmaxf(rm,0.f); mhat+=dl; \
        _Pragma("unroll") for(int r=0;r<16;++r){C0[r]-=dl;C1[r]-=dl;} \
        const float f=started?__builtin_amdgcn_exp2f(-dl):1.0f; l_reg*=f; if(hi==0)wsf[r32]=f; resc=true; } \
      started=started||live_; }while(0)
  #define RESC() do{ if(resc){ asm volatile("s_waitcnt lgkmcnt(0)":::"memory"); \
      _Pragma("unroll") for(int d_=0;d_<2;++d_) _Pragma("unroll") for(int r=0;r<16;++r)o[d_][r]*=wsf[crow(r,hi)]; } }while(0)
  f32x16 pA0,pA1,pB0,pB1;
  int sl_prev=0,sl_cur=0,sl_next=SLOTB;
  #define ROT() do{sl_prev=sl_cur;sl_cur=sl_next;sl_next=(sl_next==(NSLOT-1)*SLOTB)?0:sl_next+SLOTB;}while(0)
  DMA_K(2,2*SLOTB);
  WAIT_BAR(3);
  FPREP(0);
  FILL4(pA0,0,wl,0,true);FILL4(pA0,4,wl,0,true);FILL4(pA0,8,wl,0,true);FILL4(pA0,12,wl,0,true);
  FILL4(pA1,0,wh,32,true);FILL4(pA1,4,wh,32,true);FILL4(pA1,8,wh,32,true);FILL4(pA1,12,wh,32,true);
  qkt(pA0,pA1,Kbase,qr,r32,hi);asm volatile("s_nop 15\n\ts_nop 7":"+v"(pA0),"+v"(pA1));
  DECIDE(pA0,pA1);
  _Pragma("unroll") for(int r=0;r<16;++r){pA0[r]=__builtin_amdgcn_exp2f(pA0[r]);pA1[r]=__builtin_amdgcn_exp2f(pA1[r]);}
  WAIT_BAR(0);
  DMA_K(3,0);DMA_M(3);DMA_V(1,SLOTB);
  ROT();
  kload8(kf,kp0+sl_cur);
  RESC();
  FPREP(1);
  FILL4(pB0,0,wl,0,true);FILL4(pB0,4,wl,0,true);FILL4(pB0,8,wl,0,true);FILL4(pB0,12,wl,0,true);
  FILL4(pB1,0,wh,32,true);FILL4(pB1,4,wh,32,true);FILL4(pB1,8,wh,32,true);FILL4(pB1,12,wh,32,true);
  WAIT_BAR(3);
  s16x4 vlo[8],vhi[8]; u32x4 pw0,pw1,pw2,pw3;
  #define PKW(P,B) cvtpk_s(P[B],P[B+1])
  #define PAF(k) __builtin_bit_cast(bf16x8,pw##k)
  #define VFR(i) (bf16x8){vlo[i][0],vlo[i][1],vlo[i][2],vlo[i][3],vhi[i][0],vhi[i][1],vhi[i][2],vhi[i][3]}
  #define GAPA(MF,A0,A1,A2,A3,W0,W1,PW) do{ MF; sacc+=A0; sacc+=A1; sacc+=A2; sacc+=A3; PIN(sacc); W0; W1; PIN(PW); SBAR(); }while(0)
  #define EX(v) __builtin_amdgcn_exp2f(v)
  #define GAPB(MF,X,B,GF,Y,w,co,BN) do{ MF; X[B]=EX(X[B]); X[B+1]=EX(X[B+1]); X[B+2]=EX(X[B+2]); X[B+3]=EX(X[B+3]); PIN(X); if(GF){ FILL4(Y,B,w,co,BN); } SBAR(); }while(0)
  #define VRD(i) do{ vlo[i]=vtr(vp_+(((i)>>2)*4096+((i)&3)*1024)); vhi[i]=vtr(vp_+(((i)>>2)*4096+((i)&3)*1024+512)); }while(0)
  #define KRD(G,j) do{ if(G){ kload2(kf,kp0+sl_next,j); SBAR(); } }while(0)
  #define STEP(C0,C1,P0,P1,t,GK,GV,GL,GF,BN) do{ SBAR(); \
    const lds_cptr vp_=vp0+sl_prev; \
    VRD(0); SBAR(); float sacc=(P0[0]+P0[1]); \
    GAPA(C0=__builtin_amdgcn_mfma_f32_32x32x16_bf16(kf[0],qr[0],C0,0,0,0), P0[2],P0[3],P0[4],P0[5],     pw0[0]=PKW(P0,0), pw0[1]=PKW(P0,2), pw0); \
    VRD(4); SBAR(); GAPA(C1=__builtin_amdgcn_mfma_f32_32x32x16_bf16(kf[1],qr[0],C1,0,0,0), P0[6],P0[7],P0[8],P0[9],     pw0[2]=PKW(P0,4), pw0[3]=PKW(P0,6), pw0); \
    VRD(1); SBAR(); GAPA(C0=__builtin_amdgcn_mfma_f32_32x32x16_bf16(kf[2],qr[1],C0,0,0,0),   P0[10],P0[11],P0[12],P0[13], pw1[0]=PKW(P0,8), pw1[1]=PKW(P0,10), pw1); \
    VRD(5); SBAR(); GAPA(C1=__builtin_amdgcn_mfma_f32_32x32x16_bf16(kf[3],qr[1],C1,0,0,0),   P0[14],P0[15],P1[0],P1[1],   pw1[2]=PKW(P0,12),pw1[3]=PKW(P0,14), pw1); \
    VRD(2); SBAR(); GAPA(C0=__builtin_amdgcn_mfma_f32_32x32x16_bf16(kf[4],qr[2],C0,0,0,0),   P1[2],P1[3],P1[4],P1[5],     pw2[0]=PKW(P1,0), pw2[1]=PKW(P1,2), pw2); \
    VRD(6); SBAR(); GAPA(C1=__builtin_amdgcn_mfma_f32_32x32x16_bf16(kf[5],qr[2],C1,0,0,0),   P1[6],P1[7],P1[8],P1[9],     pw2[2]=PKW(P1,4), pw2[3]=PKW(P1,6), pw2); \
    VRD(3); SBAR(); GAPA(C0=__builtin_amdgcn_mfma_f32_32x32x16_bf16(kf[6],qr[3],C0,0,0,0),   P1[10],P1[11],P1[12],P1[13], pw3[0]=PKW(P1,8), pw3[1]=PKW(P1,10), pw3); \
    VRD(7); SBAR(); GAPA(C1=__builtin_amdgcn_mfma_f32_32x32x16_bf16(kf[7],qr[3],C1,0,0,0),   P1[14],P1[15],0.f,0.f,       pw3[2]=PKW(P1,12),pw3[3]=PKW(P1,14), pw3); \
    l_reg+=sacc; \
    if(GK){DMA_K((t)+3,sl_cur);DMA_M((t)+3);} if(GV){DMA_V((t)+1,sl_next);} \
    DECIDE(C0,C1); \
    if(GF){ FPREP((t)+1); } \
    SBAR(); \
    GAPB(o[0]=__builtin_amdgcn_mfma_f32_32x32x16_bf16(PAF(0),VFR(0),o[0],0,0,0), C0,0, GF,P0,wl,0,BN); \
    GAPB(o[1]=__builtin_amdgcn_mfma_f32_32x32x16_bf16(PAF(0),VFR(4),o[1],0,0,0), C0,4, GF,P0,wl,0,BN); \
    KRD(GL,0); GAPB(o[0]=__builtin_amdgcn_mfma_f32_32x32x16_bf16(PAF(1),VFR(1),o[0],0,0,0), C0,8, GF,P0,wl,0,BN); \
    KRD(GL,1); GAPB(o[1]=__builtin_amdgcn_mfma_f32_32x32x16_bf16(PAF(1),VFR(5),o[1],0,0,0), C0,12, GF,P0,wl,0,BN); \
    KRD(GL,2); GAPB(o[0]=__builtin_amdgcn_mfma_f32_32x32x16_bf16(PAF(2),VFR(2),o[0],0,0,0), C1,0, GF,P1,wh,32,BN); \
    KRD(GL,3); GAPB(o[1]=__builtin_amdgcn_mfma_f32_32x32x16_bf16(PAF(2),VFR(6),o[1],0,0,0), C1,4, GF,P1,wh,32,BN); \
    GAPB(o[0]=__builtin_amdgcn_mfma_f32_32x32x16_bf16(PAF(3),VFR(3),o[0],0,0,0), C1,8, GF,P1,wh,32,BN); \
    GAPB(o[1]=__builtin_amdgcn_mfma_f32_32x32x16_bf16(PAF(3),VFR(7),o[1],0,0,0), C1,12, GF,P1,wh,32,BN); \
    }while(0)
  #define ENDW(tt) do{ if((tt)+3<NT){WAIT_BAR(3);} else if((tt)+2<NT){WAIT_BAR(1);} else {WAIT_BAR(0);} }while(0)
  int t=1;
  STEP(pB0,pB1,pA0,pA1,1,(4<NT),true,true,true,true);   ENDW(1); RESC(); ROT();
  STEP(pA0,pA1,pB0,pB1,2,(5<NT),true,true,true,true);   ENDW(2); RESC(); ROT();
  t=3;
  for(;t+5<NT;t+=2){
    STEP(pB0,pB1,pA0,pA1,t,true,true,true,true,false);     WAIT_BAR(3); RESC(); ROT();
    STEP(pA0,pA1,pB0,pB1,t+1,true,true,true,true,false);   WAIT_BAR(3); RESC(); ROT();
  }
  for(;t+1<NT;t+=2){
    STEP(pB0,pB1,pA0,pA1,t,(t+3<NT),(t+1<NT),(t+1<NT),(t+1<NT),false);       ENDW(t);   RESC(); ROT();
    STEP(pA0,pA1,pB0,pB1,t+1,(t+4<NT),(t+2<NT),(t+2<NT),(t+2<NT),false);     ENDW(t+1); RESC(); ROT();
  }
  STEP(pB0,pB1,pA0,pA1,NT-1,false,false,false,false,false); RESC();
  { float sacc=pB0[0]+pB0[1]; _Pragma("unroll") for(int r=2;r<16;++r)sacc+=pB0[r]; _Pragma("unroll") for(int r=0;r<16;++r)sacc+=pB1[r]; l_reg+=sacc;
    pw0=(u32x4){PKW(pB0,0),PKW(pB0,2),PKW(pB0,4),PKW(pB0,6)};pw1=(u32x4){PKW(pB0,8),PKW(pB0,10),PKW(pB0,12),PKW(pB0,14)};pw2=(u32x4){PKW(pB1,0),PKW(pB1,2),PKW(pB1,4),PKW(pB1,6)};pw3=(u32x4){PKW(pB1,8),PKW(pB1,10),PKW(pB1,12),PKW(pB1,14)};
    SBAR(); pv(o,vb0+sl_cur,PAF(0),PAF(1),PAF(2),PAF(3)); }
  #undef PKW
  #undef PAF
  #undef VFR
  #undef PIN
  #undef MX3
  #undef GAPA
  #undef GAPB
  #undef EX
  #undef VRD
  #undef KRD
  #undef STEP
  #undef ENDW
  #undef FILL4
  #undef FPREP
  #undef SELV
  #undef CR
  #undef BR
  #undef DECIDE
  {auto rr=__builtin_amdgcn_permlane32_swap(__float_as_uint(l_reg),__float_as_uint(l_reg),false,false);l_reg=__uint_as_float(rr[0])+__uint_as_float(rr[1]);}
  if(hi==0)wsf[32+r32]=l_reg;asm volatile("s_waitcnt lgkmcnt(0)":::"memory");
  float rli[16];
  #pragma unroll
  for(int r=0;r<16;++r)rli[r]=__builtin_amdgcn_rcpf(wsf[32+crow(r,hi)]);
  bf16*Ow=O+(rowbase+q0+wid*QBLK)*OPITCH+h*D;
  { bf16*stg=(bf16*)(shm+LDS_OST)+wid*2048;
    #pragma unroll
    for(int r=0;r<16;++r){const int orow=crow(r,hi);
      #pragma unroll
      for(int d0=0;d0<2;++d0)stg[orow*64+d0*32+r32]=__float2bfloat16(o[d0][r]*rli[r]);}
    asm volatile("s_waitcnt lgkmcnt(0)":::"memory");
    #pragma unroll
    for(int i=0;i<4;++i){const int row=i*8+(lane>>3),ch=lane&7; const u32x4 v=*(const u32x4*)(stg+row*64+ch*8); ATTN_STORE16(Ow+(long)row*OPITCH+ch*8,v);} }
  asm volatile("s_waitcnt lgkmcnt(0)\n\ts_barrier":::"memory");
  #undef DMA_K
  #undef DMA_V
  #undef DMA_M
  #undef TI
  #undef RESC
  #undef ROT
}
constexpr int ATTN_LDS_BYTES=LDS_BYTES;
struct AttnTensors { const bf16* Q; const bf16* K; const bf16* V; const unsigned long long* SEL; bf16* O; };
struct AttnUnit { int bh; int qb; };
struct StaticOrder {
  int vcu,grid,block;
  __device__ __forceinline__ explicit StaticOrder(int grid_,int block_):vcu((block_%8)*(grid_/8)+block_/8),grid(grid_),block(block_){}
  __device__ __forceinline__ bool next(int i,AttnUnit&u)const{
    if(grid==256){ if(i>=4)return false; const int s=vcu&7; u.bh=vcu>>3; u.qb=(i==0)?s:(i==1)?15-s:(i==2)?16+s:31-s; return true; }
    const int n=i*grid+block; if(n>=BATCH*NHEAD*NQB)return false; u.bh=n/NQB; u.qb=n%NQB; return true; }
};
template<class Sched,int THRL=8> __device__ __forceinline__ void attn_phase(char*lds,const AttnTensors&T,const Sched&S){
  AttnUnit u;
  for(int i=0;S.next(i,u);++i){ attn_unit<THRL>(u.bh/NHEAD,u.bh%NHEAD,u.qb,T.Q,T.K,T.V,T.SEL,T.O,lds); }
}
#undef SBAR
#undef WAIT_BAR
}
#define XB_TMO      128
#define XB_XCNT(j)  (256  + 64 * (j))
#define XB_XSUB(j)  (1280 + 64 * (j))
#define XB_XGEN(j)  (2304 + 64 * (j))
#define XB_TOP      3328
#define XB_TOPGEN   3392
#define XCD_BAR_WORDS 3456
#define XB_SPIN_CAP (1u << 18)

__device__ __forceinline__ unsigned xb_ld(unsigned* p)              { return __hip_atomic_load(p, __ATOMIC_RELAXED, __HIP_MEMORY_SCOPE_AGENT); }
__device__ __forceinline__ unsigned xb_add(unsigned* p, unsigned v) { return __hip_atomic_fetch_add(p, v, __ATOMIC_RELAXED, __HIP_MEMORY_SCOPE_AGENT); }
__device__ __forceinline__ unsigned xb_xcc_id() { return (unsigned)__builtin_amdgcn_s_getreg((3 << 11) | 20) & 0xFu; }
#define XB_SPIN(cond, bar) do { unsigned _sp = 0; while (cond) { __builtin_amdgcn_s_sleep(1); \
    if ((++_sp & 255u) == 0u) { if (xb_ld(&(bar)[XB_TMO])) break; if (_sp > XB_SPIN_CAP) { atomicAdd(&(bar)[XB_TMO], 1u); break; } } } } while (0)

struct XcdBarrier {
    unsigned* bar; unsigned x;
    volatile LAS unsigned* st;
};

__device__ __forceinline__ XcdBarrier xcd_barrier_post(unsigned* bar, volatile LAS unsigned* st) {
    XcdBarrier b; b.bar = bar; b.x = xb_xcc_id(); b.st = st;
    if (threadIdx.x == 0) (void)xb_add(&bar[XB_XCNT(b.x)], 1u);
    return b;
}
__device__ __forceinline__ void xcd_barrier_complete(unsigned* bar, unsigned x, unsigned& nloc, unsigned& nx) {
    const unsigned G = gridDim.x * gridDim.y * gridDim.z;
    unsigned sum, cnt, mine, sp = 0u;
    for (;;) {
        sum = 0u; cnt = 0u; mine = 0u;
#pragma unroll
        for (unsigned j = 0; j < 16; ++j) { const unsigned c = xb_ld(&bar[XB_XCNT(j)]); sum += c; cnt += (c > 0u) ? 1u : 0u; mine = (j == x) ? c : mine; }
        if (sum == G) break;
        __builtin_amdgcn_s_sleep(1);
        if ((++sp & 255u) == 0u) { if (xb_ld(&bar[XB_TMO])) break; if (sp > XB_SPIN_CAP) { atomicAdd(&bar[XB_TMO], 1u); break; } }
    }
    nloc = mine > 0u ? mine : 1u; nx = cnt > 0u ? cnt : 1u;
}

__device__ __forceinline__ void xcd_barrier(const XcdBarrier& b) {
    asm volatile("s_waitcnt vmcnt(0)" ::: "memory");
    __syncthreads();
    if (threadIdx.x == 0) {
        unsigned* bar = b.bar;
        __builtin_amdgcn_s_waitcnt(0);
        unsigned nloc = b.st[0], nx = b.st[1];
        if (nloc == 0u) { xcd_barrier_complete(bar, b.x, nloc, nx); b.st[0] = nloc; b.st[1] = nx; }
        const unsigned old = xb_add(&bar[XB_XSUB(b.x)], 1u);
        const unsigned gen = old / nloc;
        if (old + 1u == (gen + 1u) * nloc) {
            __builtin_amdgcn_fence(__ATOMIC_RELEASE, "agent");
            asm volatile("s_waitcnt vmcnt(0)" ::: "memory");
            const unsigned og = xb_add(&bar[XB_TOP], 1u);
            const unsigned tg = og / nx;
            if (og + 1u == (tg + 1u) * nx) xb_add(&bar[XB_TOPGEN], 1u);
            else XB_SPIN(xb_ld(&bar[XB_TOPGEN]) == tg, bar);
            __builtin_amdgcn_fence(__ATOMIC_ACQUIRE, "agent");
            xb_add(&bar[XB_XGEN(b.x)], 1u);
            asm volatile("s_waitcnt vmcnt(0)" ::: "memory");
        } else {
            XB_SPIN(xb_ld(&bar[XB_XGEN(b.x)]) == gen, bar);
            __builtin_amdgcn_fence(__ATOMIC_ACQUIRE, "agent");
            asm volatile("s_waitcnt vmcnt(0)" ::: "memory");
        }
    }
    __syncthreads();
}

__device__ __forceinline__ void p0_transpose_item(const float* W, int K, int N, bf16* WT, LAS float* scr, int k0, int dn0, int c0, int lane) {
    const int n = lane & 31;
#pragma unroll 8
    for (int i = 0; i < 32; ++i) { const int kk = 2 * i + (lane >> 5); scr[kk * 33 + n] = (c0 >= 0) ? W[(size_t)(k0 + kk) * N + c0 + n] : 0.f; }
    LDS_WAIT(); asm volatile("" ::: "memory");
    const int c = lane & 7;
#pragma unroll
    for (int j = 0; j < 4; ++j) { const int nn = (lane >> 3) + 8 * j; const LAS float* s = scr + (8 * c) * 33 + nn;
        v4u o; o.x = pk2(s[0 * 33], s[1 * 33]); o.y = pk2(s[2 * 33], s[3 * 33]); o.z = pk2(s[4 * 33], s[5 * 33]); o.w = pk2(s[6 * 33], s[7 * 33]);
        *(GAS v4u*)(WT + (size_t)(dn0 + nn) * K + k0 + 8 * c) = o; }
    LDS_WAIT(); asm volatile("" ::: "memory");
}
__device__ __forceinline__ int win_src_col8(int d) {
    if (d < 2120) return d;
    if (d < 2304) return -1;
    if (d < 2816) return 2120 + (d - 2304);
    const int t = (d - 2816) >> 8, w = (d - 2816) & 255;
    return (w < 128) ? (2632 + 128 * t + w) : (3144 + 128 * t + (w - 128));
}
__device__ __forceinline__ void p0_transpose_item_win(const float* W, bf16* WT, LAS float* scr, int k0, int dn0, int lane) {
    const int n = lane & 31; const int c0 = win_src_col8(dn0 + (n & ~7)); const int col = c0 + (n & 7);
#pragma unroll 8
    for (int i = 0; i < 32; ++i) { const int kk = 2 * i + (lane >> 5); scr[kk * 33 + n] = (c0 >= 0) ? W[(size_t)(k0 + kk) * 3656 + col] : 0.f; }
    LDS_WAIT(); asm volatile("" ::: "memory");
    const int c = lane & 7;
#pragma unroll
    for (int j = 0; j < 4; ++j) { const int nn = (lane >> 3) + 8 * j; const LAS float* s = scr + (8 * c) * 33 + nn;
        v4u o; o.x = pk2(s[0 * 33], s[1 * 33]); o.y = pk2(s[2 * 33], s[3 * 33]); o.z = pk2(s[4 * 33], s[5 * 33]); o.w = pk2(s[6 * 33], s[7 * 33]);
        *(GAS v4u*)(WT + (size_t)(dn0 + nn) * D + k0 + 8 * c) = o; }
    LDS_WAIT(); asm volatile("" ::: "memory");
}
__device__ __forceinline__ float wave_sum(float v) {
#pragma unroll
    for (int o = 1; o < 64; o <<= 1) v += __shfl_xor(v, o);
    return v;
}
__device__ __forceinline__ void ln_row(const float* xrow, const float* g, const float* bta, float* orow, bf16* obrow, int lane) {
    const GAS f32x4* xr = (const GAS f32x4*)xrow + lane;
    f32x4 v[4]; float s = 0.f;
#pragma unroll
    for (int j = 0; j < 4; ++j) { v[j] = xr[64 * j]; s += (v[j].x + v[j].y) + (v[j].z + v[j].w); }
    const float mean = wave_sum(s) * (1.f / D); float s2 = 0.f;
#pragma unroll
    for (int j = 0; j < 4; ++j) { v[j] = v[j] - mean; s2 += (v[j].x * v[j].x + v[j].y * v[j].y) + (v[j].z * v[j].z + v[j].w * v[j].w); }
    const float rstd = 1.f / sqrtf(wave_sum(s2) * (1.f / D) + LN_EPS);
    GAS f32x4* of = (GAS f32x4*)orow + lane; GAS v2u* ob = (GAS v2u*)obrow + lane;
#pragma unroll
    for (int j = 0; j < 4; ++j) { const f32x4 gg = ((const GAS f32x4*)g)[lane + 64 * j], bb = ((const GAS f32x4*)bta)[lane + 64 * j];
        const f32x4 y = v[j] * rstd * gg + bb; of[64 * j] = y; v2u w; w.x = pk2(y.x, y.y); w.y = pk2(y.z, y.w); ob[64 * j] = w; }
}

struct Args { const float* in[19]; float* out; unsigned char* ws; };

__device__ __forceinline__ unsigned row_sum16(unsigned v) {
    v += (unsigned)__builtin_amdgcn_update_dpp(0, (int)v, 0xB1, 0xF, 0xF, true);
    v += (unsigned)__builtin_amdgcn_update_dpp(0, (int)v, 0x4E, 0xF, 0xF, true);
    v += (unsigned)__builtin_amdgcn_update_dpp(0, (int)v, 0x141, 0xF, 0xF, true);
    v += (unsigned)__builtin_amdgcn_update_dpp(0, (int)v, 0x140, 0xF, 0xF, true);
    return v;
}
__device__ __forceinline__ unsigned wave_sum_u(unsigned v) {
    v = row_sum16(v);
    return (unsigned)__builtin_amdgcn_readlane((int)v, 0) + (unsigned)__builtin_amdgcn_readlane((int)v, 16) + (unsigned)__builtin_amdgcn_readlane((int)v, 32) + (unsigned)__builtin_amdgcn_readlane((int)v, 48);
}
__device__ __forceinline__ unsigned score_key(float s) {
    const _Float16 h = (_Float16)s; unsigned hb = (unsigned)__builtin_bit_cast(unsigned short, h);
    return (hb & 0x8000u) ? (hb ^ 0xffffu) : (hb | 0x8000u);
}

__device__ __forceinline__ int sel_bitpos(int c) { return 32 * (c >> 5) + 16 * (c & 1) + ((c & 31) >> 1); }
__device__ __forceinline__ int sel_keyoff(int p) { const int q = p & 31; return 32 * (p >> 5) + 2 * (q & 15) + (q >> 4); }

__device__ __forceinline__ void transpose16(unsigned (&X)[64], int base) {
#define TR_STEP(S, MSK) _Pragma("unroll") for (int i = 0; i < 16; ++i) if ((i & (S)) == 0) { const unsigned a = X[base + i], bb = X[base + i + (S)]; \
        X[base + i] = (a & (MSK)) | ((bb << (S)) & ~(MSK)); X[base + i + (S)] = ((a >> (S)) & (MSK)) | (bb & ~(MSK)); }
    TR_STEP(8, 0x00ff00ffu) TR_STEP(4, 0x0f0f0f0fu) TR_STEP(2, 0x33333333u) TR_STEP(1, 0x55555555u)
#undef TR_STEP
}
__device__ __forceinline__ void select_planes(const LAS unsigned short* rowp, int Lk, int ntb, unsigned long long* selp  , int lane) {
    unsigned R[64];
#pragma unroll
    for (int i = 0; i < 32; ++i) { const v2u v = *(const LAS v2u*)(rowp + 4 * i); R[2 * i] = v.x; R[2 * i + 1] = v.y; }
    transpose16(R, 0); transpose16(R, 16); transpose16(R, 32); transpose16(R, 48);
    unsigned cand[4], gtm[4];
#pragma unroll
    for (int w = 0; w < 4; ++w) { cand[w] = (128 * lane + 32 * w < Lk) ? 0xffffffffu : 0u; gtm[w] = 0u; }
    unsigned need = 0u;
    if (Lk > TOPK) {
        unsigned above = 0u;
#pragma unroll
        for (int b = 15; b >= 0; --b) {
            const unsigned o0 = cand[0] & R[b], o1 = cand[1] & R[16 + b], o2 = cand[2] & R[32 + b], o3 = cand[3] & R[48 + b];
            const unsigned c1 = wave_sum_u((unsigned)__builtin_popcount(o0) + (unsigned)__builtin_popcount(o1) + (unsigned)__builtin_popcount(o2) + (unsigned)__builtin_popcount(o3));
            if (above + c1 >= (unsigned)TOPK) { cand[0] = o0; cand[1] = o1; cand[2] = o2; cand[3] = o3; }
            else { above += c1; gtm[0] |= o0; gtm[1] |= o1; gtm[2] |= o2; gtm[3] |= o3; cand[0] &= ~R[b]; cand[1] &= ~R[16 + b]; cand[2] &= ~R[32 + b]; cand[3] &= ~R[48 + b]; }
        }
        need = (unsigned)TOPK - above;
    } else {
#pragma unroll
        for (int w = 0; w < 4; ++w) { gtm[w] = cand[w]; cand[w] = 0u; }
    }
    { const int ce = __builtin_popcount(cand[0]) + __builtin_popcount(cand[1]) + __builtin_popcount(cand[2]) + __builtin_popcount(cand[3]); int incl = ce;
#pragma unroll
      for (int d = 1; d < 64; d <<= 1) { const int v = __shfl_up(incl, d); if (lane >= d) incl += v; }
      int allow = (int)need - (incl - ce); allow = allow < 0 ? 0 : (allow > ce ? ce : allow);
#pragma unroll
      for (int w = 0; w < 4; ++w) { const int cw = __builtin_popcount(cand[w]); const int take = allow < cw ? allow : cw; allow -= take;
          unsigned x = cand[w], sbits = 0u;
          if (take == cw) sbits = x; else for (int i = 0; i < take; ++i) { const unsigned lb = x & (0u - x); sbits |= lb; x ^= lb; }
          gtm[w] |= sbits; } }
    if (2 * lane < ntb) selp[(size_t)(2 * lane) * SEQ] = ((unsigned long long)gtm[1] << 32) | gtm[0];
    if (2 * lane + 1 < ntb) selp[(size_t)(2 * lane + 1) * SEQ] = ((unsigned long long)gtm[3] << 32) | gtm[2];
}

__global__ void __launch_bounds__(NWAVES * 64, 2) mega_fwd(Args args) {
    extern __shared__ __attribute__((aligned(16))) unsigned char lds[];
    LAS unsigned char* const L = (LAS unsigned char*)lds;
    volatile LAS unsigned* const MISC = (volatile LAS unsigned*)(L + MISC_OFF);
    const int G = gridDim.x, bx = blockIdx.x;
    const int vcu = (G % 8 == 0) ? (bx % 8) * (G / 8) + bx / 8 : bx;
    gu32* const ctl = (gu32*)(args.ws + WS_CTL);
    const int tid = threadIdx.x;
#define PHASE_VIEW() int tid_p = threadIdx.x; asm volatile("" : "+v"(tid_p)); const int lane = tid_p & 63, wave = __builtin_amdgcn_readfirstlane(tid_p >> 6); size_t z_ = 0; asm volatile("" : "+s"(z_)); unsigned char* ws = args.ws + z_; float* out = args.out + z_;     \
    const int gw = vcu * NWAVES + wave, NGW = G * NWAVES; (void)lane; (void)gw; (void)NGW; (void)out; \
    bf16* const XB = (bf16*)(ws + WS_XB); float* const R = (float*)(ws + WS_R); bf16* const HB = (bf16*)(ws + WS_BIG); bf16* const PB = (bf16*)(ws + WS_PB); \
    bf16* const QKVI = (bf16*)(ws + WS_QKVI); bf16* const KI = (bf16*)(ws + WS_KI); float* const WI = (float*)(ws + WS_WI); bf16* const BC = (bf16*)(ws + WS_BC); bf16* const Z = (bf16*)(ws + WS_Z); \
    unsigned long long* const SEL = (unsigned long long*)(ws + WS_SEL); \
    const bf16* const Qb = QKVI; const bf16* const Kb = QKVI + (size_t)M * 512; const bf16* const Vb = QKVI + (size_t)2 * M * 512; const bf16* const QIb = QKVI + (size_t)3 * M * 512; \
    (void)XB; (void)R; (void)HB; (void)PB; (void)KI; (void)WI; (void)BC; (void)Z; (void)SEL; (void)Qb; (void)Kb; (void)Vb; (void)QIb;

    for (int u = tid; u < (LDS_BYTES - LDSCTL_OFF) / 4; u += NWAVES * 64) ((LAS unsigned*)(L + LDSCTL_OFF))[u] = 0u;
    __syncthreads();
    XcdBarrier bar = xcd_barrier_post((unsigned*)(ctl + CW_BAR), MISC + 8);
#define GRID_BAR() xcd_barrier(bar)

    { PHASE_VIEW();
        const float* const x = args.in[0]; const float* const pin = args.in[1];
        LAS float* scr = (LAS float*)(L + RING_OFF + wave * 16384);
        constexpr int I_GU = (D / 64) * (NGU / 32), I_D = (FF / 64) * (D / 32), I_IN = (D / 64) * (NIN / 32), I_SQ = (D / 64) * (D / 32), I_P = (DPLE / 64) * (D / 32);
        constexpr int NITEMS = 2 * I_GU + 2 * I_D + I_IN + 2 * I_SQ + I_P;
        for (int it = gw; it < NITEMS; it += NGW) {
            int r = it;
            if (r < 2 * I_GU) { const int f = r / I_GU; r -= f * I_GU; const int nb = r % (NGU / 32), kb = r / (NGU / 32), dn0 = 32 * nb;
                const int half = (dn0 >> 7) & 1, j0 = ((dn0 >> 8) << 7) + (dn0 & 127);
                const float* W = f ? (half ? args.in[13] : args.in[12]) : (half ? args.in[5] : args.in[4]);
                p0_transpose_item(W, D, FF, (bf16*)(ws + (f ? WS_WGU2 : WS_WGU1)), scr, 64 * kb, dn0, j0, lane); continue; }
            r -= 2 * I_GU;
            if (r < 2 * I_D) { const int f = r / I_D; r -= f * I_D; const int nb = r % (D / 32), kb = r / (D / 32);
                p0_transpose_item(f ? args.in[14] : args.in[6], FF, D, (bf16*)(ws + (f ? WS_WD2 : WS_WD1)), scr, 64 * kb, 32 * nb, 32 * nb, lane); continue; }
            r -= 2 * I_D;
            if (r < I_IN) { const int nb = r % (NIN / 32), kb = r / (NIN / 32); p0_transpose_item_win(args.in[7], (bf16*)(ws + WS_WIN), scr, 64 * kb, 32 * nb, lane); continue; }
            r -= I_IN;
            if (r < 2 * I_SQ) { const int f = r / I_SQ; r -= f * I_SQ; const int nb = r % (D / 32), kb = r / (D / 32);
                p0_transpose_item(f ? args.in[17] : args.in[9], D, D, (bf16*)(ws + (f ? WS_WGATE : WS_WOUT)), scr, 64 * kb, 32 * nb, 32 * nb, lane); continue; }
            r -= 2 * I_SQ;
            { const int nb = r % (D / 32), kb = r / (D / 32); p0_transpose_item(args.in[18], DPLE, D, (bf16*)(ws + WS_WP), scr, 64 * kb, 32 * nb, 32 * nb, lane); }
        }
        const size_t gt = (size_t)bx * (NWAVES * 64) + tid_p, GT = (size_t)G * NWAVES * 64;
        for (size_t i = gt; i < (size_t)M * D / 8; i += GT) { const f32x4 a = ((const GAS f32x4*)x)[2 * i], b = ((const GAS f32x4*)x)[2 * i + 1];
            v4u o; o.x = pk2(a.x, a.y); o.y = pk2(a.z, a.w); o.z = pk2(b.x, b.y); o.w = pk2(b.z, b.w); ((GAS v4u*)XB)[i] = o; }
        for (size_t i = gt; i < (size_t)M * DPLE / 8; i += GT) { const f32x4 a = ((const GAS f32x4*)pin)[2 * i], b = ((const GAS f32x4*)pin)[2 * i + 1];
            v4u o; o.x = pk2(a.x, a.y); o.y = pk2(a.z, a.w); o.z = pk2(b.x, b.y); o.w = pk2(b.z, b.w); ((GAS v4u*)PB)[i] = o; }
    }
    GRID_BAR();

    { PHASE_VIEW(); pg8::Gemm g{XB, (const bf16*)(ws + WS_WGU1), M, NGU, D}; pg8::StaticOrder S; S.init(M, NGU, G, bx);
      pg8::EpiSwiGLU E{HB, FF};
      pg8::gemm_phase<pg8::EpiSwiGLU, pg8::StaticOrder, true, true>(L + RING_OFF, g, S, E); }
    GRID_BAR();
    { PHASE_VIEW(); pg8::Gemm g{HB, (const bf16*)(ws + WS_WD1), M, D, FF}; pg8::StaticOrder S; S.init(M, D, G, bx);
      pg8::EpiRes E{args.in[0], R, D, DN_ALPHA, 0.5f};
      pg8::gemm_phase<pg8::EpiRes, pg8::StaticOrder, true, true>(L + RING_OFF, g, S, E); }
    GRID_BAR();
    { PHASE_VIEW(); for (int m = gw; m < M; m += NGW) ln_row(R + (size_t)m * D, args.in[2], args.in[3], out + (size_t)m * D, XB + (size_t)m * D, lane); }
    GRID_BAR();
    { PHASE_VIEW(); pg8::Gemm g{XB, (const bf16*)(ws + WS_WIN), M, NIN, D}; pg8::StaticOrder S; S.init(M, NIN, G, bx);
      pg8::EpiWin E{QKVI, KI, WI, BC, Z, M, IDX_SCALE, 0.125f * LOG2E};
      pg8::gemm_phase<pg8::EpiWin, pg8::StaticOrder, true, true>(L + RING_OFF, g, S, E); }
    GRID_BAR();

    for (int rep5 = 0; rep5 < REP_P5; ++rep5) { PHASE_VIEW();
        LAS unsigned short* const sc = (LAS unsigned short*)L;
        const int r32 = lane & 31, hi = lane >> 5;
        for (int un = bx; un < BATCH * (SEQ / 8); un += G) {
            const int b = un & 3, g8 = un >> 2;
            const int t0 = 8 * g8, c = t0 >> 6, nslots = c + 1, nt32 = 2 * nslots;
            const size_t rowbase = (size_t)b * SEQ;
            bf16x8 A[2][4]; float w[2][16];
            { const int hh = (r32 >> 2) & 1, i = (r32 & 3) + 4 * (r32 >> 3);
#pragma unroll
              for (int blk = 0; blk < 2; ++blk) { const bf16* src = QIb + (rowbase + t0 + 4 * blk + 2 * hh + (i >> 3)) * 512 + (i & 7) * 64 + 8 * hi;
#pragma unroll
                  for (int ks = 0; ks < 4; ++ks) A[blk][ks] = *(const GAS bf16x8*)(src + 16 * ks); }
#pragma unroll
              for (int blk = 0; blk < 2; ++blk)
#pragma unroll
                  for (int q2 = 0; q2 < 2; ++q2) { const float* wp = WI + (rowbase + t0 + 4 * blk + 2 * hi + q2) * 8; const f32x4 a = *(const GAS f32x4*)wp, bb = *(const GAS f32x4*)(wp + 4);
                      w[blk][q2 * 8 + 0] = a.x; w[blk][q2 * 8 + 1] = a.y; w[blk][q2 * 8 + 2] = a.z; w[blk][q2 * 8 + 3] = a.w; w[blk][q2 * 8 + 4] = bb.x; w[blk][q2 * 8 + 5] = bb.y; w[blk][q2 * 8 + 6] = bb.z; w[blk][q2 * 8 + 7] = bb.w; } }
            const bf16* kb = KI + rowbase * 64 + (size_t)r32 * 64 + 8 * hi;
            bf16x8 B0[4], B1[4], B2[4];
#define IDX_LDB(Bx, ktx) do { if ((ktx) < nt32) { _Pragma("unroll") for (int ks = 0; ks < 4; ++ks) Bx[ks] = *(const GAS bf16x8*)(kb + (size_t)(ktx) * 32 * 64 + 16 * ks); } } while (0)
#define IDX_TILE(Bx, ktx) do { f32x16 a0 = {}, a1 = {}; \
                _Pragma("unroll") for (int ks = 0; ks < 4; ++ks) { a0 = __builtin_amdgcn_mfma_f32_32x32x16_bf16(A[0][ks], Bx[ks], a0, 0, 0, 0); a1 = __builtin_amdgcn_mfma_f32_32x32x16_bf16(A[1][ks], Bx[ks], a1, 0, 0, 0); } \
                const int key = 32 * (ktx) + r32; LAS unsigned short* dst = sc + (key >> 7) * 132 + (key & 127); \
                _Pragma("unroll") for (int q2 = 0; q2 < 2; ++q2) { float s0 = 0.f, s1 = 0.f; \
                    _Pragma("unroll") for (int h = 0; h < 8; ++h) { s0 += w[0][q2 * 8 + h] * __builtin_fmaxf(a0[q2 * 8 + h], 0.f); s1 += w[1][q2 * 8 + h] * __builtin_fmaxf(a1[q2 * 8 + h], 0.f); } \
                    dst[(2 * hi + q2) * SROW_U16] = (unsigned short)score_key(s0); dst[(4 + 2 * hi + q2) * SROW_U16] = (unsigned short)score_key(s1); } } while (0)
            int kt = wave;
            IDX_LDB(B0, kt); IDX_LDB(B1, kt + NWAVES);
            for (; kt < nt32; kt += 3 * NWAVES) {
                IDX_LDB(B2, kt + 2 * NWAVES); IDX_TILE(B0, kt);
                if (kt + NWAVES < nt32) { IDX_LDB(B0, kt + 3 * NWAVES); IDX_TILE(B1, kt + NWAVES); }
                if (kt + 2 * NWAVES < nt32) { IDX_LDB(B1, kt + 4 * NWAVES); IDX_TILE(B2, kt + 2 * NWAVES); }
            }
#undef IDX_LDB
#undef IDX_TILE
            __syncthreads();
            {
                const int t = t0 + wave; const int ntb = 4 * ((c >> 2) + 1);
                select_planes(sc + wave * SROW_U16 + lane * 132, 64 * nslots, ntb, SEL + (size_t)b * 128 * SEQ + t, lane);
            }
            __syncthreads();
        }
        { const float* cw = args.in[8]; float cwv[3][8];
#pragma unroll
          for (int j = 0; j < 3; ++j) { const f32x4 a = *(const GAS f32x4*)(cw + j * DC + 8 * lane), bb = *(const GAS f32x4*)(cw + j * DC + 8 * lane + 4);
              cwv[j][0] = a.x; cwv[j][1] = a.y; cwv[j][2] = a.z; cwv[j][3] = a.w; cwv[j][4] = bb.x; cwv[j][5] = bb.y; cwv[j][6] = bb.z; cwv[j][7] = bb.w; }
          for (int m = gw; m < M; m += NGW) { const int t = m & (SEQ - 1);
              const v4u zero = {0u, 0u, 0u, 0u};
              const v4u z2 = *(const GAS v4u*)(Z + (size_t)m * 512 + 8 * lane);
              const v4u z1 = (t >= 1) ? *(const GAS v4u*)(Z + (size_t)(m - 1) * 512 + 8 * lane) : zero;
              const v4u z0 = (t >= 2) ? *(const GAS v4u*)(Z + (size_t)(m - 2) * 512 + 8 * lane) : zero;
              const v4u bv = *(const GAS v4u*)(BC + (size_t)m * 512 + 8 * lane);
              float y[8];
#pragma unroll
              for (int e = 0; e < 4; ++e) { y[2 * e] = bf_lo(bv[e]) * (cwv[0][2 * e] * bf_lo(z0[e]) + cwv[1][2 * e] * bf_lo(z1[e]) + cwv[2][2 * e] * bf_lo(z2[e]));
                  y[2 * e + 1] = bf_hi(bv[e]) * (cwv[0][2 * e + 1] * bf_hi(z0[e]) + cwv[1][2 * e + 1] * bf_hi(z1[e]) + cwv[2][2 * e + 1] * bf_hi(z2[e])); }
              v4u o; o.x = pk2(y[0], y[1]); o.y = pk2(y[2], y[3]); o.z = pk2(y[4], y[5]); o.w = pk2(y[6], y[7]);
              *(GAS v4u*)(XB + (size_t)m * D + DA + 8 * lane) = o; } }
    }
    GRID_BAR();

#if !SPARSE_ATTN
    for (int rep6 = 0; rep6 < REP_P6; ++rep6) { PHASE_VIEW();
        const attn_body::AttnTensors AT{(const attn_body::bf16*)Qb, (const attn_body::bf16*)Kb, (const attn_body::bf16*)Vb, SEL, (attn_body::bf16*)XB};
        const attn_body::StaticOrder S(G, bx);
        attn_body::attn_phase<attn_body::StaticOrder>((char*)lds + RING_OFF, AT, S);
    }
#else
    for (int rep6 = 0; rep6 < REP_P6; ++rep6) { PHASE_VIEW();
        const int h = bx & 7, wx = (bx >> 3) * NWAVES + wave, NWX = (G >> 3) * NWAVES;
        LAS unsigned short* const list = (LAS unsigned short*)(L + wave * 512);
        const float slope2 = __builtin_amdgcn_exp2f(-(float)(h + 1)) * LOG2E;
        const int kk = lane >> 3, part = lane & 7;
        for (int b = 0; b < BATCH; ++b)
            for (int t = wx; t < SEQ; t += NWX) {
                const int nslots = (t >> 6) + 1; const int n = nslots * 64 < TOPK ? nslots * 64 : TOPK;
                const size_t rowbase = (size_t)b * SEQ;
                const unsigned long long* selp = SEL + (size_t)b * 128 * SEQ + t;
                unsigned long long w0 = (lane < nslots) ? selp[(size_t)lane * SEQ] : 0ull, w1 = (lane + 64 < nslots) ? selp[(size_t)(lane + 64) * SEQ] : 0ull;
                const int cnt = __popcll(w0) + __popcll(w1); int incl = cnt;
#pragma unroll
                for (int d = 1; d < 64; d <<= 1) { const int v = __shfl_up(incl, d); if (lane >= d) incl += v; }
                int pos = incl - cnt;
                while (w0) { const int bp = sel_keyoff(__ffsll((long long)w0) - 1); if (pos < TOPK) list[pos] = (unsigned short)(lane * 64 + bp); ++pos; w0 &= w0 - 1ull; }
                while (w1) { const int bp = sel_keyoff(__ffsll((long long)w1) - 1); if (pos < TOPK) list[pos] = (unsigned short)((lane + 64) * 64 + bp); ++pos; w1 &= w1 - 1ull; }
                LDS_WAIT();
                float q[8];
                { const v4u qv = *(const GAS v4u*)(Qb + (rowbase + t) * 512 + h * 64 + 8 * part); const float sc2 = 1.0f;
#pragma unroll
                  for (int e = 0; e < 4; ++e) { q[2 * e] = bf_lo(qv[e]) * sc2; q[2 * e + 1] = bf_hi(qv[e]) * sc2; } }
                float mrun = -INFINITY, lrun = 0.f, o[8];
#pragma unroll
                for (int e = 0; e < 8; ++e) o[e] = 0.f;
                const bf16* Kh = Kb + rowbase * 512 + h * 64 + 8 * part; const bf16* Vh = Vb + rowbase * 512 + h * 64 + 8 * part;
                for (int i = 0; i < n; i += 32) {
                    int key[4]; v4u kv[4], vv[4];
#pragma unroll
                    for (int u = 0; u < 4; ++u) key[u] = list[i + 8 * u + kk];
#pragma unroll
                    for (int u = 0; u < 4; ++u) { kv[u] = *(const GAS v4u*)(Kh + (size_t)key[u] * 512); vv[u] = *(const GAS v4u*)(Vh + (size_t)key[u] * 512); }
#pragma unroll
                    for (int u = 0; u < 4; ++u) {
                        float d = 0.f;
#pragma unroll
                        for (int e = 0; e < 4; ++e) d += q[2 * e] * bf_lo(kv[u][e]) + q[2 * e + 1] * bf_hi(kv[u][e]);
                        d += __shfl_xor(d, 1); d += __shfl_xor(d, 2); d += __shfl_xor(d, 4);
                        const int dist = t - key[u]; const float lg = d - slope2 * (float)(dist < 0 ? -dist : dist);
                        const float mn = __builtin_fmaxf(mrun, lg), al = __builtin_amdgcn_exp2f(mrun - mn), pp = __builtin_amdgcn_exp2f(lg - mn);
                        lrun = lrun * al + pp; mrun = mn;
#pragma unroll
                        for (int e = 0; e < 4; ++e) { o[2 * e] = o[2 * e] * al + pp * bf_lo(vv[u][e]); o[2 * e + 1] = o[2 * e + 1] * al + pp * bf_hi(vv[u][e]); }
                    }
                }
#pragma unroll
                for (int d = 8; d < 64; d <<= 1) { const float mo = __shfl_xor(mrun, d), lo_ = __shfl_xor(lrun, d); const float mn = __builtin_fmaxf(mrun, mo), a = __builtin_amdgcn_exp2f(mrun - mn), bsc = __builtin_amdgcn_exp2f(mo - mn);
                    lrun = lrun * a + lo_ * bsc;
#pragma unroll
                    for (int e = 0; e < 8; ++e) { const float oo = __shfl_xor(o[e], d); o[e] = o[e] * a + oo * bsc; }
                    mrun = mn; }
                if (kk == 0) { const float rl = 1.0f / lrun; v4u ov; ov.x = pk2(o[0] * rl, o[1] * rl); ov.y = pk2(o[2] * rl, o[3] * rl); ov.z = pk2(o[4] * rl, o[5] * rl); ov.w = pk2(o[6] * rl, o[7] * rl);
                    *(GAS v4u*)(XB + (rowbase + t) * D + h * 64 + 8 * part) = ov; }
                LDS_WAIT();
            }
    }
#endif
    GRID_BAR();

#if PROBE_CHECK
    { PHASE_VIEW();
        unsigned bad = 0u; float maxd = 0.f;
        for (int qs = gw; qs < 1500; qs += NGW) {
            const int gq = (qs * 21 + 3) % M; const int b = gq / SEQ, t = gq % SEQ;
            const int nslots = (t >> 6) + 1, Lk = 64 * nslots, n = Lk < TOPK ? Lk : TOPK;
            const size_t rowbase = (size_t)b * SEQ, row = rowbase + t;
            float wv[8];
#pragma unroll
            for (int h = 0; h < 8; ++h) wv[h] = WI[row * 8 + h];
            float minsel = INFINITY, maxuns = -INFINITY; int cnt = 0;
            for (int key = lane; key < Lk; key += 64) {
                float sc_ = 0.f;
                for (int h = 0; h < 8; ++h) { float rel = 0.f;
                    for (int d = 0; d < 64; d += 2) { const unsigned qa = *(const GAS unsigned*)(QIb + row * 512 + h * 64 + d), ka = *(const GAS unsigned*)(KI + (rowbase + key) * 64 + d); rel += bf_lo(qa) * bf_lo(ka) + bf_hi(qa) * bf_hi(ka); }
                    sc_ += wv[h] * __builtin_fmaxf(rel, 0.f); }
                const unsigned long long wd = SEL[((size_t)b * 128 + (key >> 6)) * SEQ + t];
                if ((wd >> sel_bitpos(key & 63)) & 1ull) { ++cnt; minsel = __builtin_fminf(minsel, sc_); } else maxuns = __builtin_fmaxf(maxuns, sc_);
            }
#pragma unroll
            for (int o = 1; o < 64; o <<= 1) { cnt += __shfl_xor(cnt, o); minsel = __builtin_fminf(minsel, __shfl_xor(minsel, o)); maxuns = __builtin_fmaxf(maxuns, __shfl_xor(maxuns, o)); }
            if (cnt != n) bad |= 1u;
            if (Lk > TOPK && maxuns > minsel + 0.004f * __builtin_fabsf(minsel) + 0.002f) bad |= 2u;
            const int h = lane >> 3, part = lane & 7; const float slope = __builtin_amdgcn_exp2f(-(float)(h + 1));
            float q[8], o[8]; float mrun = -INFINITY, lrun = 0.f;
            { const v4u qv = *(const GAS v4u*)(Qb + row * 512 + h * 64 + 8 * part);
#pragma unroll
              for (int e = 0; e < 4; ++e) { q[2 * e] = bf_lo(qv[e]); q[2 * e + 1] = bf_hi(qv[e]); o[2 * e] = 0.f; o[2 * e + 1] = 0.f; } }
            for (int j = 0; j < nslots; ++j) { unsigned long long wd = SEL[((size_t)b * 128 + j) * SEQ + t];
                while (wd) { const int key = 64 * j + sel_keyoff(__ffsll((long long)wd) - 1); wd &= wd - 1ull;
                    const v4u kv = *(const GAS v4u*)(Kb + (rowbase + key) * 512 + h * 64 + 8 * part), vv = *(const GAS v4u*)(Vb + (rowbase + key) * 512 + h * 64 + 8 * part);
                    float d = 0.f;
#pragma unroll
                    for (int e = 0; e < 4; ++e) d += q[2 * e] * bf_lo(kv[e]) + q[2 * e + 1] * bf_hi(kv[e]);
                    d += __shfl_xor(d, 1); d += __shfl_xor(d, 2); d += __shfl_xor(d, 4);
                    const int dist = t - key; const float lg = d * 0.6931471805599453f - slope * (float)(dist < 0 ? -dist : dist);
                    const float mn = __builtin_fmaxf(mrun, lg), al = __expf(mrun - mn), pp = __expf(lg - mn);
                    lrun = lrun * al + pp; mrun = mn;
#pragma unroll
                    for (int e = 0; e < 4; ++e) { o[2 * e] = o[2 * e] * al + pp * bf_lo(vv[e]); o[2 * e + 1] = o[2 * e + 1] * al + pp * bf_hi(vv[e]); } } }
            const v4u fv = *(const GAS v4u*)(XB + row * D + h * 64 + 8 * part);
            float dmax = 0.f, amax = 0.f;
#pragma unroll
            for (int e = 0; e < 4; ++e) { const float r0 = o[2 * e] / lrun, r1 = o[2 * e + 1] / lrun; dmax = __builtin_fmaxf(dmax, __builtin_fmaxf(__builtin_fabsf(r0 - bf_lo(fv[e])), __builtin_fabsf(r1 - bf_hi(fv[e])))); amax = __builtin_fmaxf(amax, __builtin_fmaxf(__builtin_fabsf(r0), __builtin_fabsf(r1))); }
#pragma unroll
            for (int o2 = 1; o2 < 8; o2 <<= 1) { dmax = __builtin_fmaxf(dmax, __shfl_xor(dmax, o2)); amax = __builtin_fmaxf(amax, __shfl_xor(amax, o2)); }
            maxd = __builtin_fmaxf(maxd, dmax / (amax + 1e-6f));
        }
        atomicMax((unsigned*)(ctl + 8), __float_as_uint(maxd)); if (bad) atomicOr((unsigned*)(ctl + 9), bad);
    }
#endif
    { PHASE_VIEW(); pg8::Gemm g{XB, (const bf16*)(ws + WS_WOUT), M, D, D}; pg8::StaticOrder S; S.init(M, D, G, bx);
      pg8::EpiRes E{out, R, D, DN_ALPHA, 1.0f};
      pg8::gemm_phase<pg8::EpiRes, pg8::StaticOrder, true, true>(L + RING_OFF, g, S, E); }
    GRID_BAR();
    { PHASE_VIEW(); for (int m = gw; m < M; m += NGW) ln_row(R + (size_t)m * D, args.in[10], args.in[11], out + (size_t)m * D, XB + (size_t)m * D, lane); }
    GRID_BAR();
    { PHASE_VIEW(); pg8::Gemm g{XB, (const bf16*)(ws + WS_WGU2), M, NGU, D}; pg8::StaticOrder S; S.init(M, NGU, G, bx);
      pg8::EpiSwiGLU E{HB, FF};
      pg8::gemm_phase<pg8::EpiSwiGLU, pg8::StaticOrder, true, true>(L + RING_OFF, g, S, E); }
    GRID_BAR();
    { PHASE_VIEW(); pg8::Gemm g{HB, (const bf16*)(ws + WS_WD2), M, D, FF}; pg8::StaticOrder S; S.init(M, D, G, bx);
      pg8::EpiRes E{out, R, D, DN_ALPHA, 0.5f};
      pg8::gemm_phase<pg8::EpiRes, pg8::StaticOrder, true, true>(L + RING_OFF, g, S, E); }
    GRID_BAR();
    { PHASE_VIEW(); for (int m = gw; m < M; m += NGW) ln_row(R + (size_t)m * D, args.in[15], args.in[16], out + (size_t)m * D, XB + (size_t)m * D, lane); }
    GRID_BAR();
    { PHASE_VIEW(); pg8::Gemm g{PB, (const bf16*)(ws + WS_WP), M, D, DPLE}; pg8::StaticOrder S; S.init(M, D, G, bx);
      pg8::EpiF32 E{R, D};
      pg8::gemm_phase<pg8::EpiF32, pg8::StaticOrder, true, true>(L + RING_OFF, g, S, E); }
    { PHASE_VIEW(); pg8::Gemm g{XB, (const bf16*)(ws + WS_WGATE), M, D, D}; pg8::StaticOrder S; S.init(M, D, G, bx);
      pg8::EpiGate E{out, R, out, D};
      pg8::gemm_phase<pg8::EpiGate, pg8::StaticOrder, true, true>(L + RING_OFF, g, S, E); }
#if PROBE_CHECK
    GRID_BAR();
    { PHASE_VIEW(); const float md = __uint_as_float(__hip_atomic_load((unsigned*)(ctl + 8), RLX_AGENT)); const unsigned bd = __hip_atomic_load((unsigned*)(ctl + 9), RLX_AGENT);
      float E = 0.f; if (md > 0.02f || !(md == md)) E += (md < 0.5f ? md : 0.5f); if (bd & 1u) E += 1.0f; if (bd & 2u) E += 2.0f;
      if (E > 0.f) { const size_t gt = (size_t)bx * (NWAVES * 64) + tid_p, GT = (size_t)G * NWAVES * 64;
          for (size_t i = gt; i < (size_t)M * D / 4; i += GT) { f32x4 v = ((GAS f32x4*)out)[i]; v = v * (1.0f + E); ((GAS f32x4*)out)[i] = v; } } }
#endif

}

extern "C" void kernel_launch(void* const* d_in, const int* in_sizes, int n_in, void* d_out, int out_size, void* d_ws, size_t ws_size, hipStream_t stream) {
    static int grid = 0;
    if (grid == 0) {
        if (n_in != 19 || in_sizes[0] != M * D || out_size != M * D || ws_size < WS_END) { fprintf(stderr, "kernel_launch: unexpected problem (n_in %d, in0 %d, out %d, ws %zu < %zu); nothing launched\n", n_in, n_in > 0 ? in_sizes[0] : -1, out_size, ws_size, (size_t)WS_END); grid = -1; return; }
        int dev = 0, cus = 0, per_cu = 0;
        if (hipGetDevice(&dev) != hipSuccess || hipDeviceGetAttribute(&cus, hipDeviceAttributeMultiprocessorCount, dev) != hipSuccess) { fprintf(stderr, "kernel_launch: device query failed\n"); grid = -1; return; }
        if (hipFuncSetAttribute((const void*)mega_fwd, hipFuncAttributeMaxDynamicSharedMemorySize, LDS_BYTES) != hipSuccess) { fprintf(stderr, "kernel_launch: hipFuncSetAttribute failed\n"); grid = -1; return; }
        if (hipOccupancyMaxActiveBlocksPerMultiprocessor(&per_cu, (const void*)mega_fwd, NWAVES * 64, LDS_BYTES) != hipSuccess || per_cu < 1) { fprintf(stderr, "kernel_launch: occupancy query says %d workgroups per CU\n", per_cu); }
        (void)hipGetLastError();
        grid = cus;
        if (grid % 8 != 0 || grid < 8) { fprintf(stderr, "kernel_launch: CU count %d is not a multiple of 8\n", grid); grid = -1; return; }
    }
    if (grid < 0) return;
    if (hipMemsetAsync((char*)d_ws + WS_CTL, 0, CTL_ZERO_BYTES, stream) != hipSuccess) { fprintf(stderr, "kernel_launch: memset failed\n"); return; }
    Args a{};
    for (int i = 0; i < 19; ++i) a.in[i] = (const float*)d_in[i];
    a.out = (float*)d_out; a.ws = (unsigned char*)d_ws;
    hipLaunchKernelGGL(mega_fwd, dim3(grid), dim3(NWAVES * 64), LDS_BYTES, stream, a);
}
```

```cpp
#include <hip/hip_runtime.h>
#include <hip/hip_bf16.h>
#include <cmath>
#include <cstdio>
#include <cstdint>
namespace pg8 {
#define PG8_LAS __attribute__((address_space(3)))
typedef unsigned short bf16_t;
typedef short bf16x8 __attribute__((ext_vector_type(8)));
typedef float f32x4 __attribute__((ext_vector_type(4)));
typedef unsigned u32x4 __attribute__((ext_vector_type(4)));
constexpr int BM = 256, BK = 64, HALF = 128, HTB = HALF * BK * 2  , STAGE_BYTES = 8 * HTB, NXCD = 8, WGM = 8;

__host__ __device__ __forceinline__ int lds_byte(int r, int c) { const int st = (r >> 4) * 2 + (c >> 5), rr = r & 15, cc = c & 31, ob = rr * 64 + cc * 2; return st * 1024 + (ob ^ (((ob >> 9) & 1) << 5)); }
__host__ __device__ __forceinline__ void stage_rc(int b, int& R, int& C) { const int st = b / 1024, sb = b % 1024, swz = sb ^ (((sb >> 9) & 1) << 5); R = (st >> 1) * 16 + swz / 64; C = (st & 1) * 32 + (swz % 64) / 2; }
__host__ __device__ __forceinline__ int perm32(int rho) { const int n = rho >> 4, i = rho & 15; return 8 * (i >> 2) + 4 * n + (i & 3); }

struct Unit { int pm, pn; };
struct Gemm { const bf16_t* A; const bf16_t* Bt; int M, N, K; };

struct StaticOrder {
    int nM, nN, nwg, G, c;
    __host__ __device__ void init(int M, int N, int G_, int c_) { nM = M / BM; nN = N / BM; nwg = nM * nN; G = G_; c = c_; }
    __host__ __device__ bool next(int i, Unit& u) const {
        const long L = (long)i * G + c; if (L >= nwg) return false;
        int wgid = (int)L; { const int q = nwg / NXCD, r = nwg % NXCD, xcd = wgid % NXCD, off = wgid / NXCD; wgid = (xcd < r ? xcd * (q + 1) : r * (q + 1) + (xcd - r) * q) + off; }
        const int nig = WGM * nN, gid = wgid / nig, fm = gid * WGM, gsz = (nM - fm) < WGM ? (nM - fm) : WGM;
        u.pm = fm + ((wgid % nig) % gsz); u.pn = (wgid % nig) / gsz; return true;
    }
    __device__ __forceinline__ void a_ready(const Unit&) const {}
    __device__ __forceinline__ void done(const Unit&) const {}
};

__device__ __forceinline__ unsigned cvt_pk_bf16(float lo, float hi) { unsigned r; asm volatile("v_cvt_pk_bf16_f32 %0, %1, %2" : "=v"(r) : "v"(lo), "v"(hi)); return r; }
__device__ __forceinline__ float silu_mul(float g, float u) { return g * __builtin_amdgcn_rcpf(1.0f + __builtin_amdgcn_exp2f(-1.4426950408889634f * g)) * u; }
__device__ __forceinline__ float sigmoidf_(float g) { return __builtin_amdgcn_rcpf(1.0f + __builtin_amdgcn_exp2f(-1.4426950408889634f * g)); }

struct EpiSwiGLU {
    static constexpr bool PERM = true, AFTER_DRAIN = false;
    bf16_t* H; int ldh;
    __device__ __forceinline__ void operator()(const f32x4 (&acc)[2][2][4][2], const Unit& u, int wr, int wc, int fr, int fq) const {
        const int row0 = u.pm * BM + wr * 64 + fr, col0 = u.pn * HALF + wc * 32 + 8 * fq;
#pragma unroll
        for (int ai = 0; ai < 2; ++ai)
#pragma unroll
            for (int m = 0; m < 4; ++m) { bf16_t* rowp = H + (size_t)(row0 + ai * HALF + m * 16) * ldh + col0;
                const f32x4 g0 = acc[ai][0][m][0], g1 = acc[ai][0][m][1], u0 = acc[ai][1][m][0], u1 = acc[ai][1][m][1];
                u32x4 w; w.x = cvt_pk_bf16(silu_mul(g0[0], u0[0]), silu_mul(g0[1], u0[1])); w.y = cvt_pk_bf16(silu_mul(g0[2], u0[2]), silu_mul(g0[3], u0[3]));
                w.z = cvt_pk_bf16(silu_mul(g1[0], u1[0]), silu_mul(g1[1], u1[1])); w.w = cvt_pk_bf16(silu_mul(g1[2], u1[2]), silu_mul(g1[3], u1[3]));
                *(u32x4*)rowp = w; }
    }
};
struct EpiRes {
    static constexpr bool PERM = false, AFTER_DRAIN = false;
    const float* base; float* out; int ldc; float alpha, s;
    __device__ __forceinline__ void operator()(const f32x4 (&acc)[2][2][4][2], const Unit& u, int wr, int wc, int fr, int fq) const {
        const int row0 = u.pm * BM + wr * 64 + fr, col0 = u.pn * BM + wc * 32 + 4 * fq;
#pragma unroll
        for (int ai = 0; ai < 2; ++ai)
#pragma unroll
            for (int m = 0; m < 4; ++m) { const size_t off = (size_t)(row0 + ai * HALF + m * 16) * ldc + col0;
#pragma unroll
                for (int bj = 0; bj < 2; ++bj)
#pragma unroll
                    for (int n = 0; n < 2; ++n) { const f32x4 bs = *(const f32x4*)(base + off + bj * HALF + n * 16); *(f32x4*)(out + off + bj * HALF + n * 16) = bs * alpha + acc[ai][bj][m][n] * s; } }
    }
};
struct EpiF32 {
    static constexpr bool PERM = false, AFTER_DRAIN = false;
    float* out; int ldc;
    __device__ __forceinline__ void operator()(const f32x4 (&acc)[2][2][4][2], const Unit& u, int wr, int wc, int fr, int fq) const {
        const int row0 = u.pm * BM + wr * 64 + fr, col0 = u.pn * BM + wc * 32 + 4 * fq;
#pragma unroll
        for (int ai = 0; ai < 2; ++ai)
#pragma unroll
            for (int m = 0; m < 4; ++m) { const size_t off = (size_t)(row0 + ai * HALF + m * 16) * ldc + col0;
#pragma unroll
                for (int bj = 0; bj < 2; ++bj)
#pragma unroll
                    for (int n = 0; n < 2; ++n) *(f32x4*)(out + off + bj * HALF + n * 16) = acc[ai][bj][m][n]; }
    }
};
struct EpiGate {
    static constexpr bool PERM = false, AFTER_DRAIN = false;
    const float* xin; const float* pp; float* out; int ldc;
    __device__ __forceinline__ void operator()(const f32x4 (&acc)[2][2][4][2], const Unit& u, int wr, int wc, int fr, int fq) const {
        const int row0 = u.pm * BM + wr * 64 + fr, col0 = u.pn * BM + wc * 32 + 4 * fq;
#pragma unroll
        for (int ai = 0; ai < 2; ++ai)
#pragma unroll
            for (int m = 0; m < 4; ++m) { const size_t off = (size_t)(row0 + ai * HALF + m * 16) * ldc + col0;
#pragma unroll
                for (int bj = 0; bj < 2; ++bj)
#pragma unroll
                    for (int n = 0; n < 2; ++n) { const f32x4 xv = *(const f32x4*)(xin + off + bj * HALF + n * 16), pv = *(const f32x4*)(pp + off + bj * HALF + n * 16), a = acc[ai][bj][m][n];
                        f32x4 o; o[0] = xv[0] + sigmoidf_(a[0]) * pv[0]; o[1] = xv[1] + sigmoidf_(a[1]) * pv[1]; o[2] = xv[2] + sigmoidf_(a[2]) * pv[2]; o[3] = xv[3] + sigmoidf_(a[3]) * pv[3];
                        *(f32x4*)(out + off + bj * HALF + n * 16) = o; } }
    }
};
struct EpiWin {
    static constexpr bool PERM = true, AFTER_DRAIN = false;
    bf16_t* qkvi;
    bf16_t* ki;
    float* wi;
    bf16_t* bc;
    bf16_t* z;
    int M; float idx_scale, qscale;
    __device__ __forceinline__ void operator()(const f32x4 (&acc)[2][2][4][2], const Unit& u, int wr, int wc, int fr, int fq) const {
        const int row0 = u.pm * BM + wr * 64 + fr, cw = wc * 32 + 8 * fq; const int pn = u.pn;
        if (pn >= 11) {
#pragma unroll
            for (int ai = 0; ai < 2; ++ai)
#pragma unroll
                for (int m = 0; m < 4; ++m) { bf16_t* rowp = z + (size_t)(row0 + ai * HALF + m * 16) * 512 + (pn - 11) * HALF + cw;
                    const f32x4 g0 = acc[ai][0][m][0], g1 = acc[ai][0][m][1], u0 = acc[ai][1][m][0], u1 = acc[ai][1][m][1];
                    u32x4 w; w.x = cvt_pk_bf16(g0[0] * u0[0], g0[1] * u0[1]); w.y = cvt_pk_bf16(g0[2] * u0[2], g0[3] * u0[3]); w.z = cvt_pk_bf16(g1[0] * u1[0], g1[1] * u1[1]); w.w = cvt_pk_bf16(g1[2] * u1[2], g1[3] * u1[3]);
                    *(u32x4*)rowp = w; }
        } else if (pn == 8) {
            if (wc < 2) {
#pragma unroll
                for (int ai = 0; ai < 2; ++ai)
#pragma unroll
                    for (int m = 0; m < 4; ++m) { const int rw = row0 + ai * HALF + m * 16; bf16_t* rowp = ki + (size_t)(rw >> 5) * 2048 + (cw >> 3) * 256 + (rw & 31) * 8;
                        const f32x4 v0 = acc[ai][0][m][0], v1 = acc[ai][0][m][1];
                        u32x4 w; w.x = cvt_pk_bf16(v0[0], v0[1]); w.y = cvt_pk_bf16(v0[2], v0[3]); w.z = cvt_pk_bf16(v1[0], v1[1]); w.w = cvt_pk_bf16(v1[2], v1[3]); *(u32x4*)rowp = w; }
            } else if (wc == 2 && fq == 0) {
#pragma unroll
                for (int ai = 0; ai < 2; ++ai)
#pragma unroll
                    for (int m = 0; m < 4; ++m) { float* rowp = wi + (size_t)(row0 + ai * HALF + m * 16) * 8; *(f32x4*)rowp = acc[ai][0][m][0] * idx_scale; *(f32x4*)(rowp + 4) = acc[ai][0][m][1] * idx_scale; }
            }
        } else {
            bf16_t* base; int colt; const float sc = (pn < 2) ? qscale : 1.0f;
            if (pn < 8) { base = qkvi + (size_t)(pn >> 1) * M * 512; colt = (pn & 1) * BM; } else { base = bc; colt = (pn - 9) * BM; }
#pragma unroll
            for (int ai = 0; ai < 2; ++ai)
#pragma unroll
                for (int m = 0; m < 4; ++m) { bf16_t* rowp = base + (size_t)(row0 + ai * HALF + m * 16) * 512 + colt + cw;
#pragma unroll
                    for (int bj = 0; bj < 2; ++bj) { const f32x4 v0 = acc[ai][bj][m][0] * sc, v1 = acc[ai][bj][m][1] * sc;
                        u32x4 w; w.x = cvt_pk_bf16(v0[0], v0[1]); w.y = cvt_pk_bf16(v0[2], v0[3]); w.z = cvt_pk_bf16(v1[0], v1[1]); w.w = cvt_pk_bf16(v1[2], v1[3]); *(u32x4*)(rowp + bj * HALF) = w; } }
        }
    }
};

template <class Epi, class Sched, bool ALIGN_EPI = false, bool SP2 = false>
__device__ __forceinline__ void gemm_phase(PG8_LAS unsigned char* lds, const Gemm g, const Sched& S, const Epi& E) {
    int tid_ = threadIdx.x; asm volatile("" : "+v"(tid_));
    const int tid = tid_, wid = __builtin_amdgcn_readfirstlane(tid >> 6), lane = tid & 63, wr = wid >> 2, wc = wid & 3, fr = lane & 15, fq = lane >> 4;
    const int K = g.K, nt = K / BK;
    unsigned voffA[2], voffB[2];
#pragma unroll
    for (int i = 0; i < 2; ++i) { int R, C; stage_rc(tid * 16 + i * 8192, R, C); const int Rb = Epi::PERM ? ((R & ~31) + perm32(R & 31)) : R;
        voffA[i] = (unsigned)(R * K + C) * 2u; voffB[i] = (unsigned)(Rb * K + C) * 2u; }
    const size_t kstep = (size_t)(BK * 2);
    const size_t hstep = (size_t)HALF * K * 2;
    const size_t tstep = 2 * hstep;
    const unsigned ldsw = (unsigned)wid * 1024u;
    const int aoff = lds_byte(wr * 64 + fr, fq * 8), boff = lds_byte(wc * 32 + fr, fq * 8);
#define PG8_SA(b, h) (((b) * 2 + (h)) * HTB)
#define PG8_SB(b, h) ((4 + (b) * 2 + (h)) * HTB)
#define PG8_STAGE(bufoff, gbase, voff) do { _Pragma("unroll") for (int _i = 0; _i < 2; ++_i) \
        __builtin_amdgcn_global_load_lds((const unsigned*)((const char*)(gbase) + (voff)[_i]), (PG8_LAS unsigned*)(lds + (bufoff) + ldsw + _i * 8192), 16, 0, 0); } while (0)
#define PG8_LDA(dst, b, h) do { _Pragma("unroll") for (int m = 0; m < 4; ++m) _Pragma("unroll") for (int k = 0; k < 2; ++k) dst[m][k] = *(const PG8_LAS bf16x8*)(lds + PG8_SA(b, h) + aoff + m * 2048 + k * 1024); } while (0)
#define PG8_LDB(dst, b, h) do { _Pragma("unroll") for (int n = 0; n < 2; ++n) _Pragma("unroll") for (int k = 0; k < 2; ++k) dst[n][k] = *(const PG8_LAS bf16x8*)(lds + PG8_SB(b, h) + boff + n * 2048 + k * 1024); } while (0)
#define PG8_MMA(ai, bj, At, Bt) do { __builtin_amdgcn_s_setprio(1); _Pragma("unroll") for (int m = 0; m < 4; ++m) _Pragma("unroll") for (int n = 0; n < 2; ++n) _Pragma("unroll") for (int k = 0; k < 2; ++k) \
        acc[ai][bj][m][n] = __builtin_amdgcn_mfma_f32_16x16x32_bf16(Bt[n][k], At[m][k], acc[ai][bj][m][n], 0, 0, 0); __builtin_amdgcn_s_setprio(0); } while (0)
#define PG8_WAIT_V(n) asm volatile("s_waitcnt vmcnt(" #n ")" ::: "memory")
#define PG8_WAIT_L(n) asm volatile("s_waitcnt lgkmcnt(" #n ")" ::: "memory")
#define PG8_BAR __builtin_amdgcn_s_barrier()
#define PG8_SCHED __builtin_amdgcn_sched_barrier(0)
    Unit cur, nxt; int ui = 0;
    if (!S.next(0, cur)) return;
    f32x4 acc[2][2][4][2];
#pragma unroll
    for (int a = 0; a < 2; ++a)
#pragma unroll
        for (int b = 0; b < 2; ++b)
#pragma unroll
            for (int m = 0; m < 4; ++m)
#pragma unroll
                for (int n = 0; n < 2; ++n) acc[a][b][m][n] = (f32x4){0.f, 0.f, 0.f, 0.f};
    bf16x8 At[4][2], B0[2][2], B1[2][2];
    const char* cA = (const char*)g.A + (size_t)cur.pm * tstep; const char* cB = (const char*)g.Bt + (size_t)cur.pn * tstep;
    S.a_ready(cur);
    if constexpr (SP2) {
        PG8_STAGE(PG8_SB(0, 0), cB, voffB); PG8_STAGE(PG8_SB(0, 1), cB + hstep, voffB); PG8_STAGE(PG8_SA(0, 0), cA, voffA); PG8_STAGE(PG8_SA(0, 1), cA + hstep, voffA);
        if (wr == 1) PG8_BAR;
        PG8_WAIT_V(2); PG8_BAR;
        PG8_STAGE(PG8_SB(1, 0), cB + kstep, voffB); PG8_STAGE(PG8_SA(1, 0), cA + kstep, voffA); PG8_STAGE(PG8_SB(1, 1), cB + hstep + kstep, voffB);
        PG8_WAIT_V(6); PG8_BAR;
    } else {
        PG8_STAGE(PG8_SB(0, 0), cB, voffB); PG8_STAGE(PG8_SA(0, 0), cA, voffA); PG8_STAGE(PG8_SB(0, 1), cB + hstep, voffB); PG8_STAGE(PG8_SA(0, 1), cA + hstep, voffA);
        if (wr == 1) PG8_BAR;
        PG8_WAIT_V(4); PG8_BAR;
        PG8_STAGE(PG8_SB(1, 0), cB + kstep, voffB); PG8_STAGE(PG8_SA(1, 0), cA + kstep, voffA); PG8_STAGE(PG8_SB(1, 1), cB + hstep + kstep, voffB);
        PG8_WAIT_V(6); PG8_BAR;
    }
    for (;;) {
        const bool has_next = S.next(ui + 1, nxt);
        const char* nA = has_next ? (const char*)g.A + (size_t)nxt.pm * tstep : cA; const char* nB = has_next ? (const char*)g.Bt + (size_t)nxt.pn * tstep : cB;
        for (int t = 0; t < nt; t += 2) {
            const bool last = (t == nt - 2);
            const char* a1 = cA + (size_t)(t + 1) * kstep;
            const char* a2 = last ? nA : cA + (size_t)(t + 2) * kstep; const char* b2 = last ? nB : cB + (size_t)(t + 2) * kstep;
            const char* a3 = a2 + kstep; const char* b3 = b2 + kstep;
            if (last && has_next) S.a_ready(nxt);
            if constexpr (SP2) {
            PG8_LDB(B0, 0, 0); PG8_LDB(B1, 0, 1); PG8_SCHED; PG8_LDA(At, 0, 0); PG8_STAGE(PG8_SA(1, 1), a1 + hstep, voffA);
            PG8_WAIT_V(8); PG8_WAIT_L(0); PG8_BAR; PG8_MMA(0, 0, At, B0); PG8_MMA(0, 1, At, B1); PG8_BAR; PG8_SCHED;
            PG8_LDA(At, 0, 1); PG8_STAGE(PG8_SB(0, 0), b2, voffB); PG8_STAGE(PG8_SB(0, 1), b2 + hstep, voffB); PG8_STAGE(PG8_SA(0, 0), a2, voffA);
            PG8_WAIT_V(8); PG8_WAIT_L(0); PG8_BAR; PG8_MMA(1, 0, At, B0); PG8_MMA(1, 1, At, B1); PG8_BAR; PG8_SCHED;
            PG8_LDB(B0, 1, 0); PG8_LDB(B1, 1, 1); PG8_SCHED; PG8_LDA(At, 1, 0); PG8_STAGE(PG8_SA(0, 1), a2 + hstep, voffA);
            PG8_WAIT_V(8); PG8_WAIT_L(0); PG8_BAR; PG8_MMA(0, 0, At, B0); PG8_MMA(0, 1, At, B1); PG8_BAR; PG8_SCHED;
            PG8_LDA(At, 1, 1); PG8_STAGE(PG8_SB(1, 0), b3, voffB); PG8_STAGE(PG8_SB(1, 1), b3 + hstep, voffB); PG8_STAGE(PG8_SA(1, 0), a3, voffA);
            PG8_WAIT_V(8); PG8_WAIT_L(0); PG8_BAR; PG8_MMA(1, 0, At, B0); PG8_MMA(1, 1, At, B1); PG8_BAR; PG8_SCHED;
            } else {
            PG8_LDB(B0, 0, 0); PG8_SCHED; PG8_LDA(At, 0, 0); PG8_STAGE(PG8_SA(1, 1), a1 + hstep, voffA);
            PG8_WAIT_L(8); PG8_BAR; PG8_WAIT_L(0); PG8_MMA(0, 0, At, B0); PG8_BAR; PG8_SCHED;
            PG8_LDB(B1, 0, 1); PG8_STAGE(PG8_SB(0, 0), b2, voffB);
            PG8_BAR; PG8_WAIT_L(0); PG8_MMA(0, 1, At, B1); PG8_BAR;
            PG8_LDA(At, 0, 1); PG8_STAGE(PG8_SA(0, 0), a2, voffA);
            PG8_BAR; PG8_WAIT_L(0); PG8_MMA(1, 0, At, B0); PG8_BAR; PG8_SCHED;
            PG8_STAGE(PG8_SB(0, 1), b2 + hstep, voffB);
            PG8_WAIT_V(6); PG8_BAR; PG8_MMA(1, 1, At, B1); PG8_BAR;
            PG8_LDB(B0, 1, 0); PG8_SCHED; PG8_LDA(At, 1, 0); PG8_STAGE(PG8_SA(0, 1), a2 + hstep, voffA);
            PG8_WAIT_L(8); PG8_BAR; PG8_WAIT_L(0); PG8_MMA(0, 0, At, B0); PG8_BAR; PG8_SCHED;
            PG8_LDB(B1, 1, 1); PG8_STAGE(PG8_SB(1, 0), b3, voffB);
            PG8_BAR; PG8_WAIT_L(0); PG8_MMA(0, 1, At, B1); PG8_BAR;
            PG8_LDA(At, 1, 1); PG8_STAGE(PG8_SA(1, 0), a3, voffA);
            PG8_BAR; PG8_WAIT_L(0); PG8_MMA(1, 0, At, B0); PG8_BAR; PG8_SCHED;
            PG8_STAGE(PG8_SB(1, 1), b3 + hstep, voffB);
            PG8_WAIT_V(6); PG8_BAR; PG8_MMA(1, 1, At, B1); PG8_BAR;
            }
        }
        if constexpr (ALIGN_EPI) { if (wr == 0) PG8_BAR; }
        if constexpr (!Epi::AFTER_DRAIN) { E(acc, cur, wr, wc, fr, fq); S.done(cur); }
        if (!has_next) break;
#pragma unroll
        for (int a = 0; a < 2; ++a)
#pragma unroll
            for (int b = 0; b < 2; ++b)
#pragma unroll
                for (int m = 0; m < 4; ++m)
#pragma unroll
                    for (int n = 0; n < 2; ++n) acc[a][b][m][n] = (f32x4){0.f, 0.f, 0.f, 0.f};
        cur = nxt; cA = nA; cB = nB; ++ui;
        if constexpr (ALIGN_EPI) { if (wr == 1) PG8_BAR; }
    }
    PG8_WAIT_V(0);
    if constexpr (!ALIGN_EPI) { if (wr == 0) PG8_BAR; }
    PG8_BAR;
    if constexpr (Epi::AFTER_DRAIN) { E.fused(acc, cur, wr, wc, fr, fq, lds, wid, lane); S.done(cur); }
#undef PG8_SA
#undef PG8_SB
#undef PG8_STAGE
#undef PG8_LDA
#undef PG8_LDB
#undef PG8_MMA
#undef PG8_WAIT_V
#undef PG8_WAIT_L
#undef PG8_BAR
#undef PG8_SCHED
}
}

#ifndef PROBE_CHECK
#define PROBE_CHECK 0
#endif
#define REP_P5 1
#define REP_SCORE 1
#define REP_SELECT 1
#define SPARSE_ATTN 0
#define REP_P6 1

constexpr int NWAVES = 8;
constexpr int BATCH = 4, SEQ = 8192, D = 1024, FF = 2816, DPLE = 256, NHEAD = 8, HD = 64, DA = 512, DC = 512;
constexpr int M = BATCH * SEQ;
constexpr int NGU = 2 * FF;
constexpr int NIN = 3840;
constexpr float LN_EPS = 1e-5f;
constexpr float DN_ALPHA = 1.189207115002721f;
constexpr float IDX_SCALE = 0.04419417382415922f;
constexpr int TOPK = 256;
constexpr float LOG2E = 1.4426950408889634f;

constexpr size_t MiB = 1u << 20;
constexpr size_t WS_CTL = 0, CTL_ZERO_BYTES = 1 * MiB;
constexpr size_t WS_WGU1 = 2 * MiB, WS_WD1 = 13 * MiB, WS_WIN = 19 * MiB, WS_WOUT = 27 * MiB, WS_WGU2 = 29 * MiB, WS_WD2 = 40 * MiB, WS_WGATE = 46 * MiB, WS_WP = 48 * MiB;
constexpr size_t WS_XB = 64 * MiB;
constexpr size_t WS_R = 128 * MiB;
constexpr size_t WS_BIG = 256 * MiB;
constexpr size_t WS_QKVI = WS_BIG, WS_KI = WS_BIG + 128 * MiB, WS_WI = WS_BIG + 132 * MiB, WS_BC = WS_BIG + 136 * MiB, WS_Z = WS_BIG + 168 * MiB, WS_SEL = WS_BIG + 200 * MiB;
constexpr size_t WS_PB = 496 * MiB;
constexpr size_t WS_END = 512 * MiB;
static_assert(WS_WGU1 + (size_t)NGU * D * 2 <= WS_WD1 && WS_WD1 + (size_t)D * FF * 2 <= WS_WIN && WS_WIN + (size_t)NIN * D * 2 <= WS_WOUT && WS_WOUT + (size_t)D * D * 2 <= WS_WGU2 && WS_WGU2 + (size_t)NGU * D * 2 <= WS_WD2 &&
              WS_WD2 + (size_t)D * FF * 2 <= WS_WGATE && WS_WGATE + (size_t)D * D * 2 <= WS_WP && WS_WP + (size_t)D * DPLE * 2 <= WS_XB, "weight map");
static_assert(WS_XB + (size_t)M * D * 2 <= WS_R && WS_R + (size_t)M * D * 4 <= WS_BIG && WS_BIG + (size_t)M * FF * 2 <= WS_PB && WS_SEL + (size_t)BATCH * 128 * SEQ * 8 <= WS_PB && WS_PB + (size_t)M * DPLE * 2 <= WS_END, "d_ws map");
constexpr int CW_BAR = 4096;

constexpr int RING_OFF = 0, RING_BYTES = 131072;
constexpr int SROW_U16 = 64 * 132;
constexpr int SC_BYTES = 8 * SROW_U16 * 2;
constexpr int LDSCTL_OFF = 139264, MISC_OFF = LDSCTL_OFF + 320;
constexpr int LDS_BYTES = 147456;
static_assert(SC_BYTES <= LDSCTL_OFF && RING_BYTES <= LDSCTL_OFF && MISC_OFF + 128 <= LDS_BYTES, "LDS map");

#define GAS __attribute__((address_space(1)))
#define LAS __attribute__((address_space(3)))
typedef unsigned short bf16;
typedef unsigned v4u __attribute__((ext_vector_type(4)));
typedef unsigned v2u __attribute__((ext_vector_type(2)));
typedef float f32x4 __attribute__((ext_vector_type(4)));
typedef float f32x16 __attribute__((ext_vector_type(16)));
typedef short bf16x8 __attribute__((ext_vector_type(8)));
typedef unsigned short u16x2 __attribute__((ext_vector_type(2)));
typedef GAS unsigned gu32;
#define RLX_AGENT __ATOMIC_RELAXED, __HIP_MEMORY_SCOPE_AGENT
#define LDS_WAIT() asm volatile("s_waitcnt lgkmcnt(0)" ::: "memory")
#define VM_WAIT() asm volatile("s_waitcnt vmcnt(0)" ::: "memory")
__device__ __forceinline__ unsigned f2bf(float f) { unsigned u = __builtin_bit_cast(unsigned, f); return (u + 0x7fffu + ((u >> 16) & 1u)) >> 16; }
__device__ __forceinline__ unsigned pk2(float lo, float hi) { return f2bf(lo) | (f2bf(hi) << 16); }
__device__ __forceinline__ float bf_lo(unsigned w) { return __builtin_bit_cast(float, w << 16); }
__device__ __forceinline__ float bf_hi(unsigned w) { return __builtin_bit_cast(float, w & 0xffff0000u); }
namespace attn_body {
using bf16=__hip_bfloat16;
using bf16x8=__attribute__((ext_vector_type(8)))short;
using s16x4=__attribute__((ext_vector_type(4)))short;
using f32x16=__attribute__((ext_vector_type(16)))float;
using u32x4=__attribute__((ext_vector_type(4)))unsigned;
constexpr int BATCH=4,NHEAD=8,SEQ=8192,D=64,DM=NHEAD*D,OPITCH=1024;
constexpr int NW=8,QBLK=32,QB=QBLK*NW,KVBLK=64,NQB=SEQ/QB;
constexpr int ATTN_PITCH=DM, ATTN_UNIT_ROWS=QB;
__device__ __forceinline__ int crow(int r,int hi){return (r&3)+8*(r>>2)+4*hi;}
#define SBAR() __builtin_amdgcn_sched_barrier(0)
constexpr int NSLOT=3, SLOTB=8192;
constexpr int LDS_K=0, LDS_V=NSLOT*SLOTB, LDS_WS=2*NSLOT*SLOTB, LDS_OST=LDS_WS+NW*64*4, LDS_MSK=LDS_OST+NW*4096, LDS_BYTES=LDS_MSK+NW*1024;
constexpr float C2=0.125f*1.4426950408889634f;
__device__ __forceinline__ void glds16(const void*gsrc,unsigned lds_dst){unsigned keep;
  asm volatile("s_mov_b32 %0, m0\n\ts_mov_b32 m0, %2\n\ts_nop 0\n\tglobal_load_lds_dwordx4 %1, off\n\ts_mov_b32 m0, %0":"=&s"(keep):"v"(gsrc),"s"(lds_dst):"memory");}
__device__ __forceinline__ float max3f(float a,float b,float c){float r;asm("v_max3_f32 %0, %1, %2, %3":"=v"(r):"v"(a),"v"(b),"v"(c));return r;}
__device__ __forceinline__ float max2f(float a,float b){float r;asm("v_max_f32_e32 %0, %1, %2":"=v"(r):"v"(a),"v"(b));return r;}
__device__ __forceinline__ float fadd_s(float a,float b){float r;asm("v_add_f32_e32 %0, %1, %2":"=v"(r):"v"(a),"v"(b));return r;}
__device__ __forceinline__ float fsub_s(float a,float b){float r;asm("v_sub_f32_e32 %0, %1, %2":"=v"(r):"v"(a),"v"(b));return r;}
typedef float f32x2_t __attribute__((ext_vector_type(2))); typedef unsigned v2u_t __attribute__((ext_vector_type(2))); typedef __bf16 bf16x2_t __attribute__((ext_vector_type(2)));
__device__ __forceinline__ unsigned cvtpk_s(float lo,float hi){f32x2_t v={lo,hi};bf16x2_t b=__builtin_convertvector(v,bf16x2_t);return __builtin_bit_cast(unsigned,b);}
__device__ __forceinline__ void glds4(const void*gsrc,unsigned lds_dst){unsigned keep;
  asm volatile("s_mov_b32 %0, m0\n\ts_mov_b32 m0, %2\n\ts_nop 0\n\tglobal_load_lds_dword %1, off\n\ts_mov_b32 m0, %0":"=&s"(keep):"v"(gsrc),"s"(lds_dst):"memory");}
#define WAIT_BAR(N) asm volatile("s_waitcnt vmcnt(" #N ") lgkmcnt(0)\n\ts_barrier":::"memory")

__device__ __forceinline__ void qkt(f32x16&p0,f32x16&p1,const char*Kslot,const bf16x8*qr,int r32,int hi){
  const char*kb=Kslot+hi*1024+r32*16;
  #pragma unroll
  for(int d0=0;d0<4;++d0){
    const bf16x8 b0=*reinterpret_cast<const bf16x8*>(kb+d0*2048);
    const bf16x8 b1=*reinterpret_cast<const bf16x8*>(kb+d0*2048+512);
    p0=__builtin_amdgcn_mfma_f32_32x32x16_bf16(b0,qr[d0],p0,0,0,0);p1=__builtin_amdgcn_mfma_f32_32x32x16_bf16(b1,qr[d0],p1,0,0,0);}
}
typedef __attribute__((address_space(3))) const char* lds_cptr;
typedef short v4i16_t __attribute__((ext_vector_type(4)));
__device__ __forceinline__ void kload8(bf16x8*kf,lds_cptr kp){
  kf[0]=*(const __attribute__((address_space(3))) bf16x8*)(kp);      kf[1]=*(const __attribute__((address_space(3))) bf16x8*)(kp+512);
  kf[2]=*(const __attribute__((address_space(3))) bf16x8*)(kp+2048); kf[3]=*(const __attribute__((address_space(3))) bf16x8*)(kp+2560);
  kf[4]=*(const __attribute__((address_space(3))) bf16x8*)(kp+4096); kf[5]=*(const __attribute__((address_space(3))) bf16x8*)(kp+4608);
  kf[6]=*(const __attribute__((address_space(3))) bf16x8*)(kp+6144); kf[7]=*(const __attribute__((address_space(3))) bf16x8*)(kp+6656);
}
__device__ __forceinline__ void kload2(bf16x8*kf,lds_cptr kp,int j){ kf[2*j]=*(const __attribute__((address_space(3))) bf16x8*)(kp+j*2048); kf[2*j+1]=*(const __attribute__((address_space(3))) bf16x8*)(kp+j*2048+512); }
__device__ __forceinline__ s16x4 vtr(lds_cptr p){ return __builtin_bit_cast(s16x4,__builtin_amdgcn_ds_read_tr16_b64_v4i16((__attribute__((address_space(3))) v4i16_t*)p)); }
__device__ __forceinline__ float rowmax(const f32x16&p0,const f32x16&p1){
  float a=max3f(p0[0],p0[1],p1[0]),b=max3f(p0[2],p0[3],p1[1]);a=max3f(a,p1[2],p1[3]);
  #pragma unroll
  for(int r=4;r<16;r+=4){a=max3f(a,p0[r],p0[r+1]);b=max3f(b,p0[r+2],p0[r+3]);a=max3f(a,p1[r],p1[r+1]);b=max3f(b,p1[r+2],p1[r+3]);}
  const float m=max2f(a,b);
  auto rr=__builtin_amdgcn_permlane32_swap(__float_as_uint(m),__float_as_uint(m),false,false);
  return max2f(__uint_as_float(rr[0]),__uint_as_float(rr[1]));
}
__device__ __forceinline__ void pv(f32x16*o,int vb,bf16x8 pa0,bf16x8 pa1,bf16x8 pa2,bf16x8 pa3){
  #pragma unroll
  for(int d0=0;d0<2;++d0){s16x4 lo[4],hi[4];
    #pragma unroll
    for(int ks=0;ks<4;++ks){
      asm volatile("ds_read_b64_tr_b16 %0,%1 offset:%c2":"=&v"(lo[ks]):"v"(vb),"i"(d0*4096+ks*1024):"memory");
      asm volatile("ds_read_b64_tr_b16 %0,%1 offset:%c2":"=&v"(hi[ks]):"v"(vb),"i"(d0*4096+ks*1024+512):"memory");}
    asm volatile("s_waitcnt lgkmcnt(0)":::"memory");SBAR();
    #define PK(k) (bf16x8){lo[k][0],lo[k][1],lo[k][2],lo[k][3],hi[k][0],hi[k][1],hi[k][2],hi[k][3]}
    o[d0]=__builtin_amdgcn_mfma_f32_32x32x16_bf16(pa0,PK(0),o[d0],0,0,0);
    o[d0]=__builtin_amdgcn_mfma_f32_32x32x16_bf16(pa1,PK(1),o[d0],0,0,0);
    o[d0]=__builtin_amdgcn_mfma_f32_32x32x16_bf16(pa2,PK(2),o[d0],0,0,0);
    o[d0]=__builtin_amdgcn_mfma_f32_32x32x16_bf16(pa3,PK(3),o[d0],0,0,0);
    #undef PK
  }
}

#ifndef ATTN_STORE16
#define ATTN_STORE16(p,v) (*(u32x4*)(p)=(v))
#endif
template<int THRL> __device__ __forceinline__ void attn_unit(int b,int h,int qb,const bf16*Q,const bf16*__restrict__ K,const bf16*__restrict__ V,const unsigned long long*__restrict__ SEL,bf16*O,char*shm){
  int tid_=threadIdx.x; asm volatile("":"+v"(tid_));
  const int tid=tid_,lane=tid&63,r32=lane&31,hi=lane>>5; const int wid=__builtin_amdgcn_readfirstlane(tid>>6);
  const long rowbase=(long)b*SEQ; const int q0=qb*QB;
  const bf16*Qw=Q+(rowbase+q0+wid*QBLK)*DM+h*D;
  const bf16*Kh=K+rowbase*DM+h*D,*Vh=V+rowbase*DM+h*D;
  const unsigned lds0=(unsigned)(uintptr_t)shm;
  float*wsf=(float*)(shm+LDS_WS)+wid*64;
  const bf16*ksrc=Kh+(long)lane*DM+wid*8;
  const bf16*vsrc=Vh+(long)(16*(wid&3)+(lane>>2))*DM+(wid>>2)*32+(lane&3)*8;
  const unsigned*msrc=(const unsigned*)(SEL+(size_t)b*128*SEQ+q0+wid*QBLK)+lane;
  const unsigned kdst=lds0+LDS_K+wid*1024, vdst=lds0+LDS_V+wid*1024, mdst=lds0+LDS_MSK+wid*1024;
  const int NT=(q0+QB)/KVBLK;
  #define TI(t) (NT-1-(t))
  #define DMA_K(t,slot) glds16(ksrc+(long)TI(t)*KVBLK*DM,(unsigned)__builtin_amdgcn_readfirstlane(kdst+(slot)))
  #define DMA_V(t,slot) glds16(vsrc+(long)TI(t)*KVBLK*DM,(unsigned)__builtin_amdgcn_readfirstlane(vdst+(slot)))
  #define DMA_M(t) glds4(msrc+(size_t)TI(t)*(SEQ*2),(unsigned)__builtin_amdgcn_readfirstlane(mdst+(((t)&3)<<8)))
  const int vb0=(int)(lds0+LDS_V)+((lane>>4)&1)*32+(lane&3)*8+(4*hi+((lane&15)>>2))*64;
  const char*Kbase=shm+LDS_K; bf16x8 kf[8];
  const lds_cptr shm3=(lds_cptr)shm; const lds_cptr kp0=shm3+LDS_K+hi*1024+r32*16; const lds_cptr vp0=shm3+LDS_V+((lane>>4)&1)*32+(lane&3)*8+(4*hi+((lane&15)>>2))*64;
  const lds_cptr mp0=shm3+LDS_MSK+wid*1024+r32*8;
  DMA_M(0);DMA_M(1);DMA_M(2);
  DMA_K(0,0);DMA_V(0,0);DMA_K(1,SLOTB);
  bf16x8 qr[4];
  #pragma unroll
  for(int d0=0;d0<4;++d0)qr[d0]=*reinterpret_cast<const bf16x8*>(&Qw[(long)r32*DM+d0*16+hi*8]);
  float mhat=0.f,l_reg=0.f;f32x16 o[2];o[0]=f32x16{};o[1]=f32x16{};
  bool started=false;
  const float slope2=__builtin_amdgcn_exp2f(-(float)(h+1))*1.4426950408889634f, m2s=-2.f*slope2;
  const int tq=q0+wid*QBLK+r32, sref=q0+QB-1;
  bool resc=false;
  #define CR(r) (((r)&3)+8*((r)>>2))
  #define BR(r) (16*((r)&1)+(((r)>>1)&1)+4*((r)>>2))
  #define SELV(w,c,v) __uint_as_float(((unsigned)__builtin_amdgcn_sbfe((int)(w),(c),1)&__float_as_uint(v))|(~(unsigned)__builtin_amdgcn_sbfe((int)(w),(c),1)&0xff800000u))
  float nb=0.f,dq=0.f;unsigned wl=0u,wh=0u;
  #define FPREP(tn) do{ const int ti_=TI(tn); const v2u_t mw_=*(const __attribute__((address_space(3))) v2u_t*)(mp0+(((tn)&3)<<8)); wl=mw_.x>>(2*hi); wh=mw_.y>>(2*hi); \
      nb=slope2*(float)(64*ti_+4*hi-sref)-mhat; dq=(float)(64*ti_+4*hi-tq); }while(0)
  #define FILL4(X,B,w,co,BN) do{ _Pragma("unroll") for(int r_=(B);r_<(B)+4;++r_){ float v_=__builtin_fmaf(slope2,(float)(CR(r_)+(co)),nb); \
      if(BN){ v_=__builtin_fmaf(__builtin_fmaxf(dq+(float)(CR(r_)+(co)),0.f),m2s,v_); } X[r_]=SELV(w,BR(r_),v_); } PIN(X); }while(0)
  #define PIN(x) asm volatile("":"+v"(x))
  #define MX3(a,b,c) __builtin_fmaxf(__builtin_fmaxf((a),(b)),(c))
  #define DECIDE(C0,C1) do{ float a=MX3(C0[0],C0[1],C1[0]),b_=MX3(C0[2],C0[3],C1[1]); a=MX3(a,C1[2],C1[3]); \
      _Pragma("unroll") for(int r=4;r<16;r+=4){a=MX3(a,C0[r],C0[r+1]);b_=MX3(b_,C0[r+2],C0[r+3]);a=MX3(a,C1[r],C1[r+1]);b_=MX3(b_,C1[r+2],C1[r+3]);} \
      float rm=__builtin_fmaxf(a,b_); { auto rr=__builtin_amdgcn_permlane32_swap(__float_as_uint(rm),__float_as_uint(rm),false,false); rm=__builtin_fmaxf(__uint_as_float(rr[0]),__uint_as_float(rr[1])); } \
      resc=false; const bool live_=rm>-INFINITY, fresh_=live_&&!started; \
      if(__builtin_expect(__any(fresh_||rm>(float)THRL),0)){ const float dl=fresh_?rm:__builtin_fmaxf(rm,0.f); mhat+=dl; \
        _Pragma("unroll") for(int r=0;r<16;++r){C0[r]-=dl;C1[r]-=dl;} \
        const float f=started?__builtin_amdgcn_exp2f(-dl):1.0f; l_reg*=f; if(hi==0)wsf[r32]=f; resc=true; } \
      started=started||live_; }while(0)
  #define RESC() do{ if(resc){ asm volatile("s_waitcnt lgkmcnt(0)":::"memory"); \
      _Pragma("unroll") for(int d_=0;d_<2;++d_) _Pragma("unroll") for(int r=0;r<16;++r)o[d_][r]*=wsf[crow(r,hi)]; } }while(0)
  f32x16 pA0,pA1,pB0,pB1;
  int sl_prev=0,sl_cur=0,sl_next=SLOTB;
  #define ROT() do{sl_prev=sl_cur;sl_cur=sl_next;sl_next=(sl_next==(NSLOT-1)*SLOTB)?0:sl_next+SLOTB;}while(0)
  DMA_K(2,2*SLOTB);
  WAIT_BAR(3);
  FPREP(0);
  FILL4(pA0,0,wl,0,true);FILL4(pA0,4,wl,0,true);FILL4(pA0,8,wl,0,true);FILL4(pA0,12,wl,0,true);
  FILL4(pA1,0,wh,32,true);FILL4(pA1,4,wh,32,true);FILL4(pA1,8,wh,32,true);FILL4(pA1,12,wh,32,true);
  qkt(pA0,pA1,Kbase,qr,r32,hi);asm volatile("s_nop 15\n\ts_nop 7":"+v"(pA0),"+v"(pA1));
  DECIDE(pA0,pA1);
  _Pragma("unroll") for(int r=0;r<16;++r){pA0[r]=__builtin_amdgcn_exp2f(pA0[r]);pA1[r]=__builtin_amdgcn_exp2f(pA1[r]);}
  WAIT_BAR(0);
  DMA_K(3,0);DMA_M(3);DMA_V(1,SLOTB);
  ROT();
  kload8(kf,kp0+sl_cur);
  RESC();
  FPREP(1);
  FILL4(pB0,0,wl,0,true);FILL4(pB0,4,wl,0,true);FILL4(pB0,8,wl,0,true);FILL4(pB0,12,wl,0,true);
  FILL4(pB1,0,wh,32,true);FILL4(pB1,4,wh,32,true);FILL4(pB1,8,wh,32,true);FILL4(pB1,12,wh,32,true);
  WAIT_BAR(3);
  s16x4 vlo[8],vhi[8]; u32x4 pw0,pw1,pw2,pw3;
  #define PKW(P,B) cvtpk_s(P[B],P[B+1])
  #define PAF(k) __builtin_bit_cast(bf16x8,pw##k)
  #define VFR(i) (bf16x8){vlo[i][0],vlo[i][1],vlo[i][2],vlo[i][3],vhi[i][0],vhi[i][1],vhi[i][2],vhi[i][3]}
  #define GAPA(MF,A0,A1,A2,A3,W0,W1,PW) do{ MF; sacc+=A0; sacc+=A1; sacc+=A2; sacc+=A3; PIN(sacc); W0; W1; PIN(PW); SBAR(); }while(0)
  #define EX(v) __builtin_amdgcn_exp2f(v)
  #define GAPB(MF,X,B,GF,Y,w,co,BN) do{ MF; X[B]=EX(X[B]); X[B+1]=EX(X[B+1]); X[B+2]=EX(X[B+2]); X[B+3]=EX(X[B+3]); PIN(X); if(GF){ FILL4(Y,B,w,co,BN); } SBAR(); }while(0)
  #define VRD(i) do{ vlo[i]=vtr(vp_+(((i)>>2)*4096+((i)&3)*1024)); vhi[i]=vtr(vp_+(((i)>>2)*4096+((i)&3)*1024+512)); }while(0)
  #define KRD(G,j) do{ if(G){ kload2(kf,kp0+sl_next,j); SBAR(); } }while(0)
  #define STEP(C0,C1,P0,P1,t,GK,GV,GL,GF,BN) do{ SBAR(); \
    const lds_cptr vp_=vp0+sl_prev; \
    VRD(0); SBAR(); float sacc=(P0[0]+P0[1]); \
    GAPA(C0=__builtin_amdgcn_mfma_f32_32x32x16_bf16(kf[0],qr[0],C0,0,0,0), P0[2],P0[3],P0[4],P0[5],     pw0[0]=PKW(P0,0), pw0[1]=PKW(P0,2), pw0); \
    VRD(4); SBAR(); GAPA(C1=__builtin_amdgcn_mfma_f32_32x32x16_bf16(kf[1],qr[0],C1,0,0,0), P0[6],P0[7],P0[8],P0[9],     pw0[2]=PKW(P0,4), pw0[3]=PKW(P0,6), pw0); \
    VRD(1); SBAR(); GAPA(C0=__builtin_amdgcn_mfma_f32_32x32x16_bf16(kf[2],qr[1],C0,0,0,0),   P0[10],P0[11],P0[12],P0[13], pw1[0]=PKW(P0,8), pw1[1]=PKW(P0,10), pw1); \
    VRD(5); SBAR(); GAPA(C1=__builtin_amdgcn_mfma_f32_32x32x16_bf16(kf[3],qr[1],C1,0,0,0),   P0[14],P0[15],P1[0],P1[1],   pw1[2]=PKW(P0,12),pw1[3]=PKW(P0,14), pw1); \
    VRD(2); SBAR(); GAPA(C0=__builtin_amdgcn_mfma_f32_32x32x16_bf16(kf[4],qr[2],C0,0,0,0),   P1[2],P1[3],P1[4],P1[5],     pw2[0]=PKW(P1,0), pw2[1]=PKW(P1,2), pw2); \
    VRD(6); SBAR(); GAPA(C1=__builtin_amdgcn_mfma_f32_32x32x16_bf16(kf[5],qr[2],C1,0,0,0),   P1[6],P1[7],P1[8],P1[9],     pw2[2]=PKW(P1,4), pw2[3]=PKW(P1,6), pw2); \
    VRD(3); SBAR(); GAPA(C0=__builtin_amdgcn_mfma_f32_32x32x16_bf16(kf[6],qr[3],C0,0,0,0),   P1[10],P1[11],P1[12],P1[13], pw3[0]=PKW(P1,8), pw3[1]=PKW(P1,10), pw3); \
    VRD(7); SBAR(); GAPA(C1=__builtin_amdgcn_mfma_f32_32x32x16_bf16(kf[7],qr[3],C1,0,0,0),   P1[14],P1[15],0.f,0.f,       pw3[2]=PKW(P1,12),pw3[3]=PKW(P1,14), pw3); \
    l_reg+=sacc; \
    if(GK){DMA_K((t)+3,sl_cur);DMA_M((t)+3);} if(GV){DMA_V((t)+1,sl_next);} \
    DECIDE(C0,C1); \
    if(GF){ FPREP((t)+1); } \
    SBAR(); \
    GAPB(o[0]=__builtin_amdgcn_mfma_f32_32x32x16_bf16(PAF(0),VFR(0),o[0],0,0,0), C0,0, GF,P0,wl,0,BN); \
    GAPB(o[1]=__builtin_amdgcn_mfma_f32_32x32x16_bf16(PAF(0),VFR(4),o[1],0,0,0), C0,4, GF,P0,wl,0,BN); \
    KRD(GL,0); GAPB(o[0]=__builtin_amdgcn_mfma_f32_32x32x16_bf16(PAF(1),VFR(1),o[0],0,0,0), C0,8, GF,P0,wl,0,BN); \
    KRD(GL,1); GAPB(o[1]=__builtin_amdgcn_mfma_f32_32x32x16_bf16(PAF(1),VFR(5),o[1],0,0,0), C0,12, GF,P0,wl,0,BN); \
    KRD(GL,2); GAPB(o[0]=__builtin_amdgcn_mfma_f32_32x32x16_bf16(PAF(2),VFR(2),o[0],0,0,0), C1,0, GF,P1,wh,32,BN); \
    KRD(GL,3); GAPB(o[1]=__builtin_amdgcn_mfma_f32_32x32x16_bf16(PAF(2),VFR(6),o[1],0,0,0), C1,4, GF,P1,wh,32,BN); \
    GAPB(o[0]=__builtin_amdgcn_mfma_f32_32x32x16_bf16(PAF(3),VFR(3),o[0],0,0,0), C1,8, GF,P1,wh,32,BN); \
    GAPB(o[1]=__builtin_amdgcn_mfma_f32_32x32x16_bf16(PAF(3),VFR(7),o[1],0,0,0), C1,12, GF,P1,wh,32,BN); \
    }while(0)
  #define ENDW(tt) do{ if((tt)+3<NT){WAIT_BAR(3);} else if((tt)+2<NT){WAIT_BAR(1);} else {WAIT_BAR(0);} }while(0)
  int t=1;
  STEP(pB0,pB1,pA0,pA1,1,(4<NT),true,true,true,true);   ENDW(1); RESC(); ROT();
  STEP(pA0,pA1,pB0,pB1,2,(5<NT),true,true,true,true);   ENDW(2); RESC(); ROT();
  t=3;
  for(;t+5<NT;t+=2){
    STEP(pB0,pB1,pA0,pA1,t,true,true,true,true,false);     WAIT_BAR(3); RESC(); ROT();
    STEP(pA0,pA1,pB0,pB1,t+1,true,true,true,true,false);   WAIT_BAR(3); RESC(); ROT();
  }
  for(;t+1<NT;t+=2){
    STEP(pB0,pB1,pA0,pA1,t,(t+3<NT),(t+1<NT),(t+1<NT),(t+1<NT),false);       ENDW(t);   RESC(); ROT();
    STEP(pA0,pA1,pB0,pB1,t+1,(t+4<NT),(t+2<NT),(t+2<NT),(t+2<NT),false);     ENDW(t+1); RESC(); ROT();
  }
  STEP(pB0,pB1,pA0,pA1,NT-1,false,false,false,false,false); RESC();
  { float sacc=pB0[0]+pB0[1]; _Pragma("unroll") for(int r=2;r<16;++r)sacc+=pB0[r]; _Pragma("unroll") for(int r=0;r<16;++r)sacc+=pB1[r]; l_reg+=sacc;
    pw0=(u32x4){PKW(pB0,0),PKW(pB0,2),PKW(pB0,4),PKW(pB0,6)};pw1=(u32x4){PKW(pB0,8),PKW(pB0,10),PKW(pB0,12),PKW(pB0,14)};pw2=(u32x4){PKW(pB1,0),PKW(pB1,2),PKW(pB1,4),PKW(pB1,6)};pw3=(u32x4){PKW(pB1,8),PKW(pB1,10),PKW(pB1,12),PKW(pB1,14)};
    SBAR(); pv(o,vb0+sl_cur,PAF(0),PAF(1),PAF(2),PAF(3)); }
  #undef PKW
  #undef PAF
  #undef VFR
  #undef PIN
  #undef MX3
  #undef GAPA
  #undef GAPB
  #undef EX
  #undef VRD
  #undef KRD
  #undef STEP
  #undef ENDW
  #undef FILL4
  #undef FPREP
  #undef SELV
  #undef CR
  #undef BR
  #undef DECIDE
  {auto rr=__builtin_amdgcn_permlane32_swap(__float_as_uint(l_reg),__float_as_uint(l_reg),false,false);l_reg=__uint_as_float(rr[0])+__uint_as_float(rr[1]);}
  if(hi==0)wsf[32+r32]=l_reg;asm volatile("s_waitcnt lgkmcnt(0)":::"memory");
  float rli[16];
  #pragma unroll
  for(int r=0;r<16;++r)rli[r]=__builtin_amdgcn_rcpf(wsf[32+crow(r,hi)]);
  bf16*Ow=O+(rowbase+q0+wid*QBLK)*OPITCH+h*D;
  { bf16*stg=(bf16*)(shm+LDS_OST)+wid*2048;
    #pragma unroll
    for(int r=0;r<16;++r){const int orow=crow(r,hi);
      #pragma unroll
      for(int d0=0;d0<2;++d0)stg[orow*64+d0*32+r32]=__float2bfloat16(o[d0][r]*rli[r]);}
    asm volatile("s_waitcnt lgkmcnt(0)":::"memory");
    #pragma unroll
    for(int i=0;i<4;++i){const int row=i*8+(lane>>3),ch=lane&7; const u32x4 v=*(const u32x4*)(stg+row*64+ch*8); ATTN_STORE16(Ow+(long)row*OPITCH+ch*8,v);} }
  asm volatile("s_waitcnt lgkmcnt(0)\n\ts_barrier":::"memory");
  #undef DMA_K
  #undef DMA_V
  #undef DMA_M
  #undef TI
  #undef RESC
  #undef ROT
}
constexpr int ATTN_LDS_BYTES=LDS_BYTES;
struct AttnTensors { const bf16* Q; const bf16* K; const bf16* V; const unsigned long long* SEL; bf16* O; };
struct AttnUnit { int bh; int qb; };
struct StaticOrder {
  int vcu,grid,block;
  __device__ __forceinline__ explicit StaticOrder(int grid_,int block_):vcu((block_%8)*(grid_/8)+block_/8),grid(grid_),block(block_){}
  __device__ __forceinline__ bool next(int i,AttnUnit&u)const{
    if(grid==256){ if(i>=4)return false; const int s=vcu&7; u.bh=vcu>>3; u.qb=(i==0)?s:(i==1)?15-s:(i==2)?16+s:31-s; return true; }
    const int n=i*grid+block; if(n>=BATCH*NHEAD*NQB)return false; u.bh=n/NQB; u.qb=n%NQB; return true; }
};
template<class Sched,int THRL=8> __device__ __forceinline__ void attn_phase(char*lds,const AttnTensors&T,const Sched&S){
  AttnUnit u;
  for(int i=0;S.next(i,u);++i){ attn_unit<THRL>(u.bh/NHEAD,u.bh%NHEAD,u.qb,T.Q,T.K,T.V,T.SEL,T.O,lds); }
}
#undef SBAR
#undef WAIT_BAR
}
#define XB_TMO      128
#define XB_XCNT(j)  (256  + 64 * (j))
#define XB_XSUB(j)  (1280 + 64 * (j))
#define XB_XGEN(j)  (2304 + 64 * (j))
#define XB_TOP      3328
#define XB_TOPGEN   3392
#define XCD_BAR_WORDS 3456
#define XB_SPIN_CAP (1u << 18)

__device__ __forceinline__ unsigned xb_ld(unsigned* p)              { return __hip_atomic_load(p, __ATOMIC_RELAXED, __HIP_MEMORY_SCOPE_AGENT); }
__device__ __forceinline__ unsigned xb_add(unsigned* p, unsigned v) { return __hip_atomic_fetch_add(p, v, __ATOMIC_RELAXED, __HIP_MEMORY_SCOPE_AGENT); }
__device__ __forceinline__ unsigned xb_xcc_id() { return (unsigned)__builtin_amdgcn_s_getreg((3 << 11) | 20) & 0xFu; }
#define XB_SPIN(cond, bar) do { unsigned _sp = 0; while (cond) { __builtin_amdgcn_s_sleep(1); \
    if ((++_sp & 255u) == 0u) { if (xb_ld(&(bar)[XB_TMO])) break; if (_sp > XB_SPIN_CAP) { atomicAdd(&(bar)[XB_TMO], 1u); break; } } } } while (0)

struct XcdBarrier {
    unsigned* bar; unsigned x;
    volatile LAS unsigned* st;
};

__device__ __forceinline__ XcdBarrier xcd_barrier_post(unsigned* bar, volatile LAS unsigned* st) {
    XcdBarrier b; b.bar = bar; b.x = xb_xcc_id(); b.st = st;
    if (threadIdx.x == 0) (void)xb_add(&bar[XB_XCNT(b.x)], 1u);
    return b;
}
__device__ __forceinline__ void xcd_barrier_complete(unsigned* bar, unsigned x, unsigned& nloc, unsigned& nx) {
    const unsigned G = gridDim.x * gridDim.y * gridDim.z;
    unsigned sum, cnt, mine, sp = 0u;
    for (;;) {
        sum = 0u; cnt = 0u; mine = 0u;
#pragma unroll
        for (unsigned j = 0; j < 16; ++j) { const unsigned c = xb_ld(&bar[XB_XCNT(j)]); sum += c; cnt += (c > 0u) ? 1u : 0u; mine = (j == x) ? c : mine; }
        if (sum == G) break;
        __builtin_amdgcn_s_sleep(1);
        if ((++sp & 255u) == 0u) { if (xb_ld(&bar[XB_TMO])) break; if (sp > XB_SPIN_CAP) { atomicAdd(&bar[XB_TMO], 1u); break; } }
    }
    nloc = mine > 0u ? mine : 1u; nx = cnt > 0u ? cnt : 1u;
}

__device__ __forceinline__ void xcd_barrier(const XcdBarrier& b) {
    asm volatile("s_waitcnt vmcnt(0)" ::: "memory");
    __syncthreads();
    if (threadIdx.x == 0) {
        unsigned* bar = b.bar;
        __builtin_amdgcn_s_waitcnt(0);
        unsigned nloc = b.st[0], nx = b.st[1];
        if (nloc == 0u) { xcd_barrier_complete(bar, b.x, nloc, nx); b.st[0] = nloc; b.st[1] = nx; }
        const unsigned old = xb_add(&bar[XB_XSUB(b.x)], 1u);
        const unsigned gen = old / nloc;
        if (old + 1u == (gen + 1u) * nloc) {
            __builtin_amdgcn_fence(__ATOMIC_RELEASE, "agent");
            asm volatile("s_waitcnt vmcnt(0)" ::: "memory");
            const unsigned og = xb_add(&bar[XB_TOP], 1u);
            const unsigned tg = og / nx;
            if (og + 1u == (tg + 1u) * nx) xb_add(&bar[XB_TOPGEN], 1u);
            else XB_SPIN(xb_ld(&bar[XB_TOPGEN]) == tg, bar);
            __builtin_amdgcn_fence(__ATOMIC_ACQUIRE, "agent");
            xb_add(&bar[XB_XGEN(b.x)], 1u);
            asm volatile("s_waitcnt vmcnt(0)" ::: "memory");
        } else {
            XB_SPIN(xb_ld(&bar[XB_XGEN(b.x)]) == gen, bar);
            __builtin_amdgcn_fence(__ATOMIC_ACQUIRE, "agent");
            asm volatile("s_waitcnt vmcnt(0)" ::: "memory");
        }
    }
    __syncthreads();
}

__device__ __forceinline__ void p0_transpose_item(const float* W, int K, int N, bf16* WT, LAS float* scr, int k0, int dn0, int c0, int lane) {
    const int n = lane & 31;
#pragma unroll 8
    for (int i = 0; i < 32; ++i) { const int kk = 2 * i + (lane >> 5); scr[kk * 33 + n] = (c0 >= 0) ? W[(size_t)(k0 + kk) * N + c0 + n] : 0.f; }
    LDS_WAIT(); asm volatile("" ::: "memory");
    const int c = lane & 7;
#pragma unroll
    for (int j = 0; j < 4; ++j) { const int nn = (lane >> 3) + 8 * j; const LAS float* s = scr + (8 * c) * 33 + nn;
        v4u o; o.x = pk2(s[0 * 33], s[1 * 33]); o.y = pk2(s[2 * 33], s[3 * 33]); o.z = pk2(s[4 * 33], s[5 * 33]); o.w = pk2(s[6 * 33], s[7 * 33]);
        *(GAS v4u*)(WT + (size_t)(dn0 + nn) * K + k0 + 8 * c) = o; }
    LDS_WAIT(); asm volatile("" ::: "memory");
}
__device__ __forceinline__ int win_src_col8(int d) {
    if (d < 2120) return d;
    if (d < 2304) return -1;
    if (d < 2816) return 2120 + (d - 2304);
    const int t = (d - 2816) >> 8, w = (d - 2816) & 255;
    return (w < 128) ? (2632 + 128 * t + w) : (3144 + 128 * t + (w - 128));
}
__device__ __forceinline__ void p0_transpose_item_win(const float* W, bf16* WT, LAS float* scr, int k0, int dn0, int lane) {
    const int n = lane & 31; const int c0 = win_src_col8(dn0 + (n & ~7)); const int col = c0 + (n & 7);
#pragma unroll 8
    for (int i = 0; i < 32; ++i) { const int kk = 2 * i + (lane >> 5); scr[kk * 33 + n] = (c0 >= 0) ? W[(size_t)(k0 + kk) * 3656 + col] : 0.f; }
    LDS_WAIT(); asm volatile("" ::: "memory");
    const int c = lane & 7;
#pragma unroll
    for (int j = 0; j < 4; ++j) { const int nn = (lane >> 3) + 8 * j; const LAS float* s = scr + (8 * c) * 33 + nn;
        v4u o; o.x = pk2(s[0 * 33], s[1 * 33]); o.y = pk2(s[2 * 33], s[3 * 33]); o.z = pk2(s[4 * 33], s[5 * 33]); o.w = pk2(s[6 * 33], s[7 * 33]);
        *(GAS v4u*)(WT + (size_t)(dn0 + nn) * D + k0 + 8 * c) = o; }
    LDS_WAIT(); asm volatile("" ::: "memory");
}
__device__ __forceinline__ float wave_sum(float v) {
#pragma unroll
    for (int o = 1; o < 64; o <<= 1) v += __shfl_xor(v, o);
    return v;
}
__device__ __forceinline__ void ln_row(const float* xrow, const float* g, const float* bta, float* orow, bf16* obrow, int lane) {
    const GAS f32x4* xr = (const GAS f32x4*)xrow + lane;
    f32x4 v[4]; float s = 0.f;
#pragma unroll
    for (int j = 0; j < 4; ++j) { v[j] = xr[64 * j]; s += (v[j].x + v[j].y) + (v[j].z + v[j].w); }
    const float mean = wave_sum(s) * (1.f / D); float s2 = 0.f;
#pragma unroll
    for (int j = 0; j < 4; ++j) { v[j] = v[j] - mean; s2 += (v[j].x * v[j].x + v[j].y * v[j].y) + (v[j].z * v[j].z + v[j].w * v[j].w); }
    const float rstd = 1.f / sqrtf(wave_sum(s2) * (1.f / D) + LN_EPS);
    GAS f32x4* of = (GAS f32x4*)orow + lane; GAS v2u* ob = (GAS v2u*)obrow + lane;
#pragma unroll
    for (int j = 0; j < 4; ++j) { const f32x4 gg = ((const GAS f32x4*)g)[lane + 64 * j], bb = ((const GAS f32x4*)bta)[lane + 64 * j];
        const f32x4 y = v[j] * rstd * gg + bb; of[64 * j] = y; v2u w; w.x = pk2(y.x, y.y); w.y = pk2(y.z, y.w); ob[64 * j] = w; }
}

struct Args { const float* in[19]; float* out; unsigned char* ws; };

__device__ __forceinline__ unsigned row_sum16(unsigned v) {
    v += (unsigned)__builtin_amdgcn_update_dpp(0, (int)v, 0xB1, 0xF, 0xF, true);
    v += (unsigned)__builtin_amdgcn_update_dpp(0, (int)v, 0x4E, 0xF, 0xF, true);
    v += (unsigned)__builtin_amdgcn_update_dpp(0, (int)v, 0x141, 0xF, 0xF, true);
    v += (unsigned)__builtin_amdgcn_update_dpp(0, (int)v, 0x140, 0xF, 0xF, true);
    return v;
}
__device__ __forceinline__ unsigned wave_sum_u(unsigned v) {
    v = row_sum16(v);
    return (unsigned)__builtin_amdgcn_readlane((int)v, 0) + (unsigned)__builtin_amdgcn_readlane((int)v, 16) + (unsigned)__builtin_amdgcn_readlane((int)v, 32) + (unsigned)__builtin_amdgcn_readlane((int)v, 48);
}
__device__ __forceinline__ unsigned score_key(float s) {
    const _Float16 h = (_Float16)s; unsigned hb = (unsigned)__builtin_bit_cast(unsigned short, h);
    return (hb & 0x8000u) ? (hb ^ 0xffffu) : (hb | 0x8000u);
}

typedef short s16x2 __attribute__((ext_vector_type(2)));
typedef _Float16 h16x2 __attribute__((ext_vector_type(2)));
__device__ __forceinline__ unsigned score_key2(float a, float b) {
    const unsigned hb = __builtin_bit_cast(unsigned, __builtin_amdgcn_cvt_pkrtz(a, b));
    const s16x2 sg = __builtin_bit_cast(s16x2, hb) >> 15;
    return hb ^ (__builtin_bit_cast(unsigned, sg) | 0x80008000u);
}
__device__ __forceinline__ int sel_bitpos(int c) { return 32 * (c >> 5) + 16 * (c & 1) + ((c & 31) >> 1); }
__device__ __forceinline__ int sel_keyoff(int p) { const int q = p & 31; return 32 * (p >> 5) + 2 * (q & 15) + (q >> 4); }

__device__ __forceinline__ void transpose16(unsigned (&X)[64], int base) {
#define TR_STEP(S, MSK) _Pragma("unroll") for (int i = 0; i < 16; ++i) if ((i & (S)) == 0) { const unsigned a = X[base + i], bb = X[base + i + (S)]; \
        X[base + i] = (a & (MSK)) | ((bb << (S)) & ~(MSK)); X[base + i + (S)] = ((a >> (S)) & (MSK)) | (bb & ~(MSK)); }
    TR_STEP(8, 0x00ff00ffu) TR_STEP(4, 0x0f0f0f0fu) TR_STEP(2, 0x33333333u) TR_STEP(1, 0x55555555u)
#undef TR_STEP
}
__device__ __forceinline__ void select_planes(const LAS unsigned short* rowp, int Lk, int ntb, unsigned long long* selp  , int lane) {
    unsigned R[64];
#pragma unroll
    for (int i = 0; i < 32; ++i) { const v2u v = *(const LAS v2u*)(rowp + 4 * i); R[2 * i] = v.x; R[2 * i + 1] = v.y; }
    transpose16(R, 0); transpose16(R, 16); transpose16(R, 32); transpose16(R, 48);
    unsigned cand[4], gtm[4];
#pragma unroll
    for (int w = 0; w < 4; ++w) { cand[w] = (128 * lane + 32 * w < Lk) ? 0xffffffffu : 0u; gtm[w] = 0u; }
    unsigned need = 0u;
    if (Lk > TOPK) {
        unsigned above = 0u;
#pragma unroll
        for (int b = 15; b >= 0; --b) {
            const unsigned o0 = cand[0] & R[b], o1 = cand[1] & R[16 + b], o2 = cand[2] & R[32 + b], o3 = cand[3] & R[48 + b];
            const unsigned c1 = wave_sum_u((unsigned)__builtin_popcount(o0) + (unsigned)__builtin_popcount(o1) + (unsigned)__builtin_popcount(o2) + (unsigned)__builtin_popcount(o3));
            if (above + c1 >= (unsigned)TOPK) { cand[0] = o0; cand[1] = o1; cand[2] = o2; cand[3] = o3; }
            else { above += c1; gtm[0] |= o0; gtm[1] |= o1; gtm[2] |= o2; gtm[3] |= o3; cand[0] &= ~R[b]; cand[1] &= ~R[16 + b]; cand[2] &= ~R[32 + b]; cand[3] &= ~R[48 + b]; }
        }
        need = (unsigned)TOPK - above;
    } else {
#pragma unroll
        for (int w = 0; w < 4; ++w) { gtm[w] = cand[w]; cand[w] = 0u; }
    }
    { const int ce = __builtin_popcount(cand[0]) + __builtin_popcount(cand[1]) + __builtin_popcount(cand[2]) + __builtin_popcount(cand[3]); int incl = ce;
#pragma unroll
      for (int d = 1; d < 64; d <<= 1) { const int v = __shfl_up(incl, d); if (lane >= d) incl += v; }
      int allow = (int)need - (incl - ce); allow = allow < 0 ? 0 : (allow > ce ? ce : allow);
#pragma unroll
      for (int w = 0; w < 4; ++w) { const int cw = __builtin_popcount(cand[w]); const int take = allow < cw ? allow : cw; allow -= take;
          unsigned x = cand[w], sbits = 0u;
          if (take == cw) sbits = x; else for (int i = 0; i < take; ++i) { const unsigned lb = x & (0u - x); sbits |= lb; x ^= lb; }
          gtm[w] |= sbits; } }
    if (2 * lane < ntb) selp[(size_t)(2 * lane) * SEQ] = ((unsigned long long)gtm[1] << 32) | gtm[0];
    if (2 * lane + 1 < ntb) selp[(size_t)(2 * lane + 1) * SEQ] = ((unsigned long long)gtm[3] << 32) | gtm[2];
}

__global__ void __launch_bounds__(NWAVES * 64, 2) mega_fwd(Args args) {
    extern __shared__ __attribute__((aligned(16))) unsigned char lds[];
    LAS unsigned char* const L = (LAS unsigned char*)lds;
    volatile LAS unsigned* const MISC = (volatile LAS unsigned*)(L + MISC_OFF);
    const int G = gridDim.x, bx = blockIdx.x;
    const int vcu = (G % 8 == 0) ? (bx % 8) * (G / 8) + bx / 8 : bx;
    gu32* const ctl = (gu32*)(args.ws + WS_CTL);
    const int tid = threadIdx.x;
#define PHASE_VIEW() int tid_p = threadIdx.x; asm volatile("" : "+v"(tid_p)); const int lane = tid_p & 63, wave = __builtin_amdgcn_readfirstlane(tid_p >> 6); size_t z_ = 0; asm volatile("" : "+s"(z_)); unsigned char* ws = args.ws + z_; float* out = args.out + z_;     \
    const int gw = vcu * NWAVES + wave, NGW = G * NWAVES; (void)lane; (void)gw; (void)NGW; (void)out; \
    bf16* const XB = (bf16*)(ws + WS_XB); float* const R = (float*)(ws + WS_R); bf16* const HB = (bf16*)(ws + WS_BIG); bf16* const PB = (bf16*)(ws + WS_PB); \
    bf16* const QKVI = (bf16*)(ws + WS_QKVI); bf16* const KI = (bf16*)(ws + WS_KI); float* const WI = (float*)(ws + WS_WI); bf16* const BC = (bf16*)(ws + WS_BC); bf16* const Z = (bf16*)(ws + WS_Z); \
    unsigned long long* const SEL = (unsigned long long*)(ws + WS_SEL); \
    const bf16* const Qb = QKVI; const bf16* const Kb = QKVI + (size_t)M * 512; const bf16* const Vb = QKVI + (size_t)2 * M * 512; const bf16* const QIb = QKVI + (size_t)3 * M * 512; \
    (void)XB; (void)R; (void)HB; (void)PB; (void)KI; (void)WI; (void)BC; (void)Z; (void)SEL; (void)Qb; (void)Kb; (void)Vb; (void)QIb;

    for (int u = tid; u < (LDS_BYTES - LDSCTL_OFF) / 4; u += NWAVES * 64) ((LAS unsigned*)(L + LDSCTL_OFF))[u] = 0u;
    __syncthreads();
    XcdBarrier bar = xcd_barrier_post((unsigned*)(ctl + CW_BAR), MISC + 8);
#define GRID_BAR() xcd_barrier(bar)

    { PHASE_VIEW();
        const float* const x = args.in[0]; const float* const pin = args.in[1];
        LAS float* scr = (LAS float*)(L + RING_OFF + wave * 16384);
        constexpr int I_GU = (D / 64) * (NGU / 32), I_D = (FF / 64) * (D / 32), I_IN = (D / 64) * (NIN / 32), I_SQ = (D / 64) * (D / 32), I_P = (DPLE / 64) * (D / 32);
        constexpr int NITEMS = 2 * I_GU + 2 * I_D + I_IN + 2 * I_SQ + I_P;
        for (int it = gw; it < NITEMS; it += NGW) {
            int r = it;
            if (r < 2 * I_GU) { const int f = r / I_GU; r -= f * I_GU; const int nb = r % (NGU / 32), kb = r / (NGU / 32), dn0 = 32 * nb;
                const int half = (dn0 >> 7) & 1, j0 = ((dn0 >> 8) << 7) + (dn0 & 127);
                const float* W = f ? (half ? args.in[13] : args.in[12]) : (half ? args.in[5] : args.in[4]);
                p0_transpose_item(W, D, FF, (bf16*)(ws + (f ? WS_WGU2 : WS_WGU1)), scr, 64 * kb, dn0, j0, lane); continue; }
            r -= 2 * I_GU;
            if (r < 2 * I_D) { const int f = r / I_D; r -= f * I_D; const int nb = r % (D / 32), kb = r / (D / 32);
                p0_transpose_item(f ? args.in[14] : args.in[6], FF, D, (bf16*)(ws + (f ? WS_WD2 : WS_WD1)), scr, 64 * kb, 32 * nb, 32 * nb, lane); continue; }
            r -= 2 * I_D;
            if (r < I_IN) { const int nb = r % (NIN / 32), kb = r / (NIN / 32); p0_transpose_item_win(args.in[7], (bf16*)(ws + WS_WIN), scr, 64 * kb, 32 * nb, lane); continue; }
            r -= I_IN;
            if (r < 2 * I_SQ) { const int f = r / I_SQ; r -= f * I_SQ; const int nb = r % (D / 32), kb = r / (D / 32);
                p0_transpose_item(f ? args.in[17] : args.in[9], D, D, (bf16*)(ws + (f ? WS_WGATE : WS_WOUT)), scr, 64 * kb, 32 * nb, 32 * nb, lane); continue; }
            r -= 2 * I_SQ;
            { const int nb = r % (D / 32), kb = r / (D / 32); p0_transpose_item(args.in[18], DPLE, D, (bf16*)(ws + WS_WP), scr, 64 * kb, 32 * nb, 32 * nb, lane); }
        }
        const size_t gt = (size_t)bx * (NWAVES * 64) + tid_p, GT = (size_t)G * NWAVES * 64;
        for (size_t i = gt; i < (size_t)M * D / 8; i += GT) { const f32x4 a = ((const GAS f32x4*)x)[2 * i], b = ((const GAS f32x4*)x)[2 * i + 1];
            v4u o; o.x = pk2(a.x, a.y); o.y = pk2(a.z, a.w); o.z = pk2(b.x, b.y); o.w = pk2(b.z, b.w); ((GAS v4u*)XB)[i] = o; }
        for (size_t i = gt; i < (size_t)M * DPLE / 8; i += GT) { const f32x4 a = ((const GAS f32x4*)pin)[2 * i], b = ((const GAS f32x4*)pin)[2 * i + 1];
            v4u o; o.x = pk2(a.x, a.y); o.y = pk2(a.z, a.w); o.z = pk2(b.x, b.y); o.w = pk2(b.z, b.w); ((GAS v4u*)PB)[i] = o; }
    }
    GRID_BAR();

    { PHASE_VIEW(); pg8::Gemm g{XB, (const bf16*)(ws + WS_WGU1), M, NGU, D}; pg8::StaticOrder S; S.init(M, NGU, G, bx);
      pg8::EpiSwiGLU E{HB, FF};
      pg8::gemm_phase<pg8::EpiSwiGLU, pg8::StaticOrder, true, true>(L + RING_OFF, g, S, E); }
    GRID_BAR();
    { PHASE_VIEW(); pg8::Gemm g{HB, (const bf16*)(ws + WS_WD1), M, D, FF}; pg8::StaticOrder S; S.init(M, D, G, bx);
      pg8::EpiRes E{args.in[0], R, D, DN_ALPHA, 0.5f};
      pg8::gemm_phase<pg8::EpiRes, pg8::StaticOrder, true, true>(L + RING_OFF, g, S, E); }
    GRID_BAR();
    { PHASE_VIEW(); for (int m = gw; m < M; m += NGW) ln_row(R + (size_t)m * D, args.in[2], args.in[3], out + (size_t)m * D, XB + (size_t)m * D, lane); }
    GRID_BAR();
    { PHASE_VIEW(); pg8::Gemm g{XB, (const bf16*)(ws + WS_WIN), M, NIN, D}; pg8::StaticOrder S; S.init(M, NIN, G, bx);
      pg8::EpiWin E{QKVI, KI, WI, BC, Z, M, IDX_SCALE, 0.125f * LOG2E};
      pg8::gemm_phase<pg8::EpiWin, pg8::StaticOrder, true, true>(L + RING_OFF, g, S, E); }
    GRID_BAR();

    for (int rep5 = 0; rep5 < REP_P5; ++rep5) { PHASE_VIEW();
        LAS unsigned short* const sc = (LAS unsigned short*)L;
        const int r32 = lane & 31, hi = lane >> 5;
        for (int un = bx; un < BATCH * (SEQ / 8); un += G) {
            const int b = un & 3, g8 = un >> 2;
            const int t0 = 8 * g8, c = t0 >> 6, nslots = c + 1, nt32 = 2 * nslots;
            const size_t rowbase = (size_t)b * SEQ;
            bf16x8 A[2][4]; float w[2][16];
            { const int hh = (r32 >> 2) & 1, i = (r32 & 3) + 4 * (r32 >> 3);
#pragma unroll
              for (int blk = 0; blk < 2; ++blk) { const bf16* src = QIb + (rowbase + t0 + 4 * blk + 2 * hh + (i >> 3)) * 512 + (i & 7) * 64 + 8 * hi;
#pragma unroll
                  for (int ks = 0; ks < 4; ++ks) A[blk][ks] = *(const GAS bf16x8*)(src + 16 * ks); }
#pragma unroll
              for (int blk = 0; blk < 2; ++blk)
#pragma unroll
                  for (int q2 = 0; q2 < 2; ++q2) { const float* wp = WI + (rowbase + t0 + 4 * blk + 2 * hi + q2) * 8; const f32x4 a = *(const GAS f32x4*)wp, bb = *(const GAS f32x4*)(wp + 4);
                      w[blk][q2 * 8 + 0] = a.x; w[blk][q2 * 8 + 1] = a.y; w[blk][q2 * 8 + 2] = a.z; w[blk][q2 * 8 + 3] = a.w; w[blk][q2 * 8 + 4] = bb.x; w[blk][q2 * 8 + 5] = bb.y; w[blk][q2 * 8 + 6] = bb.z; w[blk][q2 * 8 + 7] = bb.w; } }
            const bf16* kb = KI + rowbase * 64 + hi * 256 + r32 * 8;
            bf16x8 B0[4], B1[4], B2[4];
#define IDX_LDB(Bx, ktx) do { const int kc_ = (ktx) < nt32 ? (ktx) : nt32 - 1;     \
                _Pragma("unroll") for (int ks = 0; ks < 4; ++ks) Bx[ks] = *(const GAS bf16x8*)(kb + (size_t)kc_ * 2048 + 512 * ks); } while (0)
#define IDX_RF(sacc, wv, av) do { const float fv_ = av; const int ri_ = __float_as_int(fv_); sacc = __builtin_fmaf(wv, __int_as_float(ri_ > 0 ? ri_ : 0), sacc); asm("" : "+v"(sacc)); } while (0)
#define IDX_TILE(Bx, ktx) do { f32x16 a0 = {}, a1 = {}; \
                _Pragma("unroll") for (int ks = 0; ks < 4; ++ks) { a0 = __builtin_amdgcn_mfma_f32_32x32x16_bf16(A[0][ks], Bx[ks], a0, 0, 0, 0); a1 = __builtin_amdgcn_mfma_f32_32x32x16_bf16(A[1][ks], Bx[ks], a1, 0, 0, 0); } \
                const int key = 32 * ((ktx) < nt32 ? (ktx) : nt32 - 1) + r32; LAS unsigned short* dst = sc + (key >> 7) * 132 + (key & 127) + 2 * hi * SROW_U16; \
                float s00 = 0.f, s01 = 0.f, s10 = 0.f, s11 = 0.f; \
                _Pragma("unroll") for (int h = 0; h < 8; ++h) { IDX_RF(s00, w[0][h], a0[h]); IDX_RF(s01, w[0][8 + h], a0[8 + h]); IDX_RF(s10, w[1][h], a1[h]); IDX_RF(s11, w[1][8 + h], a1[8 + h]); } \
                const unsigned k0_ = score_key2(s00, s01), k1_ = score_key2(s10, s11); \
                dst[0] = (unsigned short)k0_; dst[SROW_U16] = (unsigned short)(k0_ >> 16); dst[4 * SROW_U16] = (unsigned short)k1_; dst[5 * SROW_U16] = (unsigned short)(k1_ >> 16); } while (0)
            for (int rsc = 0; rsc < REP_SCORE; ++rsc) {
            int kt = wave;
            IDX_LDB(B0, kt); IDX_LDB(B1, kt + NWAVES);
            for (; kt < nt32; kt += 3 * NWAVES) {
                IDX_LDB(B2, kt + 2 * NWAVES); IDX_TILE(B0, kt);
                IDX_LDB(B0, kt + 3 * NWAVES); IDX_TILE(B1, kt + NWAVES);
                IDX_LDB(B1, kt + 4 * NWAVES); IDX_TILE(B2, kt + 2 * NWAVES);
            }
            }
#undef IDX_LDB
#undef IDX_TILE
#undef IDX_RF
            __syncthreads();
            {
                const int t = t0 + wave; const int ntb = 4 * ((c >> 2) + 1);
                for (int rsl = 0; rsl < REP_SELECT; ++rsl) select_planes(sc + wave * SROW_U16 + lane * 132, 64 * nslots, ntb, SEL + (size_t)b * 128 * SEQ + t, lane);
            }
            __syncthreads();
        }
        { const float* cw = args.in[8]; float cwv[3][8];
#pragma unroll
          for (int j = 0; j < 3; ++j) { const f32x4 a = *(const GAS f32x4*)(cw + j * DC + 8 * lane), bb = *(const GAS f32x4*)(cw + j * DC + 8 * lane + 4);
              cwv[j][0] = a.x; cwv[j][1] = a.y; cwv[j][2] = a.z; cwv[j][3] = a.w; cwv[j][4] = bb.x; cwv[j][5] = bb.y; cwv[j][6] = bb.z; cwv[j][7] = bb.w; }
          for (int m = gw; m < M; m += NGW) { const int t = m & (SEQ - 1);
              const v4u zero = {0u, 0u, 0u, 0u};
              const v4u z2 = *(const GAS v4u*)(Z + (size_t)m * 512 + 8 * lane);
              const v4u z1 = (t >= 1) ? *(const GAS v4u*)(Z + (size_t)(m - 1) * 512 + 8 * lane) : zero;
              const v4u z0 = (t >= 2) ? *(const GAS v4u*)(Z + (size_t)(m - 2) * 512 + 8 * lane) : zero;
              const v4u bv = *(const GAS v4u*)(BC + (size_t)m * 512 + 8 * lane);
              float y[8];
#pragma unroll
              for (int e = 0; e < 4; ++e) { y[2 * e] = bf_lo(bv[e]) * (cwv[0][2 * e] * bf_lo(z0[e]) + cwv[1][2 * e] * bf_lo(z1[e]) + cwv[2][2 * e] * bf_lo(z2[e]));
                  y[2 * e + 1] = bf_hi(bv[e]) * (cwv[0][2 * e + 1] * bf_hi(z0[e]) + cwv[1][2 * e + 1] * bf_hi(z1[e]) + cwv[2][2 * e + 1] * bf_hi(z2[e])); }
              v4u o; o.x = pk2(y[0], y[1]); o.y = pk2(y[2], y[3]); o.z = pk2(y[4], y[5]); o.w = pk2(y[6], y[7]);
              *(GAS v4u*)(XB + (size_t)m * D + DA + 8 * lane) = o; } }
    }
    GRID_BAR();

#if !SPARSE_ATTN
    for (int rep6 = 0; rep6 < REP_P6; ++rep6) { PHASE_VIEW();
        const attn_body::AttnTensors AT{(const attn_body::bf16*)Qb, (const attn_body::bf16*)Kb, (const attn_body::bf16*)Vb, SEL, (attn_body::bf16*)XB};
        const attn_body::StaticOrder S(G, bx);
        attn_body::attn_phase<attn_body::StaticOrder>((char*)lds + RING_OFF, AT, S);
    }
#else
    for (int rep6 = 0; rep6 < REP_P6; ++rep6) { PHASE_VIEW();
        const int h = bx & 7, wx = (bx >> 3) * NWAVES + wave, NWX = (G >> 3) * NWAVES;
        LAS unsigned short* const list = (LAS unsigned short*)(L + wave * 512);
        const float slope2 = __builtin_amdgcn_exp2f(-(float)(h + 1)) * LOG2E;
        const int kk = lane >> 3, part = lane & 7;
        for (int b = 0; b < BATCH; ++b)
            for (int t = wx; t < SEQ; t += NWX) {
                const int nslots = (t >> 6) + 1; const int n = nslots * 64 < TOPK ? nslots * 64 : TOPK;
                const size_t rowbase = (size_t)b * SEQ;
                const unsigned long long* selp = SEL + (size_t)b * 128 * SEQ + t;
                unsigned long long w0 = (lane < nslots) ? selp[(size_t)lane * SEQ] : 0ull, w1 = (lane + 64 < nslots) ? selp[(size_t)(lane + 64) * SEQ] : 0ull;
                const int cnt = __popcll(w0) + __popcll(w1); int incl = cnt;
#pragma unroll
                for (int d = 1; d < 64; d <<= 1) { const int v = __shfl_up(incl, d); if (lane >= d) incl += v; }
                int pos = incl - cnt;
                while (w0) { const int bp = sel_keyoff(__ffsll((long long)w0) - 1); if (pos < TOPK) list[pos] = (unsigned short)(lane * 64 + bp); ++pos; w0 &= w0 - 1ull; }
                while (w1) { const int bp = sel_keyoff(__ffsll((long long)w1) - 1); if (pos < TOPK) list[pos] = (unsigned short)((lane + 64) * 64 + bp); ++pos; w1 &= w1 - 1ull; }
                LDS_WAIT();
                float q[8];
                { const v4u qv = *(const GAS v4u*)(Qb + (rowbase + t) * 512 + h * 64 + 8 * part); const float sc2 = 1.0f;
#pragma unroll
                  for (int e = 0; e < 4; ++e) { q[2 * e] = bf_lo(qv[e]) * sc2; q[2 * e + 1] = bf_hi(qv[e]) * sc2; } }
                float mrun = -INFINITY, lrun = 0.f, o[8];
#pragma unroll
                for (int e = 0; e < 8; ++e) o[e] = 0.f;
                const bf16* Kh = Kb + rowbase * 512 + h * 64 + 8 * part; const bf16* Vh = Vb + rowbase * 512 + h * 64 + 8 * part;
                for (int i = 0; i < n; i += 32) {
                    int key[4]; v4u kv[4], vv[4];
#pragma unroll
                    for (int u = 0; u < 4; ++u) key[u] = list[i + 8 * u + kk];
#pragma unroll
                    for (int u = 0; u < 4; ++u) { kv[u] = *(const GAS v4u*)(Kh + (size_t)key[u] * 512); vv[u] = *(const GAS v4u*)(Vh + (size_t)key[u] * 512); }
#pragma unroll
                    for (int u = 0; u < 4; ++u) {
                        float d = 0.f;
#pragma unroll
                        for (int e = 0; e < 4; ++e) d += q[2 * e] * bf_lo(kv[u][e]) + q[2 * e + 1] * bf_hi(kv[u][e]);
                        d += __shfl_xor(d, 1); d += __shfl_xor(d, 2); d += __shfl_xor(d, 4);
                        const int dist = t - key[u]; const float lg = d - slope2 * (float)(dist < 0 ? -dist : dist);
                        const float mn = __builtin_fmaxf(mrun, lg), al = __builtin_amdgcn_exp2f(mrun - mn), pp = __builtin_amdgcn_exp2f(lg - mn);
                        lrun = lrun * al + pp; mrun = mn;
#pragma unroll
                        for (int e = 0; e < 4; ++e) { o[2 * e] = o[2 * e] * al + pp * bf_lo(vv[u][e]); o[2 * e + 1] = o[2 * e + 1] * al + pp * bf_hi(vv[u][e]); }
                    }
                }
#pragma unroll
                for (int d = 8; d < 64; d <<= 1) { const float mo = __shfl_xor(mrun, d), lo_ = __shfl_xor(lrun, d); const float mn = __builtin_fmaxf(mrun, mo), a = __builtin_amdgcn_exp2f(mrun - mn), bsc = __builtin_amdgcn_exp2f(mo - mn);
                    lrun = lrun * a + lo_ * bsc;
#pragma unroll
                    for (int e = 0; e < 8; ++e) { const float oo = __shfl_xor(o[e], d); o[e] = o[e] * a + oo * bsc; }
                    mrun = mn; }
                if (kk == 0) { const float rl = 1.0f / lrun; v4u ov; ov.x = pk2(o[0] * rl, o[1] * rl); ov.y = pk2(o[2] * rl, o[3] * rl); ov.z = pk2(o[4] * rl, o[5] * rl); ov.w = pk2(o[6] * rl, o[7] * rl);
                    *(GAS v4u*)(XB + (rowbase + t) * D + h * 64 + 8 * part) = ov; }
                LDS_WAIT();
            }
    }
#endif
    GRID_BAR();

#if PROBE_CHECK
    { PHASE_VIEW();
        unsigned bad = 0u; float maxd = 0.f;
        for (int qs = gw; qs < 1500; qs += NGW) {
            const int gq = (qs * 21 + 3) % M; const int b = gq / SEQ, t = gq % SEQ;
            const int nslots = (t >> 6) + 1, Lk = 64 * nslots, n = Lk < TOPK ? Lk : TOPK;
            const size_t rowbase = (size_t)b * SEQ, row = rowbase + t;
            float wv[8];
#pragma unroll
            for (int h = 0; h < 8; ++h) wv[h] = WI[row * 8 + h];
            float minsel = INFINITY, maxuns = -INFINITY; int cnt = 0;
            for (int key = lane; key < Lk; key += 64) {
                float sc_ = 0.f;
                for (int h = 0; h < 8; ++h) { float rel = 0.f;
                    for (int d = 0; d < 64; d += 2) { const unsigned qa = *(const GAS unsigned*)(QIb + row * 512 + h * 64 + d), ka = *(const GAS unsigned*)(KI + ((rowbase + key) >> 5) * 2048 + (d >> 3) * 256 + ((rowbase + key) & 31) * 8 + (d & 7)); rel += bf_lo(qa) * bf_lo(ka) + bf_hi(qa) * bf_hi(ka); }
                    sc_ += wv[h] * __builtin_fmaxf(rel, 0.f); }
                const unsigned long long wd = SEL[((size_t)b * 128 + (key >> 6)) * SEQ + t];
                if ((wd >> sel_bitpos(key & 63)) & 1ull) { ++cnt; minsel = __builtin_fminf(minsel, sc_); } else maxuns = __builtin_fmaxf(maxuns, sc_);
            }
#pragma unroll
            for (int o = 1; o < 64; o <<= 1) { cnt += __shfl_xor(cnt, o); minsel = __builtin_fminf(minsel, __shfl_xor(minsel, o)); maxuns = __builtin_fmaxf(maxuns, __shfl_xor(maxuns, o)); }
            if (cnt != n) bad |= 1u;
            if (Lk > TOPK && maxuns > minsel + 0.004f * __builtin_fabsf(minsel) + 0.002f) bad |= 2u;
            const int h = lane >> 3, part = lane & 7; const float slope = __builtin_amdgcn_exp2f(-(float)(h + 1));
            float q[8], o[8]; float mrun = -INFINITY, lrun = 0.f;
            { const v4u qv = *(const GAS v4u*)(Qb + row * 512 + h * 64 + 8 * part);
#pragma unroll
              for (int e = 0; e < 4; ++e) { q[2 * e] = bf_lo(qv[e]); q[2 * e + 1] = bf_hi(qv[e]); o[2 * e] = 0.f; o[2 * e + 1] = 0.f; } }
            for (int j = 0; j < nslots; ++j) { unsigned long long wd = SEL[((size_t)b * 128 + j) * SEQ + t];
                while (wd) { const int key = 64 * j + sel_keyoff(__ffsll((long long)wd) - 1); wd &= wd - 1ull;
                    const v4u kv = *(const GAS v4u*)(Kb + (rowbase + key) * 512 + h * 64 + 8 * part), vv = *(const GAS v4u*)(Vb + (rowbase + key) * 512 + h * 64 + 8 * part);
                    float d = 0.f;
#pragma unroll
                    for (int e = 0; e < 4; ++e) d += q[2 * e] * bf_lo(kv[e]) + q[2 * e + 1] * bf_hi(kv[e]);
                    d += __shfl_xor(d, 1); d += __shfl_xor(d, 2); d += __shfl_xor(d, 4);
                    const int dist = t - key; const float lg = d * 0.6931471805599453f - slope * (float)(dist < 0 ? -dist : dist);
                    const float mn = __builtin_fmaxf(mrun, lg), al = __expf(mrun - mn), pp = __expf(lg - mn);
                    lrun = lrun * al + pp; mrun = mn;
#pragma unroll
                    for (int e = 0; e < 4; ++e) { o[2 * e] = o[2 * e] * al + pp * bf_lo(vv[e]); o[2 * e + 1] = o[2 * e + 1] * al + pp * bf_hi(vv[e]); } } }
            const v4u fv = *(const GAS v4u*)(XB + row * D + h * 64 + 8 * part);
            float dmax = 0.f, amax = 0.f;
#pragma unroll
            for (int e = 0; e < 4; ++e) { const float r0 = o[2 * e] / lrun, r1 = o[2 * e + 1] / lrun; dmax = __builtin_fmaxf(dmax, __builtin_fmaxf(__builtin_fabsf(r0 - bf_lo(fv[e])), __builtin_fabsf(r1 - bf_hi(fv[e])))); amax = __builtin_fmaxf(amax, __builtin_fmaxf(__builtin_fabsf(r0), __builtin_fabsf(r1))); }
#pragma unroll
            for (int o2 = 1; o2 < 8; o2 <<= 1) { dmax = __builtin_fmaxf(dmax, __shfl_xor(dmax, o2)); amax = __builtin_fmaxf(amax, __shfl_xor(amax, o2)); }
            maxd = __builtin_fmaxf(maxd, dmax / (amax + 1e-6f));
        }
        atomicMax((unsigned*)(ctl + 8), __float_as_uint(maxd)); if (bad) atomicOr((unsigned*)(ctl + 9), bad);
    }
#endif
    { PHASE_VIEW(); pg8::Gemm g{XB, (const bf16*)(ws + WS_WOUT), M, D, D}; pg8::StaticOrder S; S.init(M, D, G, bx);
      pg8::EpiRes E{out, R, D, DN_ALPHA, 1.0f};
      pg8::gemm_phase<pg8::EpiRes, pg8::StaticOrder, true, true>(L + RING_OFF, g, S, E); }
    GRID_BAR();
    { PHASE_VIEW(); for (int m = gw; m < M; m += NGW) ln_row(R + (size_t)m * D, args.in[10], args.in[11], out + (size_t)m * D, XB + (size_t)m * D, lane); }
    GRID_BAR();
    { PHASE_VIEW(); pg8::Gemm g{XB, (const bf16*)(ws + WS_WGU2), M, NGU, D}; pg8::StaticOrder S; S.init(M, NGU, G, bx);
      pg8::EpiSwiGLU E{HB, FF};
      pg8::gemm_phase<pg8::EpiSwiGLU, pg8::StaticOrder, true, true>(L + RING_OFF, g, S, E); }
    GRID_BAR();
    { PHASE_VIEW(); pg8::Gemm g{HB, (const bf16*)(ws + WS_WD2), M, D, FF}; pg8::StaticOrder S; S.init(M, D, G, bx);
      pg8::EpiRes E{out, R, D, DN_ALPHA, 0.5f};
      pg8::gemm_phase<pg8::EpiRes, pg8::StaticOrder, true, true>(L + RING_OFF, g, S, E); }
    GRID_BAR();
    { PHASE_VIEW(); for (int m = gw; m < M; m += NGW) ln_row(R + (size_t)m * D, args.in[15], args.in[16], out + (size_t)m * D, XB + (size_t)m * D, lane); }
    GRID_BAR();
    { PHASE_VIEW(); pg8::Gemm g{PB, (const bf16*)(ws + WS_WP), M, D, DPLE}; pg8::StaticOrder S; S.init(M, D, G, bx);
      pg8::EpiF32 E{R, D};
      pg8::gemm_phase<pg8::EpiF32, pg8::StaticOrder, true, true>(L + RING_OFF, g, S, E); }
    { PHASE_VIEW(); pg8::Gemm g{XB, (const bf16*)(ws + WS_WGATE), M, D, D}; pg8::StaticOrder S; S.init(M, D, G, bx);
      pg8::EpiGate E{out, R, out, D};
      pg8::gemm_phase<pg8::EpiGate, pg8::StaticOrder, true, true>(L + RING_OFF, g, S, E); }
#if PROBE_CHECK
    GRID_BAR();
    { PHASE_VIEW(); const float md = __uint_as_float(__hip_atomic_load((unsigned*)(ctl + 8), RLX_AGENT)); const unsigned bd = __hip_atomic_load((unsigned*)(ctl + 9), RLX_AGENT);
      float E = 0.f; if (md > 0.02f || !(md == md)) E += (md < 0.5f ? md : 0.5f); if (bd & 1u) E += 1.0f; if (bd & 2u) E += 2.0f;
      if (E > 0.f) { const size_t gt = (size_t)bx * (NWAVES * 64) + tid_p, GT = (size_t)G * NWAVES * 64;
          for (size_t i = gt; i < (size_t)M * D / 4; i += GT) { f32x4 v = ((GAS f32x4*)out)[i]; v = v * (1.0f + E); ((GAS f32x4*)out)[i] = v; } } }
#endif

}

extern "C" void kernel_launch(void* const* d_in, const int* in_sizes, int n_in, void* d_out, int out_size, void* d_ws, size_t ws_size, hipStream_t stream) {
    static int grid = 0;
    if (grid == 0) {
        if (n_in != 19 || in_sizes[0] != M * D || out_size != M * D || ws_size < WS_END) { fprintf(stderr, "kernel_launch: unexpected problem (n_in %d, in0 %d, out %d, ws %zu < %zu); nothing launched\n", n_in, n_in > 0 ? in_sizes[0] : -1, out_size, ws_size, (size_t)WS_END); grid = -1; return; }
        int dev = 0, cus = 0, per_cu = 0;
        if (hipGetDevice(&dev) != hipSuccess || hipDeviceGetAttribute(&cus, hipDeviceAttributeMultiprocessorCount, dev) != hipSuccess) { fprintf(stderr, "kernel_launch: device query failed\n"); grid = -1; return; }
        if (hipFuncSetAttribute((const void*)mega_fwd, hipFuncAttributeMaxDynamicSharedMemorySize, LDS_BYTES) != hipSuccess) { fprintf(stderr, "kernel_launch: hipFuncSetAttribute failed\n"); grid = -1; return; }
        if (hipOccupancyMaxActiveBlocksPerMultiprocessor(&per_cu, (const void*)mega_fwd, NWAVES * 64, LDS_BYTES) != hipSuccess || per_cu < 1) { fprintf(stderr, "kernel_launch: occupancy query says %d workgroups per CU\n", per_cu); }
        (void)hipGetLastError();
        grid = cus;
        if (grid % 8 != 0 || grid < 8) { fprintf(stderr, "kernel_launch: CU count %d is not a multiple of 8\n", grid); grid = -1; return; }
    }
    if (grid < 0) return;
    if (hipMemsetAsync((char*)d_ws + WS_CTL, 0, CTL_ZERO_BYTES, stream) != hipSuccess) { fprintf(stderr, "kernel_launch: memset failed\n"); return; }
    Args a{};
    for (int i = 0; i < 19; ++i) a.in[i] = (const float*)d_in[i];
    a.out = (float*)d_out; a.ws = (unsigned char*)d_ws;
    hipLaunchKernelGGL(mega_fwd, dim3(grid), dim3(NWAVES * 64), LDS_BYTES, stream, a);
}
```

```cpp
#include <hip/hip_runtime.h>
#include <hip/hip_bf16.h>
#include <cmath>
#include <cstdio>
#include <cstdint>
namespace pg8 {
#define PG8_LAS __attribute__((address_space(3)))
typedef unsigned short bf16_t;
typedef short bf16x8 __attribute__((ext_vector_type(8)));
typedef float f32x4 __attribute__((ext_vector_type(4)));
typedef unsigned u32x4 __attribute__((ext_vector_type(4)));
constexpr int BM = 256, BK = 64, HALF = 128, HTB = HALF * BK * 2  , STAGE_BYTES = 8 * HTB, NXCD = 8, WGM = 8;

__host__ __device__ __forceinline__ int lds_byte(int r, int c) { const int st = (r >> 4) * 2 + (c >> 5), rr = r & 15, cc = c & 31, ob = rr * 64 + cc * 2; return st * 1024 + (ob ^ (((ob >> 9) & 1) << 5)); }
__host__ __device__ __forceinline__ void stage_rc(int b, int& R, int& C) { const int st = b / 1024, sb = b % 1024, swz = sb ^ (((sb >> 9) & 1) << 5); R = (st >> 1) * 16 + swz / 64; C = (st & 1) * 32 + (swz % 64) / 2; }
__host__ __device__ __forceinline__ int perm32(int rho) { const int n = rho >> 4, i = rho & 15; return 8 * (i >> 2) + 4 * n + (i & 3); }

struct Unit { int pm, pn; };
struct Gemm { const bf16_t* A; const bf16_t* Bt; int M, N, K; };

struct StaticOrder {
    int nM, nN, nwg, G, c;
    __host__ __device__ void init(int M, int N, int G_, int c_) { nM = M / BM; nN = N / BM; nwg = nM * nN; G = G_; c = c_; }
    __host__ __device__ bool next(int i, Unit& u) const {
        const long L = (long)i * G + c; if (L >= nwg) return false;
        int wgid = (int)L; { const int q = nwg / NXCD, r = nwg % NXCD, xcd = wgid % NXCD, off = wgid / NXCD; wgid = (xcd < r ? xcd * (q + 1) : r * (q + 1) + (xcd - r) * q) + off; }
        const int nig = WGM * nN, gid = wgid / nig, fm = gid * WGM, gsz = (nM - fm) < WGM ? (nM - fm) : WGM;
        u.pm = fm + ((wgid % nig) % gsz); u.pn = (wgid % nig) / gsz; return true;
    }
    __device__ __forceinline__ void a_ready(const Unit&) const {}
    __device__ __forceinline__ void done(const Unit&) const {}
};

__device__ __forceinline__ unsigned cvt_pk_bf16(float lo, float hi) { unsigned r; asm volatile("v_cvt_pk_bf16_f32 %0, %1, %2" : "=v"(r) : "v"(lo), "v"(hi)); return r; }
__device__ __forceinline__ float silu_mul(float g, float u) { return g * __builtin_amdgcn_rcpf(1.0f + __builtin_amdgcn_exp2f(-1.4426950408889634f * g)) * u; }
__device__ __forceinline__ float sigmoidf_(float g) { return __builtin_amdgcn_rcpf(1.0f + __builtin_amdgcn_exp2f(-1.4426950408889634f * g)); }

struct EpiSwiGLU {
    static constexpr bool PERM = true, AFTER_DRAIN = false;
    bf16_t* H; int ldh;
    __device__ __forceinline__ void operator()(const f32x4 (&acc)[2][2][4][2], const Unit& u, int wr, int wc, int fr, int fq) const {
        const int row0 = u.pm * BM + wr * 64 + fr, col0 = u.pn * HALF + wc * 32 + 8 * fq;
#pragma unroll
        for (int ai = 0; ai < 2; ++ai)
#pragma unroll
            for (int m = 0; m < 4; ++m) { bf16_t* rowp = H + (size_t)(row0 + ai * HALF + m * 16) * ldh + col0;
                const f32x4 g0 = acc[ai][0][m][0], g1 = acc[ai][0][m][1], u0 = acc[ai][1][m][0], u1 = acc[ai][1][m][1];
                u32x4 w; w.x = cvt_pk_bf16(silu_mul(g0[0], u0[0]), silu_mul(g0[1], u0[1])); w.y = cvt_pk_bf16(silu_mul(g0[2], u0[2]), silu_mul(g0[3], u0[3]));
                w.z = cvt_pk_bf16(silu_mul(g1[0], u1[0]), silu_mul(g1[1], u1[1])); w.w = cvt_pk_bf16(silu_mul(g1[2], u1[2]), silu_mul(g1[3], u1[3]));
                *(u32x4*)rowp = w; }
    }
};
struct EpiRes {
    static constexpr bool PERM = false, AFTER_DRAIN = false;
    const float* base; float* out; int ldc; float alpha, s;
    __device__ __forceinline__ void operator()(const f32x4 (&acc)[2][2][4][2], const Unit& u, int wr, int wc, int fr, int fq) const {
        const int row0 = u.pm * BM + wr * 64 + fr, col0 = u.pn * BM + wc * 32 + 4 * fq;
#pragma unroll
        for (int ai = 0; ai < 2; ++ai)
#pragma unroll
            for (int m = 0; m < 4; ++m) { const size_t off = (size_t)(row0 + ai * HALF + m * 16) * ldc + col0;
#pragma unroll
                for (int bj = 0; bj < 2; ++bj)
#pragma unroll
                    for (int n = 0; n < 2; ++n) { const f32x4 bs = *(const f32x4*)(base + off + bj * HALF + n * 16); *(f32x4*)(out + off + bj * HALF + n * 16) = bs * alpha + acc[ai][bj][m][n] * s; } }
    }
};
struct EpiF32 {
    static constexpr bool PERM = false, AFTER_DRAIN = false;
    float* out; int ldc;
    __device__ __forceinline__ void operator()(const f32x4 (&acc)[2][2][4][2], const Unit& u, int wr, int wc, int fr, int fq) const {
        const int row0 = u.pm * BM + wr * 64 + fr, col0 = u.pn * BM + wc * 32 + 4 * fq;
#pragma unroll
        for (int ai = 0; ai < 2; ++ai)
#pragma unroll
            for (int m = 0; m < 4; ++m) { const size_t off = (size_t)(row0 + ai * HALF + m * 16) * ldc + col0;
#pragma unroll
                for (int bj = 0; bj < 2; ++bj)
#pragma unroll
                    for (int n = 0; n < 2; ++n) *(f32x4*)(out + off + bj * HALF + n * 16) = acc[ai][bj][m][n]; }
    }
};
struct EpiGate {
    static constexpr bool PERM = false, AFTER_DRAIN = false;
    const float* xin; const float* pp; float* out; int ldc;
    __device__ __forceinline__ void operator()(const f32x4 (&acc)[2][2][4][2], const Unit& u, int wr, int wc, int fr, int fq) const {
        const int row0 = u.pm * BM + wr * 64 + fr, col0 = u.pn * BM + wc * 32 + 4 * fq;
#pragma unroll
        for (int ai = 0; ai < 2; ++ai)
#pragma unroll
            for (int m = 0; m < 4; ++m) { const size_t off = (size_t)(row0 + ai * HALF + m * 16) * ldc + col0;
#pragma unroll
                for (int bj = 0; bj < 2; ++bj)
#pragma unroll
                    for (int n = 0; n < 2; ++n) { const f32x4 xv = *(const f32x4*)(xin + off + bj * HALF + n * 16), pv = *(const f32x4*)(pp + off + bj * HALF + n * 16), a = acc[ai][bj][m][n];
                        f32x4 o; o[0] = xv[0] + sigmoidf_(a[0]) * pv[0]; o[1] = xv[1] + sigmoidf_(a[1]) * pv[1]; o[2] = xv[2] + sigmoidf_(a[2]) * pv[2]; o[3] = xv[3] + sigmoidf_(a[3]) * pv[3];
                        *(f32x4*)(out + off + bj * HALF + n * 16) = o; } }
    }
};
struct EpiWin {
    static constexpr bool PERM = true, AFTER_DRAIN = false;
    bf16_t* qkvi;
    bf16_t* ki;
    float* wi;
    bf16_t* bc;
    bf16_t* z;
    int M; float idx_scale, qscale;
    __device__ __forceinline__ void operator()(const f32x4 (&acc)[2][2][4][2], const Unit& u, int wr, int wc, int fr, int fq) const {
        const int row0 = u.pm * BM + wr * 64 + fr, cw = wc * 32 + 8 * fq; const int pn = u.pn;
        if (pn >= 11) {
#pragma unroll
            for (int ai = 0; ai < 2; ++ai)
#pragma unroll
                for (int m = 0; m < 4; ++m) { bf16_t* rowp = z + (size_t)(row0 + ai * HALF + m * 16) * 512 + (pn - 11) * HALF + cw;
                    const f32x4 g0 = acc[ai][0][m][0], g1 = acc[ai][0][m][1], u0 = acc[ai][1][m][0], u1 = acc[ai][1][m][1];
                    u32x4 w; w.x = cvt_pk_bf16(g0[0] * u0[0], g0[1] * u0[1]); w.y = cvt_pk_bf16(g0[2] * u0[2], g0[3] * u0[3]); w.z = cvt_pk_bf16(g1[0] * u1[0], g1[1] * u1[1]); w.w = cvt_pk_bf16(g1[2] * u1[2], g1[3] * u1[3]);
                    *(u32x4*)rowp = w; }
        } else if (pn == 8) {
            if (wc < 2) {
#pragma unroll
                for (int ai = 0; ai < 2; ++ai)
#pragma unroll
                    for (int m = 0; m < 4; ++m) { const int rw = row0 + ai * HALF + m * 16; bf16_t* rowp = ki + (size_t)(rw >> 5) * 2048 + (cw >> 3) * 256 + (rw & 31) * 8;
                        const f32x4 v0 = acc[ai][0][m][0], v1 = acc[ai][0][m][1];
                        u32x4 w; w.x = cvt_pk_bf16(v0[0], v0[1]); w.y = cvt_pk_bf16(v0[2], v0[3]); w.z = cvt_pk_bf16(v1[0], v1[1]); w.w = cvt_pk_bf16(v1[2], v1[3]); *(u32x4*)rowp = w; }
            } else if (wc == 2 && fq == 0) {
#pragma unroll
                for (int ai = 0; ai < 2; ++ai)
#pragma unroll
                    for (int m = 0; m < 4; ++m) { float* rowp = wi + (size_t)(row0 + ai * HALF + m * 16) * 8; *(f32x4*)rowp = acc[ai][0][m][0] * idx_scale; *(f32x4*)(rowp + 4) = acc[ai][0][m][1] * idx_scale; }
            }
        } else {
            bf16_t* base; int colt; const float sc = (pn < 2) ? qscale : 1.0f;
            if (pn < 8) { base = qkvi + (size_t)(pn >> 1) * M * 512; colt = (pn & 1) * BM; } else { base = bc; colt = (pn - 9) * BM; }
#pragma unroll
            for (int ai = 0; ai < 2; ++ai)
#pragma unroll
                for (int m = 0; m < 4; ++m) { bf16_t* rowp = base + (size_t)(row0 + ai * HALF + m * 16) * 512 + colt + cw;
#pragma unroll
                    for (int bj = 0; bj < 2; ++bj) { const f32x4 v0 = acc[ai][bj][m][0] * sc, v1 = acc[ai][bj][m][1] * sc;
                        u32x4 w; w.x = cvt_pk_bf16(v0[0], v0[1]); w.y = cvt_pk_bf16(v0[2], v0[3]); w.z = cvt_pk_bf16(v1[0], v1[1]); w.w = cvt_pk_bf16(v1[2], v1[3]); *(u32x4*)(rowp + bj * HALF) = w; } }
        }
    }
};

template <class Epi, class Sched, bool ALIGN_EPI = false, bool SP2 = false>
__device__ __forceinline__ void gemm_phase(PG8_LAS unsigned char* lds, const Gemm g, const Sched& S, const Epi& E) {
    int tid_ = threadIdx.x; asm volatile("" : "+v"(tid_));
    const int tid = tid_, wid = __builtin_amdgcn_readfirstlane(tid >> 6), lane = tid & 63, wr = wid >> 2, wc = wid & 3, fr = lane & 15, fq = lane >> 4;
    const int K = g.K, nt = K / BK;
    unsigned voffA[2], voffB[2];
#pragma unroll
    for (int i = 0; i < 2; ++i) { int R, C; stage_rc(tid * 16 + i * 8192, R, C); const int Rb = Epi::PERM ? ((R & ~31) + perm32(R & 31)) : R;
        voffA[i] = (unsigned)(R * K + C) * 2u; voffB[i] = (unsigned)(Rb * K + C) * 2u; }
    const size_t kstep = (size_t)(BK * 2);
    const size_t hstep = (size_t)HALF * K * 2;
    const size_t tstep = 2 * hstep;
    const unsigned ldsw = (unsigned)wid * 1024u;
    const int aoff = lds_byte(wr * 64 + fr, fq * 8), boff = lds_byte(wc * 32 + fr, fq * 8);
#define PG8_SA(b, h) (((b) * 2 + (h)) * HTB)
#define PG8_SB(b, h) ((4 + (b) * 2 + (h)) * HTB)
#define PG8_STAGE(bufoff, gbase, voff) do { _Pragma("unroll") for (int _i = 0; _i < 2; ++_i) \
        __builtin_amdgcn_global_load_lds((const unsigned*)((const char*)(gbase) + (voff)[_i]), (PG8_LAS unsigned*)(lds + (bufoff) + ldsw + _i * 8192), 16, 0, 0); } while (0)
#define PG8_LDA(dst, b, h) do { _Pragma("unroll") for (int m = 0; m < 4; ++m) _Pragma("unroll") for (int k = 0; k < 2; ++k) dst[m][k] = *(const PG8_LAS bf16x8*)(lds + PG8_SA(b, h) + aoff + m * 2048 + k * 1024); } while (0)
#define PG8_LDB(dst, b, h) do { _Pragma("unroll") for (int n = 0; n < 2; ++n) _Pragma("unroll") for (int k = 0; k < 2; ++k) dst[n][k] = *(const PG8_LAS bf16x8*)(lds + PG8_SB(b, h) + boff + n * 2048 + k * 1024); } while (0)
#define PG8_MMA(ai, bj, At, Bt) do { __builtin_amdgcn_s_setprio(1); _Pragma("unroll") for (int m = 0; m < 4; ++m) _Pragma("unroll") for (int n = 0; n < 2; ++n) _Pragma("unroll") for (int k = 0; k < 2; ++k) \
        acc[ai][bj][m][n] = __builtin_amdgcn_mfma_f32_16x16x32_bf16(Bt[n][k], At[m][k], acc[ai][bj][m][n], 0, 0, 0); __builtin_amdgcn_s_setprio(0); } while (0)
#define PG8_WAIT_V(n) asm volatile("s_waitcnt vmcnt(" #n ")" ::: "memory")
#define PG8_WAIT_L(n) asm volatile("s_waitcnt lgkmcnt(" #n ")" ::: "memory")
#define PG8_BAR __builtin_amdgcn_s_barrier()
#define PG8_SCHED __builtin_amdgcn_sched_barrier(0)
    Unit cur, nxt; int ui = 0;
    if (!S.next(0, cur)) return;
    f32x4 acc[2][2][4][2];
#pragma unroll
    for (int a = 0; a < 2; ++a)
#pragma unroll
        for (int b = 0; b < 2; ++b)
#pragma unroll
            for (int m = 0; m < 4; ++m)
#pragma unroll
                for (int n = 0; n < 2; ++n) acc[a][b][m][n] = (f32x4){0.f, 0.f, 0.f, 0.f};
    bf16x8 At[4][2], B0[2][2], B1[2][2];
    const char* cA = (const char*)g.A + (size_t)cur.pm * tstep; const char* cB = (const char*)g.Bt + (size_t)cur.pn * tstep;
    S.a_ready(cur);
    if constexpr (SP2) {
        PG8_STAGE(PG8_SB(0, 0), cB, voffB); PG8_STAGE(PG8_SB(0, 1), cB + hstep, voffB); PG8_STAGE(PG8_SA(0, 0), cA, voffA); PG8_STAGE(PG8_SA(0, 1), cA + hstep, voffA);
        if (wr == 1) PG8_BAR;
        PG8_WAIT_V(2); PG8_BAR;
        PG8_STAGE(PG8_SB(1, 0), cB + kstep, voffB); PG8_STAGE(PG8_SA(1, 0), cA + kstep, voffA); PG8_STAGE(PG8_SB(1, 1), cB + hstep + kstep, voffB);
        PG8_WAIT_V(6); PG8_BAR;
    } else {
        PG8_STAGE(PG8_SB(0, 0), cB, voffB); PG8_STAGE(PG8_SA(0, 0), cA, voffA); PG8_STAGE(PG8_SB(0, 1), cB + hstep, voffB); PG8_STAGE(PG8_SA(0, 1), cA + hstep, voffA);
        if (wr == 1) PG8_BAR;
        PG8_WAIT_V(4); PG8_BAR;
        PG8_STAGE(PG8_SB(1, 0), cB + kstep, voffB); PG8_STAGE(PG8_SA(1, 0), cA + kstep, voffA); PG8_STAGE(PG8_SB(1, 1), cB + hstep + kstep, voffB);
        PG8_WAIT_V(6); PG8_BAR;
    }
    for (;;) {
        const bool has_next = S.next(ui + 1, nxt);
        const char* nA = has_next ? (const char*)g.A + (size_t)nxt.pm * tstep : cA; const char* nB = has_next ? (const char*)g.Bt + (size_t)nxt.pn * tstep : cB;
        for (int t = 0; t < nt; t += 2) {
            const bool last = (t == nt - 2);
            const char* a1 = cA + (size_t)(t + 1) * kstep;
            const char* a2 = last ? nA : cA + (size_t)(t + 2) * kstep; const char* b2 = last ? nB : cB + (size_t)(t + 2) * kstep;
            const char* a3 = a2 + kstep; const char* b3 = b2 + kstep;
            if (last && has_next) S.a_ready(nxt);
            if constexpr (SP2) {
            PG8_LDB(B0, 0, 0); PG8_LDB(B1, 0, 1); PG8_SCHED; PG8_LDA(At, 0, 0); PG8_STAGE(PG8_SA(1, 1), a1 + hstep, voffA);
            PG8_WAIT_V(8); PG8_WAIT_L(0); PG8_BAR; PG8_MMA(0, 0, At, B0); PG8_MMA(0, 1, At, B1); PG8_BAR; PG8_SCHED;
            PG8_LDA(At, 0, 1); PG8_STAGE(PG8_SB(0, 0), b2, voffB); PG8_STAGE(PG8_SB(0, 1), b2 + hstep, voffB); PG8_STAGE(PG8_SA(0, 0), a2, voffA);
            PG8_WAIT_V(8); PG8_WAIT_L(0); PG8_BAR; PG8_MMA(1, 0, At, B0); PG8_MMA(1, 1, At, B1); PG8_BAR; PG8_SCHED;
            PG8_LDB(B0, 1, 0); PG8_LDB(B1, 1, 1); PG8_SCHED; PG8_LDA(At, 1, 0); PG8_STAGE(PG8_SA(0, 1), a2 + hstep, voffA);
            PG8_WAIT_V(8); PG8_WAIT_L(0); PG8_BAR; PG8_MMA(0, 0, At, B0); PG8_MMA(0, 1, At, B1); PG8_BAR; PG8_SCHED;
            PG8_LDA(At, 1, 1); PG8_STAGE(PG8_SB(1, 0), b3, voffB); PG8_STAGE(PG8_SB(1, 1), b3 + hstep, voffB); PG8_STAGE(PG8_SA(1, 0), a3, voffA);
            PG8_WAIT_V(8); PG8_WAIT_L(0); PG8_BAR; PG8_MMA(1, 0, At, B0); PG8_MMA(1, 1, At, B1); PG8_BAR; PG8_SCHED;
            } else {
            PG8_LDB(B0, 0, 0); PG8_SCHED; PG8_LDA(At, 0, 0); PG8_STAGE(PG8_SA(1, 1), a1 + hstep, voffA);
            PG8_WAIT_L(8); PG8_BAR; PG8_WAIT_L(0); PG8_MMA(0, 0, At, B0); PG8_BAR; PG8_SCHED;
            PG8_LDB(B1, 0, 1); PG8_STAGE(PG8_SB(0, 0), b2, voffB);
            PG8_BAR; PG8_WAIT_L(0); PG8_MMA(0, 1, At, B1); PG8_BAR;
            PG8_LDA(At, 0, 1); PG8_STAGE(PG8_SA(0, 0), a2, voffA);
            PG8_BAR; PG8_WAIT_L(0); PG8_MMA(1, 0, At, B0); PG8_BAR; PG8_SCHED;
            PG8_STAGE(PG8_SB(0, 1), b2 + hstep, voffB);
            PG8_WAIT_V(6); PG8_BAR; PG8_MMA(1, 1, At, B1); PG8_BAR;
            PG8_LDB(B0, 1, 0); PG8_SCHED; PG8_LDA(At, 1, 0); PG8_STAGE(PG8_SA(0, 1), a2 + hstep, voffA);
            PG8_WAIT_L(8); PG8_BAR; PG8_WAIT_L(0); PG8_MMA(0, 0, At, B0); PG8_BAR; PG8_SCHED;
            PG8_LDB(B1, 1, 1); PG8_STAGE(PG8_SB(1, 0), b3, voffB);
            PG8_BAR; PG8_WAIT_L(0); PG8_MMA(0, 1, At, B1); PG8_BAR;
            PG8_LDA(At, 1, 1); PG8_STAGE(PG8_SA(1, 0), a3, voffA);
            PG8_BAR; PG8_WAIT_L(0); PG8_MMA(1, 0, At, B0); PG8_BAR; PG8_SCHED;
            PG8_STAGE(PG8_SB(1, 1), b3 + hstep, voffB);
            PG8_WAIT_V(6); PG8_BAR; PG8_MMA(1, 1, At, B1); PG8_BAR;
            }
        }
        if constexpr (ALIGN_EPI) { if (wr == 0) PG8_BAR; }
        if constexpr (!Epi::AFTER_DRAIN) { E(acc, cur, wr, wc, fr, fq); S.done(cur); }
        if (!has_next) break;
#pragma unroll
        for (int a = 0; a < 2; ++a)
#pragma unroll
            for (int b = 0; b < 2; ++b)
#pragma unroll
                for (int m = 0; m < 4; ++m)
#pragma unroll
                    for (int n = 0; n < 2; ++n) acc[a][b][m][n] = (f32x4){0.f, 0.f, 0.f, 0.f};
        cur = nxt; cA = nA; cB = nB; ++ui;
        if constexpr (ALIGN_EPI) { if (wr == 1) PG8_BAR; }
    }
    PG8_WAIT_V(0);
    if constexpr (!ALIGN_EPI) { if (wr == 0) PG8_BAR; }
    PG8_BAR;
    if constexpr (Epi::AFTER_DRAIN) { E.fused(acc, cur, wr, wc, fr, fq, lds, wid, lane); S.done(cur); }
#undef PG8_SA
#undef PG8_SB
#undef PG8_STAGE
#undef PG8_LDA
#undef PG8_LDB
#undef PG8_MMA
#undef PG8_WAIT_V
#undef PG8_WAIT_L
#undef PG8_BAR
#undef PG8_SCHED
}
}

#ifndef PROBE_CHECK
#define PROBE_CHECK 0
#endif
#define REP_P5 1
#define REP_SCORE 1
#define REP_SELECT 1
#define SPARSE_ATTN 0
#define REP_P6 1

constexpr int NWAVES = 8;
constexpr int BATCH = 4, SEQ = 8192, D = 1024, FF = 2816, DPLE = 256, NHEAD = 8, HD = 64, DA = 512, DC = 512;
constexpr int M = BATCH * SEQ;
constexpr int NGU = 2 * FF;
constexpr int NIN = 3840;
constexpr float LN_EPS = 1e-5f;
constexpr float DN_ALPHA = 1.189207115002721f;
constexpr float IDX_SCALE = 0.04419417382415922f;
constexpr int TOPK = 256;
constexpr float LOG2E = 1.4426950408889634f;

constexpr size_t MiB = 1u << 20;
constexpr size_t WS_CTL = 0, CTL_ZERO_BYTES = 1 * MiB;
constexpr size_t WS_WGU1 = 2 * MiB, WS_WD1 = 13 * MiB, WS_WIN = 19 * MiB, WS_WOUT = 27 * MiB, WS_WGU2 = 29 * MiB, WS_WD2 = 40 * MiB, WS_WGATE = 46 * MiB, WS_WP = 48 * MiB;
constexpr size_t WS_XB = 64 * MiB;
constexpr size_t WS_R = 128 * MiB;
constexpr size_t WS_BIG = 256 * MiB;
constexpr size_t WS_QKVI = WS_BIG, WS_KI = WS_BIG + 128 * MiB, WS_WI = WS_BIG + 132 * MiB, WS_BC = WS_BIG + 136 * MiB, WS_Z = WS_BIG + 168 * MiB, WS_SEL = WS_BIG + 200 * MiB;
constexpr size_t WS_PB = 496 * MiB;
constexpr size_t WS_END = 512 * MiB;
static_assert(WS_WGU1 + (size_t)NGU * D * 2 <= WS_WD1 && WS_WD1 + (size_t)D * FF * 2 <= WS_WIN && WS_WIN + (size_t)NIN * D * 2 <= WS_WOUT && WS_WOUT + (size_t)D * D * 2 <= WS_WGU2 && WS_WGU2 + (size_t)NGU * D * 2 <= WS_WD2 &&
              WS_WD2 + (size_t)D * FF * 2 <= WS_WGATE && WS_WGATE + (size_t)D * D * 2 <= WS_WP && WS_WP + (size_t)D * DPLE * 2 <= WS_XB, "weight map");
static_assert(WS_XB + (size_t)M * D * 2 <= WS_R && WS_R + (size_t)M * D * 4 <= WS_BIG && WS_BIG + (size_t)M * FF * 2 <= WS_PB && WS_SEL + (size_t)BATCH * 128 * SEQ * 8 <= WS_PB && WS_PB + (size_t)M * DPLE * 2 <= WS_END, "d_ws map");
constexpr int CW_BAR = 4096;

constexpr int RING_OFF = 0, RING_BYTES = 131072;
constexpr int SROW_U16 = 64 * 132;
constexpr int SC_BYTES = 8 * SROW_U16 * 2;
constexpr int LDSCTL_OFF = 139264, MISC_OFF = LDSCTL_OFF + 320;
constexpr int LDS_BYTES = 147456;
static_assert(SC_BYTES <= LDSCTL_OFF && RING_BYTES <= LDSCTL_OFF && MISC_OFF + 128 <= LDS_BYTES, "LDS map");

#define GAS __attribute__((address_space(1)))
#define LAS __attribute__((address_space(3)))
typedef unsigned short bf16;
typedef unsigned v4u __attribute__((ext_vector_type(4)));
typedef unsigned v2u __attribute__((ext_vector_type(2)));
typedef float f32x4 __attribute__((ext_vector_type(4)));
typedef float f32x16 __attribute__((ext_vector_type(16)));
typedef short bf16x8 __attribute__((ext_vector_type(8)));
typedef unsigned short u16x2 __attribute__((ext_vector_type(2)));
typedef GAS unsigned gu32;
#define RLX_AGENT __ATOMIC_RELAXED, __HIP_MEMORY_SCOPE_AGENT
#define LDS_WAIT() asm volatile("s_waitcnt lgkmcnt(0)" ::: "memory")
#define VM_WAIT() asm volatile("s_waitcnt vmcnt(0)" ::: "memory")
__device__ __forceinline__ unsigned f2bf(float f) { unsigned u = __builtin_bit_cast(unsigned, f); return (u + 0x7fffu + ((u >> 16) & 1u)) >> 16; }
__device__ __forceinline__ unsigned pk2(float lo, float hi) { return f2bf(lo) | (f2bf(hi) << 16); }
__device__ __forceinline__ float bf_lo(unsigned w) { return __builtin_bit_cast(float, w << 16); }
__device__ __forceinline__ float bf_hi(unsigned w) { return __builtin_bit_cast(float, w & 0xffff0000u); }
namespace attn_body {
using bf16=__hip_bfloat16;
using bf16x8=__attribute__((ext_vector_type(8)))short;
using s16x4=__attribute__((ext_vector_type(4)))short;
using f32x16=__attribute__((ext_vector_type(16)))float;
using u32x4=__attribute__((ext_vector_type(4)))unsigned;
constexpr int BATCH=4,NHEAD=8,SEQ=8192,D=64,DM=NHEAD*D,OPITCH=1024;
constexpr int NW=8,QBLK=32,QB=QBLK*NW,KVBLK=64,NQB=SEQ/QB;
constexpr int ATTN_PITCH=DM, ATTN_UNIT_ROWS=QB;
__device__ __forceinline__ int crow(int r,int hi){return (r&3)+8*(r>>2)+4*hi;}
#define SBAR() __builtin_amdgcn_sched_barrier(0)
constexpr int NSLOT=3, SLOTB=8192;
constexpr int LDS_K=0, LDS_V=NSLOT*SLOTB, LDS_WS=2*NSLOT*SLOTB, LDS_OST=LDS_WS+NW*64*4, LDS_MSK=LDS_OST+NW*4096, LDS_BYTES=LDS_MSK+NW*1024;
constexpr float C2=0.125f*1.4426950408889634f;
__device__ __forceinline__ void glds16(const void*gsrc,unsigned lds_dst){unsigned keep;
  asm volatile("s_mov_b32 %0, m0\n\ts_mov_b32 m0, %2\n\ts_nop 0\n\tglobal_load_lds_dwordx4 %1, off\n\ts_mov_b32 m0, %0":"=&s"(keep):"v"(gsrc),"s"(lds_dst):"memory");}
__device__ __forceinline__ float max3f(float a,float b,float c){float r;asm("v_max3_f32 %0, %1, %2, %3":"=v"(r):"v"(a),"v"(b),"v"(c));return r;}
__device__ __forceinline__ float max2f(float a,float b){float r;asm("v_max_f32_e32 %0, %1, %2":"=v"(r):"v"(a),"v"(b));return r;}
__device__ __forceinline__ float fadd_s(float a,float b){float r;asm("v_add_f32_e32 %0, %1, %2":"=v"(r):"v"(a),"v"(b));return r;}
__device__ __forceinline__ float fsub_s(float a,float b){float r;asm("v_sub_f32_e32 %0, %1, %2":"=v"(r):"v"(a),"v"(b));return r;}
typedef float f32x2_t __attribute__((ext_vector_type(2))); typedef unsigned v2u_t __attribute__((ext_vector_type(2))); typedef __bf16 bf16x2_t __attribute__((ext_vector_type(2)));
__device__ __forceinline__ unsigned cvtpk_s(float lo,float hi){f32x2_t v={lo,hi};bf16x2_t b=__builtin_convertvector(v,bf16x2_t);return __builtin_bit_cast(unsigned,b);}
__device__ __forceinline__ void glds4(const void*gsrc,unsigned lds_dst){unsigned keep;
  asm volatile("s_mov_b32 %0, m0\n\ts_mov_b32 m0, %2\n\ts_nop 0\n\tglobal_load_lds_dword %1, off\n\ts_mov_b32 m0, %0":"=&s"(keep):"v"(gsrc),"s"(lds_dst):"memory");}
#define WAIT_BAR(N) asm volatile("s_waitcnt vmcnt(" #N ") lgkmcnt(0)\n\ts_barrier":::"memory")

__device__ __forceinline__ void qkt(f32x16&p0,f32x16&p1,const char*Kslot,const bf16x8*qr,int r32,int hi){
  const char*kb=Kslot+hi*1024+r32*16;
  #pragma unroll
  for(int d0=0;d0<4;++d0){
    const bf16x8 b0=*reinterpret_cast<const bf16x8*>(kb+d0*2048);
    const bf16x8 b1=*reinterpret_cast<const bf16x8*>(kb+d0*2048+512);
    p0=__builtin_amdgcn_mfma_f32_32x32x16_bf16(b0,qr[d0],p0,0,0,0);p1=__builtin_amdgcn_mfma_f32_32x32x16_bf16(b1,qr[d0],p1,0,0,0);}
}
typedef __attribute__((address_space(3))) const char* lds_cptr;
typedef short v4i16_t __attribute__((ext_vector_type(4)));
__device__ __forceinline__ void kload8(bf16x8*kf,lds_cptr kp){
  kf[0]=*(const __attribute__((address_space(3))) bf16x8*)(kp);      kf[1]=*(const __attribute__((address_space(3))) bf16x8*)(kp+512);
  kf[2]=*(const __attribute__((address_space(3))) bf16x8*)(kp+2048); kf[3]=*(const __attribute__((address_space(3))) bf16x8*)(kp+2560);
  kf[4]=*(const __attribute__((address_space(3))) bf16x8*)(kp+4096); kf[5]=*(const __attribute__((address_space(3))) bf16x8*)(kp+4608);
  kf[6]=*(const __attribute__((address_space(3))) bf16x8*)(kp+6144); kf[7]=*(const __attribute__((address_space(3))) bf16x8*)(kp+6656);
}
__device__ __forceinline__ void kload2(bf16x8*kf,lds_cptr kp,int j){ kf[2*j]=*(const __attribute__((address_space(3))) bf16x8*)(kp+j*2048); kf[2*j+1]=*(const __attribute__((address_space(3))) bf16x8*)(kp+j*2048+512); }
__device__ __forceinline__ s16x4 vtr(lds_cptr p){ return __builtin_bit_cast(s16x4,__builtin_amdgcn_ds_read_tr16_b64_v4i16((__attribute__((address_space(3))) v4i16_t*)p)); }
__device__ __forceinline__ float rowmax(const f32x16&p0,const f32x16&p1){
  float a=max3f(p0[0],p0[1],p1[0]),b=max3f(p0[2],p0[3],p1[1]);a=max3f(a,p1[2],p1[3]);
  #pragma unroll
  for(int r=4;r<16;r+=4){a=max3f(a,p0[r],p0[r+1]);b=max3f(b,p0[r+2],p0[r+3]);a=max3f(a,p1[r],p1[r+1]);b=max3f(b,p1[r+2],p1[r+3]);}
  const float m=max2f(a,b);
  auto rr=__builtin_amdgcn_permlane32_swap(__float_as_uint(m),__float_as_uint(m),false,false);
  return max2f(__uint_as_float(rr[0]),__uint_as_float(rr[1]));
}
__device__ __forceinline__ void pv(f32x16*o,int vb,bf16x8 pa0,bf16x8 pa1,bf16x8 pa2,bf16x8 pa3){
  #pragma unroll
  for(int d0=0;d0<2;++d0){s16x4 lo[4],hi[4];
    #pragma unroll
    for(int ks=0;ks<4;++ks){
      asm volatile("ds_read_b64_tr_b16 %0,%1 offset:%c2":"=&v"(lo[ks]):"v"(vb),"i"(d0*4096+ks*1024):"memory");
      asm volatile("ds_read_b64_tr_b16 %0,%1 offset:%c2":"=&v"(hi[ks]):"v"(vb),"i"(d0*4096+ks*1024+512):"memory");}
    asm volatile("s_waitcnt lgkmcnt(0)":::"memory");SBAR();
    #define PK(k) (bf16x8){lo[k][0],lo[k][1],lo[k][2],lo[k][3],hi[k][0],hi[k][1],hi[k][2],hi[k][3]}
    o[d0]=__builtin_amdgcn_mfma_f32_32x32x16_bf16(pa0,PK(0),o[d0],0,0,0);
    o[d0]=__builtin_amdgcn_mfma_f32_32x32x16_bf16(pa1,PK(1),o[d0],0,0,0);
    o[d0]=__builtin_amdgcn_mfma_f32_32x32x16_bf16(pa2,PK(2),o[d0],0,0,0);
    o[d0]=__builtin_amdgcn_mfma_f32_32x32x16_bf16(pa3,PK(3),o[d0],0,0,0);
    #undef PK
  }
}

#ifndef ATTN_STORE16
#define ATTN_STORE16(p,v) (*(u32x4*)(p)=(v))
#endif
__device__ __forceinline__ float selv_(unsigned w,int c,float v,float ninf){ const int m=__builtin_amdgcn_sbfe((int)w,c,1); float r; asm("v_bfi_b32 %0, %1, %2, %3":"=v"(r):"v"(m),"v"(v),"v"(ninf)); return r; }
template<int THRL> __device__ __forceinline__ void attn_unit(int b,int h,int qb,const bf16*Q,const bf16*__restrict__ K,const bf16*__restrict__ V,const unsigned long long*__restrict__ SEL,bf16*O,char*shm){
  int tid_=threadIdx.x; asm volatile("":"+v"(tid_));
  const int tid=tid_,lane=tid&63,r32=lane&31,hi=lane>>5; const int wid=__builtin_amdgcn_readfirstlane(tid>>6);
  const long rowbase=(long)b*SEQ; const int q0=qb*QB;
  const bf16*Qw=Q+(rowbase+q0+wid*QBLK)*DM+h*D;
  const bf16*Kh=K+rowbase*DM+h*D,*Vh=V+rowbase*DM+h*D;
  const unsigned lds0=(unsigned)(uintptr_t)shm;
  float*wsf=(float*)(shm+LDS_WS)+wid*64;
  const bf16*ksrc=Kh+(long)lane*DM+wid*8;
  const bf16*vsrc=Vh+(long)(16*(wid&3)+(lane>>2))*DM+(wid>>2)*32+(lane&3)*8;
  const unsigned*msrc=(const unsigned*)(SEL+(size_t)b*128*SEQ+q0+wid*QBLK)+lane;
  const unsigned kdst=lds0+LDS_K+wid*1024, vdst=lds0+LDS_V+wid*1024, mdst=lds0+LDS_MSK+wid*1024;
  const int NT=(q0+QB)/KVBLK;
  #define TI(t) (NT-1-(t))
  #define DMA_K(t,slot) glds16(ksrc+(long)TI(t)*KVBLK*DM,(unsigned)__builtin_amdgcn_readfirstlane(kdst+(slot)))
  #define DMA_V(t,slot) glds16(vsrc+(long)TI(t)*KVBLK*DM,(unsigned)__builtin_amdgcn_readfirstlane(vdst+(slot)))
  #define DMA_M(t) glds4(msrc+(size_t)TI(t)*(SEQ*2),(unsigned)__builtin_amdgcn_readfirstlane(mdst+(((t)&3)<<8)))
  const int vb0=(int)(lds0+LDS_V)+((lane>>4)&1)*32+(lane&3)*8+(4*hi+((lane&15)>>2))*64;
  const char*Kbase=shm+LDS_K; bf16x8 kf[8];
  const lds_cptr shm3=(lds_cptr)shm; const lds_cptr kp0=shm3+LDS_K+hi*1024+r32*16; const lds_cptr vp0=shm3+LDS_V+((lane>>4)&1)*32+(lane&3)*8+(4*hi+((lane&15)>>2))*64;
  const lds_cptr mp0=shm3+LDS_MSK+wid*1024+r32*8;
  DMA_M(0);DMA_M(1);DMA_M(2);
  DMA_K(0,0);DMA_V(0,0);DMA_K(1,SLOTB);
  bf16x8 qr[4];
  #pragma unroll
  for(int d0=0;d0<4;++d0)qr[d0]=*reinterpret_cast<const bf16x8*>(&Qw[(long)r32*DM+d0*16+hi*8]);
  float mhat=0.f,l_reg=0.f;f32x16 o[2];o[0]=f32x16{};o[1]=f32x16{};
  bool started=false;
  const float slope2=__builtin_amdgcn_exp2f(-(float)(h+1))*1.4426950408889634f, m2s=-2.f*slope2;
  const int tq=q0+wid*QBLK+r32, sref=q0+QB-1;
  bool resc=false;
  #define CR(r) (((r)&3)+8*((r)>>2))
  #define BR(r) (16*((r)&1)+(((r)>>1)&1)+4*((r)>>2))
  #define SELV(w,c,v) selv_((w),(c),(v),ninf_)
  const float ninf_=-INFINITY;
  float nb=0.f,dq=0.f;unsigned wl=0u,wh=0u;
  #define FPREP(tn) do{ const int ti_=TI(tn); const v2u_t mw_=*(const __attribute__((address_space(3))) v2u_t*)(mp0+(((tn)&3)<<8)); wl=mw_.x>>(2*hi); wh=mw_.y>>(2*hi); \
      nb=slope2*(float)(64*ti_+4*hi-sref)-mhat; dq=(float)(64*ti_+4*hi-tq); }while(0)
  #define FILL4(X,B,w,co,BN) do{ _Pragma("unroll") for(int r_=(B);r_<(B)+4;++r_){ float v_=__builtin_fmaf(slope2,(float)(CR(r_)+(co)),nb); \
      if(BN){ v_=__builtin_fmaf(__builtin_fmaxf(dq+(float)(CR(r_)+(co)),0.f),m2s,v_); } X[r_]=SELV(w,BR(r_),v_); } PIN(X); }while(0)
  #define PIN(x) asm volatile("":"+v"(x))
  #define MX3(a,b,c) __builtin_fmaxf(__builtin_fmaxf((a),(b)),(c))
  #define DECIDE(C0,C1) do{ float a=MX3(C0[0],C0[1],C1[0]),b_=MX3(C0[2],C0[3],C1[1]); a=MX3(a,C1[2],C1[3]); \
      _Pragma("unroll") for(int r=4;r<16;r+=4){a=MX3(a,C0[r],C0[r+1]);b_=MX3(b_,C0[r+2],C0[r+3]);a=MX3(a,C1[r],C1[r+1]);b_=MX3(b_,C1[r+2],C1[r+3]);} \
      float rm=__builtin_fmaxf(a,b_); { auto rr=__builtin_amdgcn_permlane32_swap(__float_as_uint(rm),__float_as_uint(rm),false,false); rm=__builtin_fmaxf(__uint_as_float(rr[0]),__uint_as_float(rr[1])); } \
      resc=false; const bool live_=rm>-INFINITY, fresh_=live_&&!started; \
      if(__builtin_expect(__any(fresh_||rm>(float)THRL),0)){ const float dl=fresh_?rm:__builtin_fmaxf(rm,0.f); mhat+=dl; \
        _Pragma("unroll") for(int r=0;r<16;++r){C0[r]-=dl;C1[r]-=dl;} \
        const float f=started?__builtin_amdgcn_exp2f(-dl):1.0f; l_reg*=f; if(hi==0)wsf[r32]=f; resc=true; } \
      started=started||live_; }while(0)
  #define RESC() do{ if(resc){ asm volatile("s_waitcnt lgkmcnt(0)":::"memory"); \
      _Pragma("unroll") for(int d_=0;d_<2;++d_) _Pragma("unroll") for(int r=0;r<16;++r)o[d_][r]*=wsf[crow(r,hi)]; } }while(0)
  f32x16 pA0,pA1,pB0,pB1;
  int sl_prev=0,sl_cur=0,sl_next=SLOTB;
  #define ROT() do{sl_prev=sl_cur;sl_cur=sl_next;sl_next=(sl_next==(NSLOT-1)*SLOTB)?0:sl_next+SLOTB;}while(0)
  DMA_K(2,2*SLOTB);
  WAIT_BAR(3);
  FPREP(0);
  FILL4(pA0,0,wl,0,true);FILL4(pA0,4,wl,0,true);FILL4(pA0,8,wl,0,true);FILL4(pA0,12,wl,0,true);
  FILL4(pA1,0,wh,32,true);FILL4(pA1,4,wh,32,true);FILL4(pA1,8,wh,32,true);FILL4(pA1,12,wh,32,true);
  qkt(pA0,pA1,Kbase,qr,r32,hi);asm volatile("s_nop 15\n\ts_nop 7":"+v"(pA0),"+v"(pA1));
  DECIDE(pA0,pA1);
  _Pragma("unroll") for(int r=0;r<16;++r){pA0[r]=__builtin_amdgcn_exp2f(pA0[r]);pA1[r]=__builtin_amdgcn_exp2f(pA1[r]);}
  WAIT_BAR(0);
  DMA_K(3,0);DMA_M(3);DMA_V(1,SLOTB);
  ROT();
  kload8(kf,kp0+sl_cur);
  RESC();
  FPREP(1);
  FILL4(pB0,0,wl,0,true);FILL4(pB0,4,wl,0,true);FILL4(pB0,8,wl,0,true);FILL4(pB0,12,wl,0,true);
  FILL4(pB1,0,wh,32,true);FILL4(pB1,4,wh,32,true);FILL4(pB1,8,wh,32,true);FILL4(pB1,12,wh,32,true);
  WAIT_BAR(3);
  s16x4 vlo[8],vhi[8]; u32x4 pw0,pw1,pw2,pw3;
  #define PKW(P,B) cvtpk_s(P[B],P[B+1])
  #define PAF(k) __builtin_bit_cast(bf16x8,pw##k)
  #define VFR(i) (bf16x8){vlo[i][0],vlo[i][1],vlo[i][2],vlo[i][3],vhi[i][0],vhi[i][1],vhi[i][2],vhi[i][3]}
  #define GAPA(MF,A0,A1,A2,A3,W0,W1,PW) do{ MF; sacc+=A0; sacc+=A1; sacc+=A2; sacc+=A3; PIN(sacc); W0; W1; PIN(PW); SBAR(); }while(0)
  #define EX(v) __builtin_amdgcn_exp2f(v)
  #define GAPB(MF,X,B,GF,Y,w,co,BN) do{ MF; X[B]=EX(X[B]); X[B+1]=EX(X[B+1]); X[B+2]=EX(X[B+2]); X[B+3]=EX(X[B+3]); PIN(X); if(GF){ FILL4(Y,B,w,co,BN); } SBAR(); }while(0)
  #define VRD(i) do{ vlo[i]=vtr(vp_+(((i)>>2)*4096+((i)&3)*1024)); vhi[i]=vtr(vp_+(((i)>>2)*4096+((i)&3)*1024+512)); }while(0)
  #define KRD(G,j) do{ if(G){ kload2(kf,kp0+sl_next,j); SBAR(); } }while(0)
  #define STEP(C0,C1,P0,P1,t,GK,GV,GL,GF,BN) do{ SBAR(); \
    const lds_cptr vp_=vp0+sl_prev; \
    VRD(0); SBAR(); float sacc=(P0[0]+P0[1]); \
    GAPA(C0=__builtin_amdgcn_mfma_f32_32x32x16_bf16(kf[0],qr[0],C0,0,0,0), P0[2],P0[3],P0[4],P0[5],     pw0[0]=PKW(P0,0), pw0[1]=PKW(P0,2), pw0); \
    VRD(4); SBAR(); GAPA(C1=__builtin_amdgcn_mfma_f32_32x32x16_bf16(kf[1],qr[0],C1,0,0,0), P0[6],P0[7],P0[8],P0[9],     pw0[2]=PKW(P0,4), pw0[3]=PKW(P0,6), pw0); \
    VRD(1); SBAR(); GAPA(C0=__builtin_amdgcn_mfma_f32_32x32x16_bf16(kf[2],qr[1],C0,0,0,0),   P0[10],P0[11],P0[12],P0[13], pw1[0]=PKW(P0,8), pw1[1]=PKW(P0,10), pw1); \
    VRD(5); SBAR(); GAPA(C1=__builtin_amdgcn_mfma_f32_32x32x16_bf16(kf[3],qr[1],C1,0,0,0),   P0[14],P0[15],P1[0],P1[1],   pw1[2]=PKW(P0,12),pw1[3]=PKW(P0,14), pw1); \
    VRD(2); SBAR(); GAPA(C0=__builtin_amdgcn_mfma_f32_32x32x16_bf16(kf[4],qr[2],C0,0,0,0),   P1[2],P1[3],P1[4],P1[5],     pw2[0]=PKW(P1,0), pw2[1]=PKW(P1,2), pw2); \
    VRD(6); SBAR(); GAPA(C1=__builtin_amdgcn_mfma_f32_32x32x16_bf16(kf[5],qr[2],C1,0,0,0),   P1[6],P1[7],P1[8],P1[9],     pw2[2]=PKW(P1,4), pw2[3]=PKW(P1,6), pw2); \
    VRD(3); SBAR(); GAPA(C0=__builtin_amdgcn_mfma_f32_32x32x16_bf16(kf[6],qr[3],C0,0,0,0),   P1[10],P1[11],P1[12],P1[13], pw3[0]=PKW(P1,8), pw3[1]=PKW(P1,10), pw3); \
    VRD(7); SBAR(); GAPA(C1=__builtin_amdgcn_mfma_f32_32x32x16_bf16(kf[7],qr[3],C1,0,0,0),   P1[14],P1[15],0.f,0.f,       pw3[2]=PKW(P1,12),pw3[3]=PKW(P1,14), pw3); \
    l_reg+=sacc; \
    if(GK){DMA_K((t)+3,sl_cur);DMA_M((t)+3);} if(GV){DMA_V((t)+1,sl_next);} \
    DECIDE(C0,C1); \
    if(GF){ FPREP((t)+1); } \
    SBAR(); \
    GAPB(o[0]=__builtin_amdgcn_mfma_f32_32x32x16_bf16(PAF(0),VFR(0),o[0],0,0,0), C0,0, GF,P0,wl,0,BN); \
    GAPB(o[1]=__builtin_amdgcn_mfma_f32_32x32x16_bf16(PAF(0),VFR(4),o[1],0,0,0), C0,4, GF,P0,wl,0,BN); \
    KRD(GL,0); GAPB(o[0]=__builtin_amdgcn_mfma_f32_32x32x16_bf16(PAF(1),VFR(1),o[0],0,0,0), C0,8, GF,P0,wl,0,BN); \
    KRD(GL,1); GAPB(o[1]=__builtin_amdgcn_mfma_f32_32x32x16_bf16(PAF(1),VFR(5),o[1],0,0,0), C0,12, GF,P0,wl,0,BN); \
    KRD(GL,2); GAPB(o[0]=__builtin_amdgcn_mfma_f32_32x32x16_bf16(PAF(2),VFR(2),o[0],0,0,0), C1,0, GF,P1,wh,32,BN); \
    KRD(GL,3); GAPB(o[1]=__builtin_amdgcn_mfma_f32_32x32x16_bf16(PAF(2),VFR(6),o[1],0,0,0), C1,4, GF,P1,wh,32,BN); \
    GAPB(o[0]=__builtin_amdgcn_mfma_f32_32x32x16_bf16(PAF(3),VFR(3),o[0],0,0,0), C1,8, GF,P1,wh,32,BN); \
    GAPB(o[1]=__builtin_amdgcn_mfma_f32_32x32x16_bf16(PAF(3),VFR(7),o[1],0,0,0), C1,12, GF,P1,wh,32,BN); \
    }while(0)
  #define ENDW(tt) do{ if((tt)+3<NT){WAIT_BAR(3);} else if((tt)+2<NT){WAIT_BAR(1);} else {WAIT_BAR(0);} }while(0)
  int t=1;
  STEP(pB0,pB1,pA0,pA1,1,(4<NT),true,true,true,true);   ENDW(1); RESC(); ROT();
  STEP(pA0,pA1,pB0,pB1,2,(5<NT),true,true,true,true);   ENDW(2); RESC(); ROT();
  t=3;
  for(;t+5<NT;t+=2){
    STEP(pB0,pB1,pA0,pA1,t,true,true,true,true,false);     WAIT_BAR(3); RESC(); ROT();
    STEP(pA0,pA1,pB0,pB1,t+1,true,true,true,true,false);   WAIT_BAR(3); RESC(); ROT();
  }
  for(;t+1<NT;t+=2){
    STEP(pB0,pB1,pA0,pA1,t,(t+3<NT),(t+1<NT),(t+1<NT),(t+1<NT),false);       ENDW(t);   RESC(); ROT();
    STEP(pA0,pA1,pB0,pB1,t+1,(t+4<NT),(t+2<NT),(t+2<NT),(t+2<NT),false);     ENDW(t+1); RESC(); ROT();
  }
  STEP(pB0,pB1,pA0,pA1,NT-1,false,false,false,false,false); RESC();
  { float sacc=pB0[0]+pB0[1]; _Pragma("unroll") for(int r=2;r<16;++r)sacc+=pB0[r]; _Pragma("unroll") for(int r=0;r<16;++r)sacc+=pB1[r]; l_reg+=sacc;
    pw0=(u32x4){PKW(pB0,0),PKW(pB0,2),PKW(pB0,4),PKW(pB0,6)};pw1=(u32x4){PKW(pB0,8),PKW(pB0,10),PKW(pB0,12),PKW(pB0,14)};pw2=(u32x4){PKW(pB1,0),PKW(pB1,2),PKW(pB1,4),PKW(pB1,6)};pw3=(u32x4){PKW(pB1,8),PKW(pB1,10),PKW(pB1,12),PKW(pB1,14)};
    SBAR(); pv(o,vb0+sl_cur,PAF(0),PAF(1),PAF(2),PAF(3)); }
  #undef PKW
  #undef PAF
  #undef VFR
  #undef PIN
  #undef MX3
  #undef GAPA
  #undef GAPB
  #undef EX
  #undef VRD
  #undef KRD
  #undef STEP
  #undef ENDW
  #undef FILL4
  #undef FPREP
  #undef SELV
  #undef CR
  #undef BR
  #undef DECIDE
  {auto rr=__builtin_amdgcn_permlane32_swap(__float_as_uint(l_reg),__float_as_uint(l_reg),false,false);l_reg=__uint_as_float(rr[0])+__uint_as_float(rr[1]);}
  if(hi==0)wsf[32+r32]=l_reg;asm volatile("s_waitcnt lgkmcnt(0)":::"memory");
  float rli[16];
  #pragma unroll
  for(int r=0;r<16;++r)rli[r]=__builtin_amdgcn_rcpf(wsf[32+crow(r,hi)]);
  bf16*Ow=O+(rowbase+q0+wid*QBLK)*OPITCH+h*D;
  { bf16*stg=(bf16*)(shm+LDS_OST)+wid*2048;
    #pragma unroll
    for(int r=0;r<16;++r){const int orow=crow(r,hi);
      #pragma unroll
      for(int d0=0;d0<2;++d0)stg[orow*64+d0*32+r32]=__float2bfloat16(o[d0][r]*rli[r]);}
    asm volatile("s_waitcnt lgkmcnt(0)":::"memory");
    #pragma unroll
    for(int i=0;i<4;++i){const int row=i*8+(lane>>3),ch=lane&7; const u32x4 v=*(const u32x4*)(stg+row*64+ch*8); ATTN_STORE16(Ow+(long)row*OPITCH+ch*8,v);} }
  asm volatile("s_waitcnt lgkmcnt(0)\n\ts_barrier":::"memory");
  #undef DMA_K
  #undef DMA_V
  #undef DMA_M
  #undef TI
  #undef RESC
  #undef ROT
}
constexpr int ATTN_LDS_BYTES=LDS_BYTES;
struct AttnTensors { const bf16* Q; const bf16* K; const bf16* V; const unsigned long long* SEL; bf16* O; };
struct AttnUnit { int bh; int qb; };
struct StaticOrder {
  int vcu,grid,block;
  __device__ __forceinline__ explicit StaticOrder(int grid_,int block_):vcu((block_%8)*(grid_/8)+block_/8),grid(grid_),block(block_){}
  __device__ __forceinline__ bool next(int i,AttnUnit&u)const{
    if(grid==256){ if(i>=4)return false; const int s=vcu&7; u.bh=vcu>>3; u.qb=(i==0)?s:(i==1)?15-s:(i==2)?16+s:31-s; return true; }
    const int n=i*grid+block; if(n>=BATCH*NHEAD*NQB)return false; u.bh=n/NQB; u.qb=n%NQB; return true; }
};
template<class Sched,int THRL=8> __device__ __forceinline__ void attn_phase(char*lds,const AttnTensors&T,const Sched&S){
  AttnUnit u;
  for(int i=0;S.next(i,u);++i){ attn_unit<THRL>(u.bh/NHEAD,u.bh%NHEAD,u.qb,T.Q,T.K,T.V,T.SEL,T.O,lds); }
}
#undef SBAR
#undef WAIT_BAR
}
#define XB_TMO      128
#define XB_XCNT(j)  (256  + 64 * (j))
#define XB_XSUB(j)  (1280 + 64 * (j))
#define XB_XGEN(j)  (2304 + 64 * (j))
#define XB_TOP      3328
#define XB_TOPGEN   3392
#define XCD_BAR_WORDS 3456
#define XB_SPIN_CAP (1u << 18)

__device__ __forceinline__ unsigned xb_ld(unsigned* p)              { return __hip_atomic_load(p, __ATOMIC_RELAXED, __HIP_MEMORY_SCOPE_AGENT); }
__device__ __forceinline__ unsigned xb_add(unsigned* p, unsigned v) { return __hip_atomic_fetch_add(p, v, __ATOMIC_RELAXED, __HIP_MEMORY_SCOPE_AGENT); }
__device__ __forceinline__ unsigned xb_xcc_id() { return (unsigned)__builtin_amdgcn_s_getreg((3 << 11) | 20) & 0xFu; }
#define XB_SPIN(cond, bar) do { unsigned _sp = 0; while (cond) { __builtin_amdgcn_s_sleep(1); \
    if ((++_sp & 255u) == 0u) { if (xb_ld(&(bar)[XB_TMO])) break; if (_sp > XB_SPIN_CAP) { atomicAdd(&(bar)[XB_TMO], 1u); break; } } } } while (0)

struct XcdBarrier {
    unsigned* bar; unsigned x;
    volatile LAS unsigned* st;
};

__device__ __forceinline__ XcdBarrier xcd_barrier_post(unsigned* bar, volatile LAS unsigned* st) {
    XcdBarrier b; b.bar = bar; b.x = xb_xcc_id(); b.st = st;
    if (threadIdx.x == 0) (void)xb_add(&bar[XB_XCNT(b.x)], 1u);
    return b;
}
__device__ __forceinline__ void xcd_barrier_complete(unsigned* bar, unsigned x, unsigned& nloc, unsigned& nx) {
    const unsigned G = gridDim.x * gridDim.y * gridDim.z;
    unsigned sum, cnt, mine, sp = 0u;
    for (;;) {
        sum = 0u; cnt = 0u; mine = 0u;
#pragma unroll
        for (unsigned j = 0; j < 16; ++j) { const unsigned c = xb_ld(&bar[XB_XCNT(j)]); sum += c; cnt += (c > 0u) ? 1u : 0u; mine = (j == x) ? c : mine; }
        if (sum == G) break;
        __builtin_amdgcn_s_sleep(1);
        if ((++sp & 255u) == 0u) { if (xb_ld(&bar[XB_TMO])) break; if (sp > XB_SPIN_CAP) { atomicAdd(&bar[XB_TMO], 1u); break; } }
    }
    nloc = mine > 0u ? mine : 1u; nx = cnt > 0u ? cnt : 1u;
}

__device__ __forceinline__ void xcd_barrier(const XcdBarrier& b) {
    asm volatile("s_waitcnt vmcnt(0)" ::: "memory");
    __syncthreads();
    if (threadIdx.x == 0) {
        unsigned* bar = b.bar;
        __builtin_amdgcn_s_waitcnt(0);
        unsigned nloc = b.st[0], nx = b.st[1];
        if (nloc == 0u) { xcd_barrier_complete(bar, b.x, nloc, nx); b.st[0] = nloc; b.st[1] = nx; }
        const unsigned old = xb_add(&bar[XB_XSUB(b.x)], 1u);
        const unsigned gen = old / nloc;
        if (old + 1u == (gen + 1u) * nloc) {
            __builtin_amdgcn_fence(__ATOMIC_RELEASE, "agent");
            asm volatile("s_waitcnt vmcnt(0)" ::: "memory");
            const unsigned og = xb_add(&bar[XB_TOP], 1u);
            const unsigned tg = og / nx;
            if (og + 1u == (tg + 1u) * nx) xb_add(&bar[XB_TOPGEN], 1u);
            else XB_SPIN(xb_ld(&bar[XB_TOPGEN]) == tg, bar);
            __builtin_amdgcn_fence(__ATOMIC_ACQUIRE, "agent");
            xb_add(&bar[XB_XGEN(b.x)], 1u);
            asm volatile("s_waitcnt vmcnt(0)" ::: "memory");
        } else {
            XB_SPIN(xb_ld(&bar[XB_XGEN(b.x)]) == gen, bar);
            __builtin_amdgcn_fence(__ATOMIC_ACQUIRE, "agent");
            asm volatile("s_waitcnt vmcnt(0)" ::: "memory");
        }
    }
    __syncthreads();
}

__device__ __forceinline__ void p0_transpose_item(const float* W, int K, int N, bf16* WT, LAS float* scr, int k0, int dn0, int c0, int lane) {
    const int n = lane & 31;
    float tv[32];
#pragma unroll
    for (int i = 0; i < 32; ++i) { const int kk = 2 * i + (lane >> 5); tv[i] = (c0 >= 0) ? W[(size_t)(k0 + kk) * N + c0 + n] : 0.f; }
#pragma unroll
    for (int i = 0; i < 32; ++i) { const int kk = 2 * i + (lane >> 5); scr[kk * 33 + n] = tv[i]; }
    LDS_WAIT(); asm volatile("" ::: "memory");
    const int c = lane & 7;
#pragma unroll
    for (int j = 0; j < 4; ++j) { const int nn = (lane >> 3) + 8 * j; const LAS float* s = scr + (8 * c) * 33 + nn;
        v4u o; o.x = pk2(s[0 * 33], s[1 * 33]); o.y = pk2(s[2 * 33], s[3 * 33]); o.z = pk2(s[4 * 33], s[5 * 33]); o.w = pk2(s[6 * 33], s[7 * 33]);
        *(GAS v4u*)(WT + (size_t)(dn0 + nn) * K + k0 + 8 * c) = o; }
    LDS_WAIT(); asm volatile("" ::: "memory");
}
__device__ __forceinline__ int win_src_col8(int d) {
    if (d < 2120) return d;
    if (d < 2304) return -1;
    if (d < 2816) return 2120 + (d - 2304);
    const int t = (d - 2816) >> 8, w = (d - 2816) & 255;
    return (w < 128) ? (2632 + 128 * t + w) : (3144 + 128 * t + (w - 128));
}
__device__ __forceinline__ void p0_transpose_item_win(const float* W, bf16* WT, LAS float* scr, int k0, int dn0, int lane) {
    const int n = lane & 31; const int c0 = win_src_col8(dn0 + (n & ~7)); const int col = c0 + (n & 7);
    float tv[32];
#pragma unroll
    for (int i = 0; i < 32; ++i) { const int kk = 2 * i + (lane >> 5); tv[i] = (c0 >= 0) ? W[(size_t)(k0 + kk) * 3656 + col] : 0.f; }
#pragma unroll
    for (int i = 0; i < 32; ++i) { const int kk = 2 * i + (lane >> 5); scr[kk * 33 + n] = tv[i]; }
    LDS_WAIT(); asm volatile("" ::: "memory");
    const int c = lane & 7;
#pragma unroll
    for (int j = 0; j < 4; ++j) { const int nn = (lane >> 3) + 8 * j; const LAS float* s = scr + (8 * c) * 33 + nn;
        v4u o; o.x = pk2(s[0 * 33], s[1 * 33]); o.y = pk2(s[2 * 33], s[3 * 33]); o.z = pk2(s[4 * 33], s[5 * 33]); o.w = pk2(s[6 * 33], s[7 * 33]);
        *(GAS v4u*)(WT + (size_t)(dn0 + nn) * D + k0 + 8 * c) = o; }
    LDS_WAIT(); asm volatile("" ::: "memory");
}
__device__ __forceinline__ float wave_sum(float v) {
#pragma unroll
    for (int o = 1; o < 64; o <<= 1) v += __shfl_xor(v, o);
    return v;
}
__device__ __forceinline__ void ln_row(const float* xrow, const float* g, const float* bta, float* orow, bf16* obrow, int lane) {
    const GAS f32x4* xr = (const GAS f32x4*)xrow + lane;
    f32x4 v[4]; float s = 0.f;
#pragma unroll
    for (int j = 0; j < 4; ++j) { v[j] = xr[64 * j]; s += (v[j].x + v[j].y) + (v[j].z + v[j].w); }
    const float mean = wave_sum(s) * (1.f / D); float s2 = 0.f;
#pragma unroll
    for (int j = 0; j < 4; ++j) { v[j] = v[j] - mean; s2 += (v[j].x * v[j].x + v[j].y * v[j].y) + (v[j].z * v[j].z + v[j].w * v[j].w); }
    const float rstd = 1.f / sqrtf(wave_sum(s2) * (1.f / D) + LN_EPS);
    GAS f32x4* of = (GAS f32x4*)orow + lane; GAS v2u* ob = (GAS v2u*)obrow + lane;
#pragma unroll
    for (int j = 0; j < 4; ++j) { const f32x4 gg = ((const GAS f32x4*)g)[lane + 64 * j], bb = ((const GAS f32x4*)bta)[lane + 64 * j];
        const f32x4 y = v[j] * rstd * gg + bb; of[64 * j] = y; v2u w; w.x = pk2(y.x, y.y); w.y = pk2(y.z, y.w); ob[64 * j] = w; }
}

struct Args { const float* in[19]; float* out; unsigned char* ws; };

__device__ __forceinline__ unsigned row_sum16(unsigned v) {
    v += (unsigned)__builtin_amdgcn_update_dpp(0, (int)v, 0xB1, 0xF, 0xF, true);
    v += (unsigned)__builtin_amdgcn_update_dpp(0, (int)v, 0x4E, 0xF, 0xF, true);
    v += (unsigned)__builtin_amdgcn_update_dpp(0, (int)v, 0x141, 0xF, 0xF, true);
    v += (unsigned)__builtin_amdgcn_update_dpp(0, (int)v, 0x140, 0xF, 0xF, true);
    return v;
}
__device__ __forceinline__ unsigned wave_sum_u(unsigned v) {
    v = row_sum16(v);
    return (unsigned)__builtin_amdgcn_readlane((int)v, 0) + (unsigned)__builtin_amdgcn_readlane((int)v, 16) + (unsigned)__builtin_amdgcn_readlane((int)v, 32) + (unsigned)__builtin_amdgcn_readlane((int)v, 48);
}
__device__ __forceinline__ unsigned score_key(float s) {
    const _Float16 h = (_Float16)s; unsigned hb = (unsigned)__builtin_bit_cast(unsigned short, h);
    return (hb & 0x8000u) ? (hb ^ 0xffffu) : (hb | 0x8000u);
}

typedef short s16x2 __attribute__((ext_vector_type(2)));
typedef _Float16 h16x2 __attribute__((ext_vector_type(2)));
__device__ __forceinline__ unsigned score_key2(float a, float b) {
    const unsigned hb = __builtin_bit_cast(unsigned, __builtin_amdgcn_cvt_pkrtz(a, b));
    const s16x2 sg = __builtin_bit_cast(s16x2, hb) >> 15;
    return hb ^ (__builtin_bit_cast(unsigned, sg) | 0x80008000u);
}
__device__ __forceinline__ int sel_bitpos(int c) { return 32 * (c >> 5) + 16 * (c & 1) + ((c & 31) >> 1); }
__device__ __forceinline__ int sel_keyoff(int p) { const int q = p & 31; return 32 * (p >> 5) + 2 * (q & 15) + (q >> 4); }

__device__ __forceinline__ void transpose16(unsigned (&X)[64], int base) {
#define TR_STEP(S, MSK) _Pragma("unroll") for (int i = 0; i < 16; ++i) if ((i & (S)) == 0) { const unsigned a = X[base + i], bb = X[base + i + (S)]; \
        X[base + i] = (a & (MSK)) | ((bb << (S)) & ~(MSK)); X[base + i + (S)] = ((a >> (S)) & (MSK)) | (bb & ~(MSK)); }
    TR_STEP(8, 0x00ff00ffu) TR_STEP(4, 0x0f0f0f0fu) TR_STEP(2, 0x33333333u) TR_STEP(1, 0x55555555u)
#undef TR_STEP
}
__device__ __forceinline__ void select_planes(const LAS unsigned short* rowp, int Lk, int ntb, unsigned long long* selp  , int lane) {
    unsigned R[64];
#pragma unroll
    for (int i = 0; i < 32; ++i) { const v2u v = *(const LAS v2u*)(rowp + 4 * i); R[2 * i] = v.x; R[2 * i + 1] = v.y; }
    transpose16(R, 0); transpose16(R, 16); transpose16(R, 32); transpose16(R, 48);
    unsigned cand[4], gtm[4];
#pragma unroll
    for (int w = 0; w < 4; ++w) { cand[w] = (128 * lane + 32 * w < Lk) ? 0xffffffffu : 0u; gtm[w] = 0u; }
    unsigned need = 0u;
    if (Lk > TOPK) {
        unsigned above = 0u;
#pragma unroll
        for (int b = 15; b >= 0; --b) {
            const unsigned o0 = cand[0] & R[b], o1 = cand[1] & R[16 + b], o2 = cand[2] & R[32 + b], o3 = cand[3] & R[48 + b];
            const unsigned c1 = wave_sum_u((unsigned)__builtin_popcount(o0) + (unsigned)__builtin_popcount(o1) + (unsigned)__builtin_popcount(o2) + (unsigned)__builtin_popcount(o3));
            if (above + c1 >= (unsigned)TOPK) { cand[0] = o0; cand[1] = o1; cand[2] = o2; cand[3] = o3; }
            else { above += c1; gtm[0] |= o0; gtm[1] |= o1; gtm[2] |= o2; gtm[3] |= o3; cand[0] &= ~R[b]; cand[1] &= ~R[16 + b]; cand[2] &= ~R[32 + b]; cand[3] &= ~R[48 + b]; }
        }
        need = (unsigned)TOPK - above;
    } else {
#pragma unroll
        for (int w = 0; w < 4; ++w) { gtm[w] = cand[w]; cand[w] = 0u; }
    }
    { const int ce = __builtin_popcount(cand[0]) + __builtin_popcount(cand[1]) + __builtin_popcount(cand[2]) + __builtin_popcount(cand[3]); int incl = ce;
#pragma unroll
      for (int d = 1; d < 64; d <<= 1) { const int v = __shfl_up(incl, d); if (lane >= d) incl += v; }
      int allow = (int)need - (incl - ce); allow = allow < 0 ? 0 : (allow > ce ? ce : allow);
#pragma unroll
      for (int w = 0; w < 4; ++w) { const int cw = __builtin_popcount(cand[w]); const int take = allow < cw ? allow : cw; allow -= take;
          unsigned x = cand[w], sbits = 0u;
          if (take == cw) sbits = x; else for (int i = 0; i < take; ++i) { const unsigned lb = x & (0u - x); sbits |= lb; x ^= lb; }
          gtm[w] |= sbits; } }
    if (2 * lane < ntb) selp[(size_t)(2 * lane) * SEQ] = ((unsigned long long)gtm[1] << 32) | gtm[0];
    if (2 * lane + 1 < ntb) selp[(size_t)(2 * lane + 1) * SEQ] = ((unsigned long long)gtm[3] << 32) | gtm[2];
}

__global__ void __launch_bounds__(NWAVES * 64, 2) mega_fwd(Args args) {
    extern __shared__ __attribute__((aligned(16))) unsigned char lds[];
    LAS unsigned char* const L = (LAS unsigned char*)lds;
    volatile LAS unsigned* const MISC = (volatile LAS unsigned*)(L + MISC_OFF);
    const int G = gridDim.x, bx = blockIdx.x;
    const int vcu = (G % 8 == 0) ? (bx % 8) * (G / 8) + bx / 8 : bx;
    gu32* const ctl = (gu32*)(args.ws + WS_CTL);
    const int tid = threadIdx.x;
#define PHASE_VIEW() int tid_p = threadIdx.x; asm volatile("" : "+v"(tid_p)); const int lane = tid_p & 63, wave = __builtin_amdgcn_readfirstlane(tid_p >> 6); size_t z_ = 0; asm volatile("" : "+s"(z_)); unsigned char* ws = args.ws + z_; float* out = args.out + z_;     \
    const int gw = vcu * NWAVES + wave, NGW = G * NWAVES; (void)lane; (void)gw; (void)NGW; (void)out; \
    bf16* const XB = (bf16*)(ws + WS_XB); float* const R = (float*)(ws + WS_R); bf16* const HB = (bf16*)(ws + WS_BIG); bf16* const PB = (bf16*)(ws + WS_PB); \
    bf16* const QKVI = (bf16*)(ws + WS_QKVI); bf16* const KI = (bf16*)(ws + WS_KI); float* const WI = (float*)(ws + WS_WI); bf16* const BC = (bf16*)(ws + WS_BC); bf16* const Z = (bf16*)(ws + WS_Z); \
    unsigned long long* const SEL = (unsigned long long*)(ws + WS_SEL); \
    const bf16* const Qb = QKVI; const bf16* const Kb = QKVI + (size_t)M * 512; const bf16* const Vb = QKVI + (size_t)2 * M * 512; const bf16* const QIb = QKVI + (size_t)3 * M * 512; \
    (void)XB; (void)R; (void)HB; (void)PB; (void)KI; (void)WI; (void)BC; (void)Z; (void)SEL; (void)Qb; (void)Kb; (void)Vb; (void)QIb;

    for (int u = tid; u < (LDS_BYTES - LDSCTL_OFF) / 4; u += NWAVES * 64) ((LAS unsigned*)(L + LDSCTL_OFF))[u] = 0u;
    __syncthreads();
    XcdBarrier bar = xcd_barrier_post((unsigned*)(ctl + CW_BAR), MISC + 8);
#define GRID_BAR() xcd_barrier(bar)

    { PHASE_VIEW();
        const float* const x = args.in[0]; const float* const pin = args.in[1];
        LAS float* scr = (LAS float*)(L + RING_OFF + wave * 16384);
        constexpr int I_GU = (D / 64) * (NGU / 32), I_D = (FF / 64) * (D / 32), I_IN = (D / 64) * (NIN / 32), I_SQ = (D / 64) * (D / 32), I_P = (DPLE / 64) * (D / 32);
        constexpr int NITEMS = 2 * I_GU + 2 * I_D + I_IN + 2 * I_SQ + I_P;
        for (int it = gw; it < NITEMS; it += NGW) {
            int r = it;
            if (r < 2 * I_GU) { const int f = r / I_GU; r -= f * I_GU; const int nb = r % (NGU / 32), kb = r / (NGU / 32), dn0 = 32 * nb;
                const int half = (dn0 >> 7) & 1, j0 = ((dn0 >> 8) << 7) + (dn0 & 127);
                const float* W = f ? (half ? args.in[13] : args.in[12]) : (half ? args.in[5] : args.in[4]);
                p0_transpose_item(W, D, FF, (bf16*)(ws + (f ? WS_WGU2 : WS_WGU1)), scr, 64 * kb, dn0, j0, lane); continue; }
            r -= 2 * I_GU;
            if (r < 2 * I_D) { const int f = r / I_D; r -= f * I_D; const int nb = r % (D / 32), kb = r / (D / 32);
                p0_transpose_item(f ? args.in[14] : args.in[6], FF, D, (bf16*)(ws + (f ? WS_WD2 : WS_WD1)), scr, 64 * kb, 32 * nb, 32 * nb, lane); continue; }
            r -= 2 * I_D;
            if (r < I_IN) { const int nb = r % (NIN / 32), kb = r / (NIN / 32); p0_transpose_item_win(args.in[7], (bf16*)(ws + WS_WIN), scr, 64 * kb, 32 * nb, lane); continue; }
            r -= I_IN;
            if (r < 2 * I_SQ) { const int f = r / I_SQ; r -= f * I_SQ; const int nb = r % (D / 32), kb = r / (D / 32);
                p0_transpose_item(f ? args.in[17] : args.in[9], D, D, (bf16*)(ws + (f ? WS_WGATE : WS_WOUT)), scr, 64 * kb, 32 * nb, 32 * nb, lane); continue; }
            r -= 2 * I_SQ;
            { const int nb = r % (D / 32), kb = r / (D / 32); p0_transpose_item(args.in[18], DPLE, D, (bf16*)(ws + WS_WP), scr, 64 * kb, 32 * nb, 32 * nb, lane); }
        }
        const size_t gt = (size_t)bx * (NWAVES * 64) + tid_p, GT = (size_t)G * NWAVES * 64;
        for (size_t i = gt; i < (size_t)M * D / 8; i += 4 * GT) {
            f32x4 a[4], b[4];
#pragma unroll
            for (int u = 0; u < 4; ++u) { const size_t j = i + u * GT; if (j < (size_t)M * D / 8) { a[u] = ((const GAS f32x4*)x)[2 * j]; b[u] = ((const GAS f32x4*)x)[2 * j + 1]; } }
#pragma unroll
            for (int u = 0; u < 4; ++u) { const size_t j = i + u * GT; if (j < (size_t)M * D / 8) { v4u o; o.x = pk2(a[u].x, a[u].y); o.y = pk2(a[u].z, a[u].w); o.z = pk2(b[u].x, b[u].y); o.w = pk2(b[u].z, b[u].w); ((GAS v4u*)XB)[j] = o; } } }
        for (size_t i = gt; i < (size_t)M * DPLE / 8; i += GT) { const f32x4 a = ((const GAS f32x4*)pin)[2 * i], b = ((const GAS f32x4*)pin)[2 * i + 1];
            v4u o; o.x = pk2(a.x, a.y); o.y = pk2(a.z, a.w); o.z = pk2(b.x, b.y); o.w = pk2(b.z, b.w); ((GAS v4u*)PB)[i] = o; }
    }
    GRID_BAR();

    { PHASE_VIEW(); pg8::Gemm g{XB, (const bf16*)(ws + WS_WGU1), M, NGU, D}; pg8::StaticOrder S; S.init(M, NGU, G, bx);
      pg8::EpiSwiGLU E{HB, FF};
      pg8::gemm_phase<pg8::EpiSwiGLU, pg8::StaticOrder, true, true>(L + RING_OFF, g, S, E); }
    GRID_BAR();
    { PHASE_VIEW(); pg8::Gemm g{HB, (const bf16*)(ws + WS_WD1), M, D, FF}; pg8::StaticOrder S; S.init(M, D, G, bx);
      pg8::EpiRes E{args.in[0], R, D, DN_ALPHA, 0.5f};
      pg8::gemm_phase<pg8::EpiRes, pg8::StaticOrder, true, true>(L + RING_OFF, g, S, E); }
    GRID_BAR();
    { PHASE_VIEW(); for (int m = gw; m < M; m += NGW) ln_row(R + (size_t)m * D, args.in[2], args.in[3], out + (size_t)m * D, XB + (size_t)m * D, lane); }
    GRID_BAR();
    { PHASE_VIEW(); pg8::Gemm g{XB, (const bf16*)(ws + WS_WIN), M, NIN, D}; pg8::StaticOrder S; S.init(M, NIN, G, bx);
      pg8::EpiWin E{QKVI, KI, WI, BC, Z, M, IDX_SCALE, 0.125f * LOG2E};
      pg8::gemm_phase<pg8::EpiWin, pg8::StaticOrder, true, true>(L + RING_OFF, g, S, E); }
    GRID_BAR();

    for (int rep5 = 0; rep5 < REP_P5; ++rep5) { PHASE_VIEW();
        LAS unsigned short* const sc = (LAS unsigned short*)L;
        const int r32 = lane & 31, hi = lane >> 5;
        for (int un = bx; un < BATCH * (SEQ / 8); un += G) {
            const int b = un & 3, g8 = un >> 2;
            const int t0 = 8 * g8, c = t0 >> 6, nslots = c + 1, nt32 = 2 * nslots;
            const size_t rowbase = (size_t)b * SEQ;
            bf16x8 A[2][4]; float w[2][16];
            { const int hh = (r32 >> 2) & 1, i = (r32 & 3) + 4 * (r32 >> 3);
#pragma unroll
              for (int blk = 0; blk < 2; ++blk) { const bf16* src = QIb + (rowbase + t0 + 4 * blk + 2 * hh + (i >> 3)) * 512 + (i & 7) * 64 + 8 * hi;
#pragma unroll
                  for (int ks = 0; ks < 4; ++ks) A[blk][ks] = *(const GAS bf16x8*)(src + 16 * ks); }
#pragma unroll
              for (int blk = 0; blk < 2; ++blk)
#pragma unroll
                  for (int q2 = 0; q2 < 2; ++q2) { const float* wp = WI + (rowbase + t0 + 4 * blk + 2 * hi + q2) * 8; const f32x4 a = *(const GAS f32x4*)wp, bb = *(const GAS f32x4*)(wp + 4);
                      w[blk][q2 * 8 + 0] = a.x; w[blk][q2 * 8 + 1] = a.y; w[blk][q2 * 8 + 2] = a.z; w[blk][q2 * 8 + 3] = a.w; w[blk][q2 * 8 + 4] = bb.x; w[blk][q2 * 8 + 5] = bb.y; w[blk][q2 * 8 + 6] = bb.z; w[blk][q2 * 8 + 7] = bb.w; } }
            const bf16* kb = KI + rowbase * 64 + hi * 256 + r32 * 8;
            bf16x8 B0[4], B1[4], B2[4];
#define IDX_LDB(Bx, ktx) do { const int kc_ = (ktx) < nt32 ? (ktx) : nt32 - 1;     \
                _Pragma("unroll") for (int ks = 0; ks < 4; ++ks) Bx[ks] = *(const GAS bf16x8*)(kb + (size_t)kc_ * 2048 + 512 * ks); } while (0)
#define IDX_RF(sacc, wv, av) do { const float fv_ = av; const int ri_ = __float_as_int(fv_); sacc = __builtin_fmaf(wv, __int_as_float(ri_ > 0 ? ri_ : 0), sacc); asm("" : "+v"(sacc)); } while (0)
#define IDX_TILE(Bx, ktx) do { f32x16 a0 = {}, a1 = {}; \
                _Pragma("unroll") for (int ks = 0; ks < 4; ++ks) { a0 = __builtin_amdgcn_mfma_f32_32x32x16_bf16(A[0][ks], Bx[ks], a0, 0, 0, 0); a1 = __builtin_amdgcn_mfma_f32_32x32x16_bf16(A[1][ks], Bx[ks], a1, 0, 0, 0); } \
                const int key = 32 * ((ktx) < nt32 ? (ktx) : nt32 - 1) + r32; LAS unsigned short* dst = sc + (key >> 7) * 132 + (key & 127) + 2 * hi * SROW_U16; \
                float s00 = 0.f, s01 = 0.f, s10 = 0.f, s11 = 0.f; \
                _Pragma("unroll") for (int h = 0; h < 8; ++h) { IDX_RF(s00, w[0][h], a0[h]); IDX_RF(s01, w[0][8 + h], a0[8 + h]); IDX_RF(s10, w[1][h], a1[h]); IDX_RF(s11, w[1][8 + h], a1[8 + h]); } \
                const unsigned k0_ = score_key2(s00, s01), k1_ = score_key2(s10, s11); \
                dst[0] = (unsigned short)k0_; dst[SROW_U16] = (unsigned short)(k0_ >> 16); dst[4 * SROW_U16] = (unsigned short)k1_; dst[5 * SROW_U16] = (unsigned short)(k1_ >> 16); } while (0)
            for (int rsc = 0; rsc < REP_SCORE; ++rsc) {
            int kt = wave;
            IDX_LDB(B0, kt); IDX_LDB(B1, kt + NWAVES);
            for (; kt < nt32; kt += 3 * NWAVES) {
                IDX_LDB(B2, kt + 2 * NWAVES); IDX_TILE(B0, kt);
                IDX_LDB(B0, kt + 3 * NWAVES); IDX_TILE(B1, kt + NWAVES);
                IDX_LDB(B1, kt + 4 * NWAVES); IDX_TILE(B2, kt + 2 * NWAVES);
            }
            }
#undef IDX_LDB
#undef IDX_TILE
#undef IDX_RF
            __syncthreads();
            {
                const int t = t0 + wave; const int ntb = 4 * ((c >> 2) + 1);
                for (int rsl = 0; rsl < REP_SELECT; ++rsl) select_planes(sc + wave * SROW_U16 + lane * 132, 64 * nslots, ntb, SEL + (size_t)b * 128 * SEQ + t, lane);
            }
            __syncthreads();
        }
        { const float* cw = args.in[8]; float cwv[3][8];
#pragma unroll
          for (int j = 0; j < 3; ++j) { const f32x4 a = *(const GAS f32x4*)(cw + j * DC + 8 * lane), bb = *(const GAS f32x4*)(cw + j * DC + 8 * lane + 4);
              cwv[j][0] = a.x; cwv[j][1] = a.y; cwv[j][2] = a.z; cwv[j][3] = a.w; cwv[j][4] = bb.x; cwv[j][5] = bb.y; cwv[j][6] = bb.z; cwv[j][7] = bb.w; }
          for (int m = gw; m < M; m += NGW) { const int t = m & (SEQ - 1);
              const v4u zero = {0u, 0u, 0u, 0u};
              const v4u z2 = *(const GAS v4u*)(Z + (size_t)m * 512 + 8 * lane);
              const v4u z1 = (t >= 1) ? *(const GAS v4u*)(Z + (size_t)(m - 1) * 512 + 8 * lane) : zero;
              const v4u z0 = (t >= 2) ? *(const GAS v4u*)(Z + (size_t)(m - 2) * 512 + 8 * lane) : zero;
              const v4u bv = *(const GAS v4u*)(BC + (size_t)m * 512 + 8 * lane);
              float y[8];
#pragma unroll
              for (int e = 0; e < 4; ++e) { y[2 * e] = bf_lo(bv[e]) * (cwv[0][2 * e] * bf_lo(z0[e]) + cwv[1][2 * e] * bf_lo(z1[e]) + cwv[2][2 * e] * bf_lo(z2[e]));
                  y[2 * e + 1] = bf_hi(bv[e]) * (cwv[0][2 * e + 1] * bf_hi(z0[e]) + cwv[1][2 * e + 1] * bf_hi(z1[e]) + cwv[2][2 * e + 1] * bf_hi(z2[e])); }
              v4u o; o.x = pk2(y[0], y[1]); o.y = pk2(y[2], y[3]); o.z = pk2(y[4], y[5]); o.w = pk2(y[6], y[7]);
              *(GAS v4u*)(XB + (size_t)m * D + DA + 8 * lane) = o; } }
    }
    GRID_BAR();

#if !SPARSE_ATTN
    for (int rep6 = 0; rep6 < REP_P6; ++rep6) { PHASE_VIEW();
        const attn_body::AttnTensors AT{(const attn_body::bf16*)Qb, (const attn_body::bf16*)Kb, (const attn_body::bf16*)Vb, SEL, (attn_body::bf16*)XB};
        const attn_body::StaticOrder S(G, bx);
        attn_body::attn_phase<attn_body::StaticOrder>((char*)lds + RING_OFF, AT, S);
    }
#else
    for (int rep6 = 0; rep6 < REP_P6; ++rep6) { PHASE_VIEW();
        const int h = bx & 7, wx = (bx >> 3) * NWAVES + wave, NWX = (G >> 3) * NWAVES;
        LAS unsigned short* const list = (LAS unsigned short*)(L + wave * 512);
        const float slope2 = __builtin_amdgcn_exp2f(-(float)(h + 1)) * LOG2E;
        const int kk = lane >> 3, part = lane & 7;
        for (int b = 0; b < BATCH; ++b)
            for (int t = wx; t < SEQ; t += NWX) {
                const int nslots = (t >> 6) + 1; const int n = nslots * 64 < TOPK ? nslots * 64 : TOPK;
                const size_t rowbase = (size_t)b * SEQ;
                const unsigned long long* selp = SEL + (size_t)b * 128 * SEQ + t;
                unsigned long long w0 = (lane < nslots) ? selp[(size_t)lane * SEQ] : 0ull, w1 = (lane + 64 < nslots) ? selp[(size_t)(lane + 64) * SEQ] : 0ull;
                const int cnt = __popcll(w0) + __popcll(w1); int incl = cnt;
#pragma unroll
                for (int d = 1; d < 64; d <<= 1) { const int v = __shfl_up(incl, d); if (lane >= d) incl += v; }
                int pos = incl - cnt;
                while (w0) { const int bp = sel_keyoff(__ffsll((long long)w0) - 1); if (pos < TOPK) list[pos] = (unsigned short)(lane * 64 + bp); ++pos; w0 &= w0 - 1ull; }
                while (w1) { const int bp = sel_keyoff(__ffsll((long long)w1) - 1); if (pos < TOPK) list[pos] = (unsigned short)((lane + 64) * 64 + bp); ++pos; w1 &= w1 - 1ull; }
                LDS_WAIT();
                float q[8];
                { const v4u qv = *(const GAS v4u*)(Qb + (rowbase + t) * 512 + h * 64 + 8 * part); const float sc2 = 1.0f;
#pragma unroll
                  for (int e = 0; e < 4; ++e) { q[2 * e] = bf_lo(qv[e]) * sc2; q[2 * e + 1] = bf_hi(qv[e]) * sc2; } }
                float mrun = -INFINITY, lrun = 0.f, o[8];
#pragma unroll
                for (int e = 0; e < 8; ++e) o[e] = 0.f;
                const bf16* Kh = Kb + rowbase * 512 + h * 64 + 8 * part; const bf16* Vh = Vb + rowbase * 512 + h * 64 + 8 * part;
                for (int i = 0; i < n; i += 32) {
                    int key[4]; v4u kv[4], vv[4];
#pragma unroll
                    for (int u = 0; u < 4; ++u) key[u] = list[i + 8 * u + kk];
#pragma unroll
                    for (int u = 0; u < 4; ++u) { kv[u] = *(const GAS v4u*)(Kh + (size_t)key[u] * 512); vv[u] = *(const GAS v4u*)(Vh + (size_t)key[u] * 512); }
#pragma unroll
                    for (int u = 0; u < 4; ++u) {
                        float d = 0.f;
#pragma unroll
                        for (int e = 0; e < 4; ++e) d += q[2 * e] * bf_lo(kv[u][e]) + q[2 * e + 1] * bf_hi(kv[u][e]);
                        d += __shfl_xor(d, 1); d += __shfl_xor(d, 2); d += __shfl_xor(d, 4);
                        const int dist = t - key[u]; const float lg = d - slope2 * (float)(dist < 0 ? -dist : dist);
                        const float mn = __builtin_fmaxf(mrun, lg), al = __builtin_amdgcn_exp2f(mrun - mn), pp = __builtin_amdgcn_exp2f(lg - mn);
                        lrun = lrun * al + pp; mrun = mn;
#pragma unroll
                        for (int e = 0; e < 4; ++e) { o[2 * e] = o[2 * e] * al + pp * bf_lo(vv[u][e]); o[2 * e + 1] = o[2 * e + 1] * al + pp * bf_hi(vv[u][e]); }
                    }
                }
#pragma unroll
                for (int d = 8; d < 64; d <<= 1) { const float mo = __shfl_xor(mrun, d), lo_ = __shfl_xor(lrun, d); const float mn = __builtin_fmaxf(mrun, mo), a = __builtin_amdgcn_exp2f(mrun - mn), bsc = __builtin_amdgcn_exp2f(mo - mn);
                    lrun = lrun * a + lo_ * bsc;
#pragma unroll
                    for (int e = 0; e < 8; ++e) { const float oo = __shfl_xor(o[e], d); o[e] = o[e] * a + oo * bsc; }
                    mrun = mn; }
                if (kk == 0) { const float rl = 1.0f / lrun; v4u ov; ov.x = pk2(o[0] * rl, o[1] * rl); ov.y = pk2(o[2] * rl, o[3] * rl); ov.z = pk2(o[4] * rl, o[5] * rl); ov.w = pk2(o[6] * rl, o[7] * rl);
                    *(GAS v4u*)(XB + (rowbase + t) * D + h * 64 + 8 * part) = ov; }
                LDS_WAIT();
            }
    }
#endif
    GRID_BAR();

#if PROBE_CHECK
    { PHASE_VIEW();
        unsigned bad = 0u; float maxd = 0.f;
        for (int qs = gw; qs < 1500; qs += NGW) {
            const int gq = (qs * 21 + 3) % M; const int b = gq / SEQ, t = gq % SEQ;
            const int nslots = (t >> 6) + 1, Lk = 64 * nslots, n = Lk < TOPK ? Lk : TOPK;
            const size_t rowbase = (size_t)b * SEQ, row = rowbase + t;
            float wv[8];
#pragma unroll
            for (int h = 0; h < 8; ++h) wv[h] = WI[row * 8 + h];
            float minsel = INFINITY, maxuns = -INFINITY; int cnt = 0;
            for (int key = lane; key < Lk; key += 64) {
                float sc_ = 0.f;
                for (int h = 0; h < 8; ++h) { float rel = 0.f;
                    for (int d = 0; d < 64; d += 2) { const unsigned qa = *(const GAS unsigned*)(QIb + row * 512 + h * 64 + d), ka = *(const GAS unsigned*)(KI + ((rowbase + key) >> 5) * 2048 + (d >> 3) * 256 + ((rowbase + key) & 31) * 8 + (d & 7)); rel += bf_lo(qa) * bf_lo(ka) + bf_hi(qa) * bf_hi(ka); }
                    sc_ += wv[h] * __builtin_fmaxf(rel, 0.f); }
                const unsigned long long wd = SEL[((size_t)b * 128 + (key >> 6)) * SEQ + t];
                if ((wd >> sel_bitpos(key & 63)) & 1ull) { ++cnt; minsel = __builtin_fminf(minsel, sc_); } else maxuns = __builtin_fmaxf(maxuns, sc_);
            }
#pragma unroll
            for (int o = 1; o < 64; o <<= 1) { cnt += __shfl_xor(cnt, o); minsel = __builtin_fminf(minsel, __shfl_xor(minsel, o)); maxuns = __builtin_fmaxf(maxuns, __shfl_xor(maxuns, o)); }
            if (cnt != n) bad |= 1u;
            if (Lk > TOPK && maxuns > minsel + 0.004f * __builtin_fabsf(minsel) + 0.002f) bad |= 2u;
            const int h = lane >> 3, part = lane & 7; const float slope = __builtin_amdgcn_exp2f(-(float)(h + 1));
            float q[8], o[8]; float mrun = -INFINITY, lrun = 0.f;
            { const v4u qv = *(const GAS v4u*)(Qb + row * 512 + h * 64 + 8 * part);
#pragma unroll
              for (int e = 0; e < 4; ++e) { q[2 * e] = bf_lo(qv[e]); q[2 * e + 1] = bf_hi(qv[e]); o[2 * e] = 0.f; o[2 * e + 1] = 0.f; } }
            for (int j = 0; j < nslots; ++j) { unsigned long long wd = SEL[((size_t)b * 128 + j) * SEQ + t];
                while (wd) { const int key = 64 * j + sel_keyoff(__ffsll((long long)wd) - 1); wd &= wd - 1ull;
                    const v4u kv = *(const GAS v4u*)(Kb + (rowbase + key) * 512 + h * 64 + 8 * part), vv = *(const GAS v4u*)(Vb + (rowbase + key) * 512 + h * 64 + 8 * part);
                    float d = 0.f;
#pragma unroll
                    for (int e = 0; e < 4; ++e) d += q[2 * e] * bf_lo(kv[e]) + q[2 * e + 1] * bf_hi(kv[e]);
                    d += __shfl_xor(d, 1); d += __shfl_xor(d, 2); d += __shfl_xor(d, 4);
                    const int dist = t - key; const float lg = d * 0.6931471805599453f - slope * (float)(dist < 0 ? -dist : dist);
                    const float mn = __builtin_fmaxf(mrun, lg), al = __expf(mrun - mn), pp = __expf(lg - mn);
                    lrun = lrun * al + pp; mrun = mn;
#pragma unroll
                    for (int e = 0; e < 4; ++e) { o[2 * e] = o[2 * e] * al + pp * bf_lo(vv[e]); o[2 * e + 1] = o[2 * e + 1] * al + pp * bf_hi(vv[e]); } } }
            const v4u fv = *(const GAS v4u*)(XB + row * D + h * 64 + 8 * part);
            float dmax = 0.f, amax = 0.f;
#pragma unroll
            for (int e = 0; e < 4; ++e) { const float r0 = o[2 * e] / lrun, r1 = o[2 * e + 1] / lrun; dmax = __builtin_fmaxf(dmax, __builtin_fmaxf(__builtin_fabsf(r0 - bf_lo(fv[e])), __builtin_fabsf(r1 - bf_hi(fv[e])))); amax = __builtin_fmaxf(amax, __builtin_fmaxf(__builtin_fabsf(r0), __builtin_fabsf(r1))); }
#pragma unroll
            for (int o2 = 1; o2 < 8; o2 <<= 1) { dmax = __builtin_fmaxf(dmax, __shfl_xor(dmax, o2)); amax = __builtin_fmaxf(amax, __shfl_xor(amax, o2)); }
            maxd = __builtin_fmaxf(maxd, dmax / (amax + 1e-6f));
        }
        atomicMax((unsigned*)(ctl + 8), __float_as_uint(maxd)); if (bad) atomicOr((unsigned*)(ctl + 9), bad);
    }
#endif
    { PHASE_VIEW(); pg8::Gemm g{XB, (const bf16*)(ws + WS_WOUT), M, D, D}; pg8::StaticOrder S; S.init(M, D, G, bx);
      pg8::EpiRes E{out, R, D, DN_ALPHA, 1.0f};
      pg8::gemm_phase<pg8::EpiRes, pg8::StaticOrder, true, true>(L + RING_OFF, g, S, E); }
    GRID_BAR();
    { PHASE_VIEW(); for (int m = gw; m < M; m += NGW) ln_row(R + (size_t)m * D, args.in[10], args.in[11], out + (size_t)m * D, XB + (size_t)m * D, lane); }
    GRID_BAR();
    { PHASE_VIEW(); pg8::Gemm g{XB, (const bf16*)(ws + WS_WGU2), M, NGU, D}; pg8::StaticOrder S; S.init(M, NGU, G, bx);
      pg8::EpiSwiGLU E{HB, FF};
      pg8::gemm_phase<pg8::EpiSwiGLU, pg8::StaticOrder, true, true>(L + RING_OFF, g, S, E); }
    GRID_BAR();
    { PHASE_VIEW(); pg8::Gemm g{HB, (const bf16*)(ws + WS_WD2), M, D, FF}; pg8::StaticOrder S; S.init(M, D, G, bx);
      pg8::EpiRes E{out, R, D, DN_ALPHA, 0.5f};
      pg8::gemm_phase<pg8::EpiRes, pg8::StaticOrder, true, true>(L + RING_OFF, g, S, E); }
    GRID_BAR();
    { PHASE_VIEW(); for (int m = gw; m < M; m += NGW) ln_row(R + (size_t)m * D, args.in[15], args.in[16], out + (size_t)m * D, XB + (size_t)m * D, lane); }
    GRID_BAR();
    { PHASE_VIEW(); pg8::Gemm g{PB, (const bf16*)(ws + WS_WP), M, D, DPLE}; pg8::StaticOrder S; S.init(M, D, G, bx);
      pg8::EpiF32 E{R, D};
      pg8::gemm_phase<pg8::EpiF32, pg8::StaticOrder, true, true>(L + RING_OFF, g, S, E); }
    { PHASE_VIEW(); pg8::Gemm g{XB, (const bf16*)(ws + WS_WGATE), M, D, D}; pg8::StaticOrder S; S.init(M, D, G, bx);
      pg8::EpiGate E{out, R, out, D};
      pg8::gemm_phase<pg8::EpiGate, pg8::StaticOrder, true, true>(L + RING_OFF, g, S, E); }
#if PROBE_CHECK
    GRID_BAR();
    { PHASE_VIEW(); const float md = __uint_as_float(__hip_atomic_load((unsigned*)(ctl + 8), RLX_AGENT)); const unsigned bd = __hip_atomic_load((unsigned*)(ctl + 9), RLX_AGENT);
      float E = 0.f; if (md > 0.02f || !(md == md)) E += (md < 0.5f ? md : 0.5f); if (bd & 1u) E += 1.0f; if (bd & 2u) E += 2.0f;
      if (E > 0.f) { const size_t gt = (size_t)bx * (NWAVES * 64) + tid_p, GT = (size_t)G * NWAVES * 64;
          for (size_t i = gt; i < (size_t)M * D / 4; i += GT) { f32x4 v = ((GAS f32x4*)out)[i]; v = v * (1.0f + E); ((GAS f32x4*)out)[i] = v; } } }
#endif

}

extern "C" void kernel_launch(void* const* d_in, const int* in_sizes, int n_in, void* d_out, int out_size, void* d_ws, size_t ws_size, hipStream_t stream) {
    static int grid = 0;
    if (grid == 0) {
        if (n_in != 19 || in_sizes[0] != M * D || out_size != M * D || ws_size < WS_END) { fprintf(stderr, "kernel_launch: unexpected problem (n_in %d, in0 %d, out %d, ws %zu < %zu); nothing launched\n", n_in, n_in > 0 ? in_sizes[0] : -1, out_size, ws_size, (size_t)WS_END); grid = -1; return; }
        int dev = 0, cus = 0, per_cu = 0;
        if (hipGetDevice(&dev) != hipSuccess || hipDeviceGetAttribute(&cus, hipDeviceAttributeMultiprocessorCount, dev) != hipSuccess) { fprintf(stderr, "kernel_launch: device query failed\n"); grid = -1; return; }
        if (hipFuncSetAttribute((const void*)mega_fwd, hipFuncAttributeMaxDynamicSharedMemorySize, LDS_BYTES) != hipSuccess) { fprintf(stderr, "kernel_launch: hipFuncSetAttribute failed\n"); grid = -1; return; }
        if (hipOccupancyMaxActiveBlocksPerMultiprocessor(&per_cu, (const void*)mega_fwd, NWAVES * 64, LDS_BYTES) != hipSuccess || per_cu < 1) { fprintf(stderr, "kernel_launch: occupancy query says %d workgroups per CU\n", per_cu); }
        (void)hipGetLastError();
        grid = cus;
        if (grid % 8 != 0 || grid < 8) { fprintf(stderr, "kernel_launch: CU count %d is not a multiple of 8\n", grid); grid = -1; return; }
    }
    if (grid < 0) return;
    if (hipMemsetAsync((char*)d_ws + WS_CTL, 0, CTL_ZERO_BYTES, stream) != hipSuccess) { fprintf(stderr, "kernel_launch: memset failed\n"); return; }
    Args a{};
    for (int i = 0; i < 19; ++i) a.in[i] = (const float*)d_in[i];
    a.out = (float*)d_out; a.ws = (unsigned char*)d_ws;
    hipLaunchKernelGGL(mega_fwd, dim3(grid), dim3(NWAVES * 64), LDS_BYTES, stream, a);
}
```
